# Optimizing an MI355X kernel written in HIP

```python
import jax, jax.numpy as jnp
from jax import lax
import numpy as np

D_MODEL = 1024
BATCH = 8
SEQ = 4096
DEPTH = 2

N_EVEN = (DEPTH + 1) // 2
N_ODD = DEPTH // 2
EPS = 1e-6
A_WIDTH = D_MODEL // 2
CONV_WIDTH = 3
B_WIDTH = D_MODEL // 2
HG_HEADS = 4
HG_DK = B_WIDTH // HG_HEADS
HG_DV = B_WIDTH // HG_HEADS
HG_CHUNK = 64
IN0_SIZES = (A_WIDTH, A_WIDTH, A_WIDTH, B_WIDTH, B_WIDTH, B_WIDTH, B_WIDTH)
IN0_COLS = sum(IN0_SIZES)
IN0_SPLITS = tuple(int(s) for s in np.cumsum(IN0_SIZES)[:-1])
GM_WIDTH = D_MODEL
GM_GROUPS = 4
GM_CHUNK = 128
D_FF = 4 * D_MODEL

kernel_name = "hybrid_conv_hgrn2_gmlp_adaln"


def rmsnorm(x, g):
    xf = x.astype(jnp.float32)
    inv = lax.rsqrt(jnp.mean(xf * xf, axis=-1, keepdims=True) + EPS)
    return (xf * inv).astype(x.dtype) * g


def layernorm(x, g, b):
    xf = x.astype(jnp.float32)
    mu = jnp.mean(xf, axis=-1, keepdims=True)
    xc = xf - mu
    inv = lax.rsqrt(jnp.mean(xc * xc, axis=-1, keepdims=True) + EPS)
    return (xc * inv).astype(x.dtype) * g + b


def ada_modulation(c, w, b):
    m = jnp.einsum('bd,de->be', jax.nn.silu(c), w) + b
    return jnp.split(m[:, None, :], 6, axis=-1)


def short_conv_mixer(gate_b, gate_c, h, w_conv, b_conv):
    z = gate_c * h
    s = z.shape[1]
    zp = jnp.pad(z, ((0, 0), (CONV_WIDTH - 1, 0), (0, 0)))
    conv = b_conv
    for tap in range(CONV_WIDTH):
        conv = conv + zp[:, tap:tap + s, :] * w_conv[tap]
    return gate_b * conv


def hgrn2_mixer(q, f_logit, i, g, lower_bound, gain):
    f32 = jnp.float32
    bsz, s, _ = q.shape
    n_chunks = s // HG_CHUNK
    lb = lower_bound.astype(f32)
    f = lb + (1.0 - lb) * jax.nn.sigmoid(f_logit.astype(f32))
    log_f = jnp.log(f)
    k = 1.0 - f

    def to_chunks(t, d):
        return t.reshape(bsz, n_chunks, HG_CHUNK, HG_HEADS, d).transpose(1, 0, 3, 2, 4)

    qc = to_chunks(q.astype(f32), HG_DK)
    kc = to_chunks(k, HG_DK)
    lfc = to_chunks(log_f, HG_DK)
    vc = to_chunks(i.astype(f32), HG_DV)
    causal = jnp.tril(jnp.ones((HG_CHUNK, HG_CHUNK), dtype=bool))[:, :, None]

    def step(state, inp):
        qb, kb, lfb, vb = inp
        cum = jnp.cumsum(lfb, axis=2)
        o_inter = jnp.einsum('bhck,bhkv->bhcv', qb * jnp.exp(cum), state)
        diff = cum[:, :, :, None, :] - cum[:, :, None, :, :]
        decay = jnp.exp(jnp.where(causal, diff, -jnp.inf))
        scores = jnp.einsum('bhtk,bhtsk,bhsk->bhts', qb, decay, kb)
        o_intra = jnp.einsum('bhts,bhsv->bhtv', scores, vb)
        last = cum[:, :, -1:, :]
        k_dec = kb * jnp.exp(last - cum)
        new_state = (jnp.exp(last[:, :, 0, :])[..., None] * state
                     + jnp.einsum('bhck,bhcv->bhkv', k_dec, vb))
        return new_state, o_inter + o_intra

    s0 = jnp.zeros((bsz, HG_HEADS, HG_DK, HG_DV), f32)
    _, o = lax.scan(step, s0, (qc, kc, lfc, vc))
    o = o.transpose(1, 0, 3, 2, 4).reshape(bsz, s, HG_HEADS, HG_DV)
    o = o * lax.rsqrt(jnp.mean(o * o, axis=-1, keepdims=True) + EPS)
    o = o.reshape(bsz, s, HG_HEADS * HG_DV) * gain.astype(f32) * jax.nn.silu(g.astype(f32))
    return o.astype(q.dtype)


def spatial_gating_mixer(z, ln_g, ln_b, w_s, b_s):
    u, v = jnp.split(z, 2, axis=-1)
    v = layernorm(v, ln_g, ln_b)
    bsz, s, e = v.shape
    vc = v.reshape(bsz, s // GM_CHUNK, GM_CHUNK, GM_GROUPS, e // GM_GROUPS)
    mask = jnp.tril(jnp.ones((GM_CHUNK, GM_CHUNK), dtype=w_s.dtype))
    w = w_s * mask
    mixed = jnp.einsum('gts,bnsgd->bntgd', w, vc) + b_s.T[None, None, :, :, None]
    return u * mixed.reshape(bsz, s, e)


def setup_inputs(seed: int = 0) -> dict:
    key = jax.random.key(seed)
    ks = jax.random.split(key, 24)
    nrm = jax.random.normal
    D = D_MODEL
    inp = {}
    inp["x"] = nrm(ks[0], (BATCH, SEQ, D), jnp.float32)
    inp["c"] = nrm(ks[1], (BATCH, D), jnp.float32)
    inp["ada_w"] = nrm(ks[2], (DEPTH, D, 6 * D), jnp.float32) * D ** -0.5
    inp["ada_b"] = nrm(ks[3], (DEPTH, 6 * D), jnp.float32) * 0.02
    inp["norm_mix_g"] = 1.0 + 0.02 * nrm(ks[4], (DEPTH, D), jnp.float32)
    inp["norm_ffn_g"] = 1.0 + 0.02 * nrm(ks[5], (DEPTH, D), jnp.float32)
    inp["w_in0"] = nrm(ks[6], (N_EVEN, D, IN0_COLS), jnp.float32) * D ** -0.5
    inp["conv_w"] = nrm(ks[7], (N_EVEN, CONV_WIDTH, A_WIDTH), jnp.float32) * CONV_WIDTH ** -0.5
    inp["conv_b"] = 0.02 * nrm(ks[8], (N_EVEN, A_WIDTH), jnp.float32)
    inp["hg_lb"] = 0.5 * nrm(ks[9], (DEPTH + 1, B_WIDTH), jnp.float32)
    inp["hg_gain"] = 1.0 + 0.02 * nrm(ks[10], (N_EVEN, B_WIDTH), jnp.float32)
    inp["w_out0"] = nrm(ks[11], (N_EVEN, A_WIDTH + B_WIDTH, D), jnp.float32) * (A_WIDTH + B_WIDTH) ** -0.5
    inp["w_in1"] = nrm(ks[12], (N_ODD, D, 2 * GM_WIDTH), jnp.float32) * D ** -0.5
    inp["b_in1"] = 0.02 * nrm(ks[13], (N_ODD, 2 * GM_WIDTH), jnp.float32)
    inp["gm_ln_g"] = 1.0 + 0.02 * nrm(ks[14], (N_ODD, GM_WIDTH), jnp.float32)
    inp["gm_ln_b"] = 0.02 * nrm(ks[15], (N_ODD, GM_WIDTH), jnp.float32)
    inp["gm_ws"] = nrm(ks[16], (N_ODD, GM_GROUPS, GM_CHUNK, GM_CHUNK), jnp.float32) * GM_CHUNK ** -0.5
    inp["gm_bs"] = 1.0 + 0.02 * nrm(ks[17], (N_ODD, GM_GROUPS, GM_CHUNK), jnp.float32)
    inp["w_out1"] = nrm(ks[18], (N_ODD, GM_WIDTH, D), jnp.float32) * GM_WIDTH ** -0.5
    inp["w_ff1"] = nrm(ks[19], (DEPTH, D, D_FF), jnp.float32) * D ** -0.5
    inp["w_ff2"] = nrm(ks[20], (DEPTH, D_FF, D), jnp.float32) * D_FF ** -0.5
    inp["final_g"] = 1.0 + 0.02 * nrm(ks[21], (D,), jnp.float32)
    return inp


def reference(x, c, ada_w, ada_b, norm_mix_g, norm_ffn_g, w_in0, conv_w, conv_b,
              hg_lb, hg_gain, w_out0, w_in1, b_in1, gm_ln_g, gm_ln_b, gm_ws, gm_bs,
              w_out1, w_ff1, w_ff2, final_g):
    lower_bounds = jnp.cumsum(jax.nn.softmax(hg_lb.astype(jnp.float32), axis=0), axis=0)
    for layer in range(DEPTH):
        sh1, sc1, g1, sh2, sc2, g2 = ada_modulation(c, ada_w[layer], ada_b[layer])
        h = rmsnorm(x, norm_mix_g[layer]) * (1.0 + sc1) + sh1
        j = layer // 2
        if layer % 2 == 0:
            p = jnp.einsum('bsd,de->bse', h, w_in0[j])
            a_b, a_c, a_h, b_q, b_f, b_i, b_g = jnp.split(p, IN0_SPLITS, axis=-1)
            y_a = short_conv_mixer(a_b, a_c, a_h, conv_w[j], conv_b[j])
            y_b = hgrn2_mixer(b_q, b_f, b_i, b_g, lower_bounds[layer], hg_gain[j])
            y = jnp.einsum('bse,ed->bsd', jnp.concatenate([y_a, y_b], axis=-1), w_out0[j])
        else:
            z = jax.nn.gelu(jnp.einsum('bsd,de->bse', h, w_in1[j]) + b_in1[j])
            y = spatial_gating_mixer(z, gm_ln_g[j], gm_ln_b[j], gm_ws[j], gm_bs[j])
            y = jnp.einsum('bse,ed->bsd', y, w_out1[j])
        x = x + g1 * y
        h = rmsnorm(x, norm_ffn_g[layer]) * (1.0 + sc2) + sh2
        hid = jnp.square(jax.nn.relu(jnp.einsum('bsd,df->bsf', h, w_ff1[layer])))
        x = x + g2 * jnp.einsum('bsf,fd->bsd', hid, w_ff2[layer])
    return rmsnorm(x, final_g)
```

```cpp
#include <hip/hip_runtime.h>
#include <hip/hip_cooperative_groups.h>
#include <cstdio>
#include <cstdint>
namespace cg = cooperative_groups;
namespace pg8 {
#define PG8_LAS __attribute__((address_space(3)))
typedef unsigned short bf16_t;
typedef short bf16x8 __attribute__((ext_vector_type(8)));
typedef float f32x4 __attribute__((ext_vector_type(4)));
typedef unsigned u32x4 __attribute__((ext_vector_type(4)));
constexpr int BM = 256, BK = 64, HALF = 128, HTB = HALF * BK * 2  , STAGE_BYTES = 8 * HTB, NXCD = 8, WGM = 8;

__host__ __device__ __forceinline__ int lds_byte(int r, int c) { const int st = (r >> 4) * 2 + (c >> 5), rr = r & 15, cc = c & 31, ob = rr * 64 + cc * 2; return st * 1024 + (ob ^ (((ob >> 9) & 1) << 5)); }
__host__ __device__ __forceinline__ void stage_rc(int b, int& R, int& C) { const int st = b / 1024, sb = b % 1024, swz = sb ^ (((sb >> 9) & 1) << 5); R = (st >> 1) * 16 + swz / 64; C = (st & 1) * 32 + (swz % 64) / 2; }
__host__ __device__ __forceinline__ int perm32(int rho) { const int n = rho >> 4, i = rho & 15; return 8 * (i >> 2) + 4 * n + (i & 3); }

struct Unit { int pm, pn; };
struct Gemm { const bf16_t* A; const bf16_t* Bt; int M, N, K; };

struct StaticOrder {
    int nM, nN, nwg, G, c;
    __host__ __device__ void init(int M, int N, int G_, int c_) { nM = M / BM; nN = N / BM; nwg = nM * nN; G = G_; c = c_; }
    __host__ __device__ bool next(int i, Unit& u) const {
        const long L = (long)i * G + c; if (L >= nwg) return false;
        int wgid = (int)L; { const int q = nwg / NXCD, r = nwg % NXCD, xcd = wgid % NXCD, off = wgid / NXCD; wgid = (xcd < r ? xcd * (q + 1) : r * (q + 1) + (xcd - r) * q) + off; }
        const int nig = WGM * nN, gid = wgid / nig, fm = gid * WGM, gsz = (nM - fm) < WGM ? (nM - fm) : WGM;
        u.pm = fm + ((wgid % nig) % gsz); u.pn = (wgid % nig) / gsz; return true;
    }
    __device__ __forceinline__ void a_ready(const Unit&) const {}
    __device__ __forceinline__ void done(const Unit&) const {}
};

__device__ __forceinline__ unsigned cvt_pk_bf16(float lo, float hi) { unsigned r; asm volatile("v_cvt_pk_bf16_f32 %0, %1, %2" : "=v"(r) : "v"(lo), "v"(hi)); return r; }
typedef float f32x2 __attribute__((ext_vector_type(2)));
__device__ __forceinline__ float gelu_tanh(float x) {
    const float u = 0.7978845608f * (x + 0.044715f * x * x * x);
    const float e = __builtin_amdgcn_exp2f(-2.0f * 1.4426950408889634f * u);
    return x * __builtin_amdgcn_rcpf(1.0f + e);
}
template <int ACT> struct EpiBf16 {
    static constexpr bool PERM = true, AFTER_DRAIN = false;
    bf16_t* O; int ldc; const float* bias;
    __device__ __forceinline__ void operator()(const f32x4 (&acc)[2][2][4][2], const Unit& u, int wr, int wc, int fr, int fq) const {
        const int row0 = u.pm * BM + wr * 64 + fr; const int col0 = u.pn * BM + wc * 32 + 8 * fq;
        f32x4 bv[2][2];
#pragma unroll
        for (int bj = 0; bj < 2; ++bj)
#pragma unroll
            for (int n = 0; n < 2; ++n) bv[bj][n] = bias ? *(const f32x4*)(bias + col0 + bj * HALF + 4 * n) : (f32x4){0.f, 0.f, 0.f, 0.f};
#pragma unroll
        for (int ai = 0; ai < 2; ++ai)
#pragma unroll
            for (int m = 0; m < 4; ++m) { bf16_t* rowp = O + (size_t)(row0 + ai * HALF + m * 16) * ldc + col0;
#pragma unroll
                for (int bj = 0; bj < 2; ++bj) { f32x4 v0 = acc[ai][bj][m][0] + bv[bj][0], v1 = acc[ai][bj][m][1] + bv[bj][1];
                    if (ACT == 1) {
#pragma unroll
                        for (int i = 0; i < 4; ++i) { v0[i] = gelu_tanh(v0[i]); v1[i] = gelu_tanh(v1[i]); } }
                    if (ACT == 2) {
#pragma unroll
                        for (int i = 0; i < 4; ++i) { const float a = fmaxf(v0[i], 0.f), b = fmaxf(v1[i], 0.f); v0[i] = a * a; v1[i] = b * b; } }
                    u32x4 w; w.x = cvt_pk_bf16(v0[0], v0[1]); w.y = cvt_pk_bf16(v0[2], v0[3]); w.z = cvt_pk_bf16(v1[0], v1[1]); w.w = cvt_pk_bf16(v1[2], v1[3]);
                    *(u32x4*)(rowp + bj * HALF) = w; } }
    }
};
struct EpiResGate {
    static constexpr bool PERM = false, AFTER_DRAIN = false;
    const float* base; float* out; const float* gate;
    __device__ __forceinline__ void operator()(const f32x4 (&acc)[2][2][4][2], const Unit& u, int wr, int wc, int fr, int fq) const {
        const int row0 = u.pm * BM + wr * 64 + fr; const int col0 = u.pn * BM + wc * 32 + 4 * fq; const int b = u.pm >> 4;
        f32x4 gv[2][2];
#pragma unroll
        for (int bj = 0; bj < 2; ++bj)
#pragma unroll
            for (int n = 0; n < 2; ++n) gv[bj][n] = *(const f32x4*)(gate + (size_t)b * 6144 + col0 + bj * HALF + n * 16);
#pragma unroll
        for (int ai = 0; ai < 2; ++ai)
#pragma unroll
            for (int m = 0; m < 4; ++m) { const size_t off = (size_t)(row0 + ai * HALF + m * 16) * 1024 + col0;
#pragma unroll
                for (int bj = 0; bj < 2; ++bj)
#pragma unroll
                    for (int n = 0; n < 2; ++n) { const f32x4 bs = *(const f32x4*)(base + off + bj * HALF + n * 16);
                        *(f32x4*)(out + off + bj * HALF + n * 16) = bs + gv[bj][n] * acc[ai][bj][m][n]; }
                asm volatile("" ::: "memory"); }
    }
};
template <class Epi, class Sched, bool ALIGN_EPI = false, bool SP2 = false>
__device__ __forceinline__ void gemm_phase(PG8_LAS unsigned char* lds, const Gemm g, const Sched& S, const Epi& E) {
    const int tid = threadIdx.x, wid = __builtin_amdgcn_readfirstlane(tid >> 6), lane = tid & 63, wr = wid >> 2, wc = wid & 3, fr = lane & 15, fq = lane >> 4;
    const int K = g.K, nt = K / BK;
    unsigned voffA[2], voffB[2];
#pragma unroll
    for (int i = 0; i < 2; ++i) { int R, C; stage_rc(tid * 16 + i * 8192, R, C); const int Rb = Epi::PERM ? ((R & ~31) + perm32(R & 31)) : R;
        voffA[i] = (unsigned)(R * K + C) * 2u; voffB[i] = (unsigned)(Rb * K + C) * 2u; }
    const size_t kstep = (size_t)(BK * 2);
    const size_t hstep = (size_t)HALF * K * 2;
    const size_t tstep = 2 * hstep;
    const unsigned ldsw = (unsigned)wid * 1024u;
    const int aoff = lds_byte(wr * 64 + fr, fq * 8), boff = lds_byte(wc * 32 + fr, fq * 8);
#define PG8_SA(b, h) (((b) * 2 + (h)) * HTB)
#define PG8_SB(b, h) ((4 + (b) * 2 + (h)) * HTB)
#define PG8_STAGE(bufoff, gbase, voff) do { _Pragma("unroll") for (int _i = 0; _i < 2; ++_i) \
        __builtin_amdgcn_global_load_lds((const unsigned*)((const char*)(gbase) + (voff)[_i]), (PG8_LAS unsigned*)(lds + (bufoff) + ldsw + _i * 8192), 16, 0, 0); } while (0)
#define PG8_LDA(dst, b, h) do { _Pragma("unroll") for (int m = 0; m < 4; ++m) _Pragma("unroll") for (int k = 0; k < 2; ++k) dst[m][k] = *(const PG8_LAS bf16x8*)(lds + PG8_SA(b, h) + aoff + m * 2048 + k * 1024); } while (0)
#define PG8_LDB(dst, b, h) do { _Pragma("unroll") for (int n = 0; n < 2; ++n) _Pragma("unroll") for (int k = 0; k < 2; ++k) dst[n][k] = *(const PG8_LAS bf16x8*)(lds + PG8_SB(b, h) + boff + n * 2048 + k * 1024); } while (0)
#define PG8_MMA(ai, bj, At, Bt) do { __builtin_amdgcn_s_setprio(1); _Pragma("unroll") for (int m = 0; m < 4; ++m) _Pragma("unroll") for (int n = 0; n < 2; ++n) _Pragma("unroll") for (int k = 0; k < 2; ++k) \
        acc[ai][bj][m][n] = __builtin_amdgcn_mfma_f32_16x16x32_bf16(Bt[n][k], At[m][k], acc[ai][bj][m][n], 0, 0, 0); __builtin_amdgcn_s_setprio(0); } while (0)
#define PG8_WAIT_V(n) asm volatile("s_waitcnt vmcnt(" #n ")" ::: "memory")
#define PG8_WAIT_L(n) asm volatile("s_waitcnt lgkmcnt(" #n ")" ::: "memory")
#define PG8_BAR __builtin_amdgcn_s_barrier()
#define PG8_SCHED __builtin_amdgcn_sched_barrier(0)
    Unit cur, nxt; int ui = 0;
    if (!S.next(0, cur)) return;
    f32x4 acc[2][2][4][2];
#pragma unroll
    for (int a = 0; a < 2; ++a)
#pragma unroll
        for (int b = 0; b < 2; ++b)
#pragma unroll
            for (int m = 0; m < 4; ++m)
#pragma unroll
                for (int n = 0; n < 2; ++n) acc[a][b][m][n] = (f32x4){0.f, 0.f, 0.f, 0.f};
    bf16x8 At[4][2], B0[2][2], B1[2][2];
    const char* cA = (const char*)g.A + (size_t)cur.pm * tstep; const char* cB = (const char*)g.Bt + (size_t)cur.pn * tstep;
    S.a_ready(cur);
    if constexpr (SP2) {
        PG8_STAGE(PG8_SB(0, 0), cB, voffB); PG8_STAGE(PG8_SB(0, 1), cB + hstep, voffB); PG8_STAGE(PG8_SA(0, 0), cA, voffA); PG8_STAGE(PG8_SA(0, 1), cA + hstep, voffA);
        if (wr == 1) PG8_BAR;
        PG8_WAIT_V(2); PG8_BAR;
        PG8_STAGE(PG8_SB(1, 0), cB + kstep, voffB); PG8_STAGE(PG8_SA(1, 0), cA + kstep, voffA); PG8_STAGE(PG8_SB(1, 1), cB + hstep + kstep, voffB);
        PG8_WAIT_V(6); PG8_BAR;
    } else {
        PG8_STAGE(PG8_SB(0, 0), cB, voffB); PG8_STAGE(PG8_SA(0, 0), cA, voffA); PG8_STAGE(PG8_SB(0, 1), cB + hstep, voffB); PG8_STAGE(PG8_SA(0, 1), cA + hstep, voffA);
        if (wr == 1) PG8_BAR;
        PG8_WAIT_V(4); PG8_BAR;
        PG8_STAGE(PG8_SB(1, 0), cB + kstep, voffB); PG8_STAGE(PG8_SA(1, 0), cA + kstep, voffA); PG8_STAGE(PG8_SB(1, 1), cB + hstep + kstep, voffB);
        PG8_WAIT_V(6); PG8_BAR;
    }
    for (;;) {
        const bool has_next = S.next(ui + 1, nxt);
        const char* nA = has_next ? (const char*)g.A + (size_t)nxt.pm * tstep : cA; const char* nB = has_next ? (const char*)g.Bt + (size_t)nxt.pn * tstep : cB;
        for (int t = 0; t < nt; t += 2) {
            const bool last = (t == nt - 2);
            const char* a1 = cA + (size_t)(t + 1) * kstep;
            const char* a2 = last ? nA : cA + (size_t)(t + 2) * kstep; const char* b2 = last ? nB : cB + (size_t)(t + 2) * kstep;
            const char* a3 = a2 + kstep; const char* b3 = b2 + kstep;
            if (last && has_next) S.a_ready(nxt);
            if constexpr (SP2) {
            PG8_LDB(B0, 0, 0); PG8_LDB(B1, 0, 1); PG8_SCHED; PG8_LDA(At, 0, 0); PG8_STAGE(PG8_SA(1, 1), a1 + hstep, voffA);
            PG8_WAIT_V(8); PG8_WAIT_L(0); PG8_BAR; PG8_MMA(0, 0, At, B0); PG8_MMA(0, 1, At, B1); PG8_BAR; PG8_SCHED;
            PG8_LDA(At, 0, 1); PG8_STAGE(PG8_SB(0, 0), b2, voffB); PG8_STAGE(PG8_SB(0, 1), b2 + hstep, voffB); PG8_STAGE(PG8_SA(0, 0), a2, voffA);
            PG8_WAIT_V(8); PG8_WAIT_L(0); PG8_BAR; PG8_MMA(1, 0, At, B0); PG8_MMA(1, 1, At, B1); PG8_BAR; PG8_SCHED;
            PG8_LDB(B0, 1, 0); PG8_LDB(B1, 1, 1); PG8_SCHED; PG8_LDA(At, 1, 0); PG8_STAGE(PG8_SA(0, 1), a2 + hstep, voffA);
            PG8_WAIT_V(8); PG8_WAIT_L(0); PG8_BAR; PG8_MMA(0, 0, At, B0); PG8_MMA(0, 1, At, B1); PG8_BAR; PG8_SCHED;
            PG8_LDA(At, 1, 1); PG8_STAGE(PG8_SB(1, 0), b3, voffB); PG8_STAGE(PG8_SB(1, 1), b3 + hstep, voffB); PG8_STAGE(PG8_SA(1, 0), a3, voffA);
            PG8_WAIT_V(8); PG8_WAIT_L(0); PG8_BAR; PG8_MMA(1, 0, At, B0); PG8_MMA(1, 1, At, B1); PG8_BAR; PG8_SCHED;
            } else {
            PG8_LDB(B0, 0, 0); PG8_SCHED; PG8_LDA(At, 0, 0); PG8_STAGE(PG8_SA(1, 1), a1 + hstep, voffA);
            PG8_WAIT_L(8); PG8_BAR; PG8_WAIT_L(0); PG8_MMA(0, 0, At, B0); PG8_BAR; PG8_SCHED;
            PG8_LDB(B1, 0, 1); PG8_STAGE(PG8_SB(0, 0), b2, voffB);
            PG8_BAR; PG8_WAIT_L(0); PG8_MMA(0, 1, At, B1); PG8_BAR;
            PG8_LDA(At, 0, 1); PG8_STAGE(PG8_SA(0, 0), a2, voffA);
            PG8_BAR; PG8_WAIT_L(0); PG8_MMA(1, 0, At, B0); PG8_BAR; PG8_SCHED;
            PG8_STAGE(PG8_SB(0, 1), b2 + hstep, voffB);
            PG8_WAIT_V(6); PG8_BAR; PG8_MMA(1, 1, At, B1); PG8_BAR;
            PG8_LDB(B0, 1, 0); PG8_SCHED; PG8_LDA(At, 1, 0); PG8_STAGE(PG8_SA(0, 1), a2 + hstep, voffA);
            PG8_WAIT_L(8); PG8_BAR; PG8_WAIT_L(0); PG8_MMA(0, 0, At, B0); PG8_BAR; PG8_SCHED;
            PG8_LDB(B1, 1, 1); PG8_STAGE(PG8_SB(1, 0), b3, voffB);
            PG8_BAR; PG8_WAIT_L(0); PG8_MMA(0, 1, At, B1); PG8_BAR;
            PG8_LDA(At, 1, 1); PG8_STAGE(PG8_SA(1, 0), a3, voffA);
            PG8_BAR; PG8_WAIT_L(0); PG8_MMA(1, 0, At, B0); PG8_BAR; PG8_SCHED;
            PG8_STAGE(PG8_SB(1, 1), b3 + hstep, voffB);
            PG8_WAIT_V(6); PG8_BAR; PG8_MMA(1, 1, At, B1); PG8_BAR;
            }
        }
        if constexpr (ALIGN_EPI) { if (wr == 0) PG8_BAR; }
        if constexpr (!Epi::AFTER_DRAIN) { E(acc, cur, wr, wc, fr, fq); S.done(cur); }
        if (!has_next) break;
#pragma unroll
        for (int a = 0; a < 2; ++a)
#pragma unroll
            for (int b = 0; b < 2; ++b)
#pragma unroll
                for (int m = 0; m < 4; ++m)
#pragma unroll
                    for (int n = 0; n < 2; ++n) acc[a][b][m][n] = (f32x4){0.f, 0.f, 0.f, 0.f};
        cur = nxt; cA = nA; cB = nB; ++ui;
        if constexpr (ALIGN_EPI) { if (wr == 1) PG8_BAR; }
    }
    PG8_WAIT_V(0);
    if constexpr (!ALIGN_EPI) { if (wr == 0) PG8_BAR; }
    PG8_BAR;
    if constexpr (Epi::AFTER_DRAIN) { E.fused(acc, cur, wr, wc, fr, fq, lds, wid, lane); S.done(cur); }
#undef PG8_SA
#undef PG8_SB
#undef PG8_STAGE
#undef PG8_LDA
#undef PG8_LDB
#undef PG8_MMA
#undef PG8_WAIT_V
#undef PG8_WAIT_L
#undef PG8_BAR
#undef PG8_SCHED
}
}
namespace mk {
#define LAS __attribute__((address_space(3)))
typedef unsigned short bf16;
typedef short bf16x8 __attribute__((ext_vector_type(8)));
typedef short s16x4 __attribute__((ext_vector_type(4)));
typedef float f32x4 __attribute__((ext_vector_type(4)));
typedef unsigned v4u __attribute__((ext_vector_type(4)));
typedef unsigned v2u __attribute__((ext_vector_type(2)));

constexpr int BATCH = 8, SEQ = 4096, D = 1024, M = BATCH * SEQ, FF = 4096, NIN0 = 3584, NIN1 = 2048;
constexpr int NT = 512;
constexpr float EPS = 1e-6f;
constexpr size_t MiB = 1u << 20;
constexpr size_t WS_MODP = 0;
constexpr size_t WS_MODF = 3 * MiB;
constexpr size_t WS_DEC = 4 * MiB;
constexpr size_t WS_WIN0 = 8 * MiB, WS_WOUT0 = 15 * MiB, WS_WIN1 = 17 * MiB, WS_WOUT1 = 21 * MiB, WS_WFF1 = 23 * MiB, WS_WFF2 = 39 * MiB;
constexpr size_t WS_H = 56 * MiB;
constexpr size_t WS_P = 120 * MiB;
constexpr size_t WS_S = 376 * MiB;
constexpr size_t WS_END = 440 * MiB;
constexpr int LDS_BYTES = 147456;
constexpr int NPH = 18;

struct Args { const float* in[22]; float* out; unsigned char* ws; int ph_lo, ph_hi; };

__device__ __forceinline__ float bf2f(unsigned u) { return __builtin_bit_cast(float, u << 16); }
__device__ __forceinline__ float bflo(unsigned w) { return __builtin_bit_cast(float, w << 16); }
__device__ __forceinline__ float bfhi(unsigned w) { return __builtin_bit_cast(float, w & 0xffff0000u); }
__device__ __forceinline__ unsigned pk2(float lo, float hi) { return pg8::cvt_pk_bf16(lo, hi); }
__device__ __forceinline__ unsigned short f2bf(float f) { return (unsigned short)(pg8::cvt_pk_bf16(f, 0.f) & 0xffffu); }
__device__ __forceinline__ float wave_sum(float v) {
#pragma unroll
    for (int o = 1; o < 64; o <<= 1) v += __shfl_xor(v, o);
    return v;
}
__device__ __forceinline__ float sigmoidf_(float x) { return __builtin_amdgcn_rcpf(1.0f + __expf(-x)); }
__device__ __forceinline__ float siluf_(float x) { return x * sigmoidf_(x); }

__device__ __forceinline__ bf16x8 rowfrag(LAS const unsigned char* T, int pitchB, int r0, int k0, int fr, int fq) {
    return *(LAS const bf16x8*)(T + (r0 + fr) * pitchB + (k0 + 8 * fq) * 2);
}
typedef short v4i16_t __attribute__((ext_vector_type(4)));
__device__ __forceinline__ bf16x8 trfrag(LAS const unsigned char* T, int pitchB, int k0, int n0, int lane) {
    const int g = lane >> 4, q = (lane & 15) >> 2, pp = lane & 3;
    LAS const unsigned char* p0 = T + (k0 + 8 * g + q) * pitchB + (n0 + 4 * pp) * 2;
    const v4i16_t a = __builtin_amdgcn_ds_read_tr16_b64_v4i16((LAS v4i16_t*)p0);
    const v4i16_t b = __builtin_amdgcn_ds_read_tr16_b64_v4i16((LAS v4i16_t*)(p0 + 4 * pitchB));
    return (bf16x8){a.x, a.y, a.z, a.w, b.x, b.y, b.z, b.w};
}
#define MFMA16(a, b, c) __builtin_amdgcn_mfma_f32_16x16x32_bf16((a), (b), (c), 0, 0, 0)

__device__ __forceinline__ void transpose_item(const float* W, int K, int N, bf16* WT, LAS float* scr, int item, int lane) {
    const int nblk = N / 32, kb = item / nblk, nb = item % nblk, k0 = 64 * kb, n0 = 32 * nb;
#pragma unroll 8
    for (int i = 0; i < 32; ++i) { const int kk = 2 * i + (lane >> 5); scr[kk * 33 + (lane & 31)] = W[(size_t)(k0 + kk) * N + n0 + (lane & 31)]; }
    asm volatile("s_waitcnt lgkmcnt(0)" ::: "memory");
    const int c = lane & 7;
#pragma unroll
    for (int j = 0; j < 4; ++j) { const int n = (lane >> 3) + 8 * j; const LAS float* s = scr + (8 * c) * 33 + n;
        v4u o; o.x = pk2(s[0 * 33], s[1 * 33]); o.y = pk2(s[2 * 33], s[3 * 33]); o.z = pk2(s[4 * 33], s[5 * 33]); o.w = pk2(s[6 * 33], s[7 * 33]);
        *(v4u*)(WT + (size_t)(n0 + n) * K + k0 + 8 * c) = o; }
    asm volatile("s_waitcnt lgkmcnt(0)" ::: "memory");
}
__device__ __forceinline__ void phase_prologue(const Args& a, LAS unsigned char* lds, int tid, int lane, int wave, int G) {
    LAS float* sc = (LAS float*)lds;
    const float* c = a.in[1];
    for (int i = tid; i < 8192; i += NT) sc[i] = siluf_(c[i]);
    __syncthreads();
    float* modp = (float*)(a.ws + WS_MODP);
    for (int it = blockIdx.x; it < 192; it += G) {
        const int l = it / 96, r = it % 96, ch = r / 12, eb = r % 12, e = eb * 512 + tid;
        const float* w = a.in[2] + ((size_t)l * 1024 + ch * 128) * 6144 + e;
        float acc0 = 0.f, acc1 = 0.f, acc2 = 0.f, acc3 = 0.f, acc4 = 0.f, acc5 = 0.f, acc6 = 0.f, acc7 = 0.f;
        const LAS float* s = sc + ch * 128;
#pragma unroll 8
        for (int d = 0; d < 128; ++d) { const float wv = w[(size_t)d * 6144];
            acc0 += s[d] * wv; acc1 += s[1024 + d] * wv; acc2 += s[2048 + d] * wv; acc3 += s[3072 + d] * wv;
            acc4 += s[4096 + d] * wv; acc5 += s[5120 + d] * wv; acc6 += s[6144 + d] * wv; acc7 += s[7168 + d] * wv; }
        float* o = modp + (size_t)((ch * 2 + l) * 8) * 6144 + e;
        o[0] = acc0; o[6144] = acc1; o[2 * 6144] = acc2; o[3 * 6144] = acc3; o[4 * 6144] = acc4; o[5 * 6144] = acc5; o[6 * 6144] = acc6; o[7 * 6144] = acc7;
    }
    __syncthreads();
    LAS float* scr = (LAS float*)(lds + 32768 + wave * 8704);
    const int gw = blockIdx.x * 8 + wave, NGW = G * 8;
    constexpr int I0 = 1792, I1 = 512, I2 = 1024, I3 = 512, I4 = 2048, I5 = 2048;
    constexpr int NITEMS = I0 + I1 + I2 + I3 + 2 * I4 + 2 * I5;
    for (int it = gw; it < NITEMS; it += NGW) {
        int r = it;
        if (r < I0) { transpose_item(a.in[6], 1024, NIN0, (bf16*)(a.ws + WS_WIN0), scr, r, lane); continue; } r -= I0;
        if (r < I1) { transpose_item(a.in[11], 1024, 1024, (bf16*)(a.ws + WS_WOUT0), scr, r, lane); continue; } r -= I1;
        if (r < I2) { transpose_item(a.in[12], 1024, NIN1, (bf16*)(a.ws + WS_WIN1), scr, r, lane); continue; } r -= I2;
        if (r < I3) { transpose_item(a.in[18], 1024, 1024, (bf16*)(a.ws + WS_WOUT1), scr, r, lane); continue; } r -= I3;
        if (r < 2 * I4) { const int l = r / I4; transpose_item(a.in[19] + (size_t)l * 1024 * 4096, 1024, 4096, (bf16*)(a.ws + WS_WFF1) + (size_t)l * 4096 * 1024, scr, r % I4, lane); continue; } r -= 2 * I4;
        { const int l = r / I5; transpose_item(a.in[20] + (size_t)l * 4096 * 1024, 4096, 1024, (bf16*)(a.ws + WS_WFF2) + (size_t)l * 1024 * 4096, scr, r % I5, lane); }
    }
}

template <bool PARTIAL>
__device__ __forceinline__ float modval(const Args& a, int l, int b, int idx) {
    if (PARTIAL) {
        const float* modp = (const float*)(a.ws + WS_MODP);
        float s = a.in[3][l * 6144 + idx];
#pragma unroll
        for (int ch = 0; ch < 8; ++ch) s += modp[(size_t)((ch * 2 + l) * 8 + b) * 6144 + idx];
        return s;
    } else {
        return ((const float*)(a.ws + WS_MODF))[(size_t)(l * 8 + b) * 6144 + idx];
    }
}
template <bool PARTIAL>
__device__ __forceinline__ void phase_norm(const Args& a, const float* xsrc, const float* gvec, int l, int jshift, int jscale, int tid, int lane, int wave, int G) {
    bf16* h = (bf16*)(a.ws + WS_H);
    if (PARTIAL) {
        float* modf = (float*)(a.ws + WS_MODF);
        for (int i = blockIdx.x * NT + tid; i < 2 * 8 * 6144; i += G * NT) { const int ll = i / 49152, bb = (i / 6144) % 8, idx = i % 6144; modf[i] = modval<true>(a, ll, bb, idx); }
    }
    for (int blk = blockIdx.x; blk < 256; blk += G) {
        const int b = blk >> 5;
        f32x4 gs[4], sh[4];
#pragma unroll
        for (int j = 0; j < 4; ++j) { const int col = lane * 4 + 256 * j;
#pragma unroll
            for (int i = 0; i < 4; ++i) { gs[j][i] = gvec[col + i] * (1.0f + modval<PARTIAL>(a, l, b, jscale * 1024 + col + i)); sh[j][i] = modval<PARTIAL>(a, l, b, jshift * 1024 + col + i); } }
        for (int r = wave; r < 128; r += 8) {
            const size_t m = (size_t)blk * 128 + r;
            const f32x4* xr = (const f32x4*)(xsrc + m * 1024) + lane;
            f32x4 v[4]; float ss = 0.f;
#pragma unroll
            for (int j = 0; j < 4; ++j) { v[j] = xr[64 * j]; ss += (v[j].x * v[j].x + v[j].y * v[j].y) + (v[j].z * v[j].z + v[j].w * v[j].w); }
            const float inv = 1.0f / sqrtf(wave_sum(ss) * (1.0f / 1024.0f) + EPS);
            v2u* o8 = (v2u*)(h + m * 1024) + lane;
#pragma unroll
            for (int j = 0; j < 4; ++j) { const f32x4 o = v[j] * inv * gs[j] + sh[j]; v2u w; w.x = pk2(o.x, o.y); w.y = pk2(o.z, o.w); o8[64 * j] = w; }
        }
    }
}
__device__ __forceinline__ void phase_final_norm(const Args& a, int lane, int wave, int G) {
    const float* g = a.in[21];
    f32x4 gs[4];
#pragma unroll
    for (int j = 0; j < 4; ++j) gs[j] = *(const f32x4*)(g + lane * 4 + 256 * j);
    for (int m = blockIdx.x * 8 + wave; m < M; m += G * 8) {
        f32x4* xr = (f32x4*)(a.out + (size_t)m * 1024) + lane;
        f32x4 v[4]; float ss = 0.f;
#pragma unroll
        for (int j = 0; j < 4; ++j) { v[j] = xr[64 * j]; ss += (v[j].x * v[j].x + v[j].y * v[j].y) + (v[j].z * v[j].z + v[j].w * v[j].w); }
        const float inv = 1.0f / sqrtf(wave_sum(ss) * (1.0f / 1024.0f) + EPS);
#pragma unroll
        for (int j = 0; j < 4; ++j) xr[64 * j] = v[j] * inv * gs[j];
    }
}

__device__ __forceinline__ void conv_mixer(const Args& a, int tid, int G) {
    const bf16* p = (const bf16*)(a.ws + WS_P); bf16* y = (bf16*)(a.ws + WS_H);
    const float* cw = a.in[7]; const float* cb = a.in[8];
    for (int it = blockIdx.x * NT + tid; it < M * 64; it += G * NT) {
        const int m = it >> 6, c0 = (it & 63) * 8, t = m & (SEQ - 1);
        const bf16* pr = p + (size_t)m * NIN0 + c0;
        float conv[8];
#pragma unroll
        for (int i = 0; i < 8; ++i) conv[i] = cb[c0 + i];
#pragma unroll
        for (int tap = 0; tap < 3; ++tap) {
            const int dt = 2 - tap;
            if (t - dt >= 0) {
                const v4u cc = *(const v4u*)(pr - (size_t)dt * NIN0 + 512), hh = *(const v4u*)(pr - (size_t)dt * NIN0 + 1024);
#pragma unroll
                for (int i = 0; i < 4; ++i) {
                    conv[2 * i] += cw[tap * 512 + c0 + 2 * i] * (bflo(cc[i]) * bflo(hh[i]));
                    conv[2 * i + 1] += cw[tap * 512 + c0 + 2 * i + 1] * (bfhi(cc[i]) * bfhi(hh[i]));
                }
            }
        }
        const v4u bb = *(const v4u*)pr;
        v4u o;
#pragma unroll
        for (int i = 0; i < 4; ++i) o[i] = pk2(bflo(bb[i]) * conv[2 * i], bfhi(bb[i]) * conv[2 * i + 1]);
        *(v4u*)(y + (size_t)m * 1024 + c0) = o;
    }
}
constexpr int HP = 272;
constexpr int HG_SEG = 0, HG_QD = 2048, HG_QR = 19456, HG_KR = 36864, HG_V = 54272, HG_S = 71680, HG_P = 106496, HG_O = 19456;
constexpr int PP = 144;
constexpr int OP = 528;
__device__ __forceinline__ void hg_cum(const Args& a, LAS unsigned char* lds, int tid, int m0, int h, float (&cum)[16], float (&kk)[16], float& mid, float& last) {
    const int k = tid & 127, seg = tid >> 7, ch = h * 128 + k;
    const float* lbp = a.in[9];
    const float l0 = lbp[ch], l1 = lbp[512 + ch], l2 = lbp[1024 + ch], mx = fmaxf(l0, fmaxf(l1, l2));
    const float e0 = __expf(l0 - mx), e1 = __expf(l1 - mx), e2 = __expf(l2 - mx), lb = e0 / (e0 + e1 + e2);
    const bf16* p = (const bf16*)(a.ws + WS_P) + (size_t)(m0 + seg * 16) * NIN0 + 2048 + ch;
    float run = 0.f;
#pragma unroll
    for (int i = 0; i < 16; ++i) { const float x = bf2f(p[(size_t)i * NIN0]); const float f = lb + (1.0f - lb) * sigmoidf_(x); run += __logf(f); cum[i] = run; kk[i] = 1.0f - f; }
    LAS float* st = (LAS float*)(lds + HG_SEG);
    st[seg * 128 + k] = run;
    __syncthreads();
    const float s0 = st[k], s1 = st[128 + k], s2 = st[256 + k], s3 = st[384 + k];
    const float off = seg == 0 ? 0.f : (seg == 1 ? s0 : (seg == 2 ? s0 + s1 : s0 + s1 + s2));
    mid = s0 + s1; last = (s0 + s1) + (s2 + s3);
#pragma unroll
    for (int i = 0; i < 16; ++i) cum[i] += off;
}
__device__ __forceinline__ void load_tile128(LAS unsigned char* dst, const bf16* src, size_t src_pitch, int rows, int tid) {
    for (int id = tid; id < rows * 16; id += NT) { const int r = id >> 4, c = id & 15; *(LAS v4u*)(dst + r * HP + c * 16) = *(const v4u*)(src + (size_t)r * src_pitch + c * 8); }
}
__device__ __forceinline__ void hg_pass_a(const Args& a, LAS unsigned char* lds, int tid, int lane, int wave, int G) {
    const bf16* p = (const bf16*)(a.ws + WS_P);
    float* loc = a.out; float* dec = (float*)(a.ws + WS_DEC);
    for (int unit = blockIdx.x; unit < 2048; unit += G) {
        const int b = unit >> 8, h = (unit >> 6) & 3, c = unit & 63, m0 = b * SEQ + c * 64;
        float cum[16], kk[16], mid, last;
        hg_cum(a, lds, tid, m0, h, cum, kk, mid, last);
        const int k = tid & 127, seg = tid >> 7;
#pragma unroll
        for (int i = 0; i < 16; ++i) *(LAS unsigned short*)(lds + HG_KR + (seg * 16 + i) * HP + k * 2) = f2bf(kk[i] * __expf(last - cum[i]));
        if (seg == 0) dec[unit * 128 + k] = __expf(last);
        load_tile128(lds + HG_V, p + (size_t)m0 * NIN0 + 2560 + h * 128, NIN0, 64, tid);
        __syncthreads();
        f32x4 acc[8];
#pragma unroll
        for (int n = 0; n < 8; ++n) acc[n] = (f32x4){0.f, 0.f, 0.f, 0.f};
#pragma unroll
        for (int ks = 0; ks < 2; ++ks) {
            const bf16x8 A = trfrag(lds + HG_KR, HP, 32 * ks, 16 * wave, lane);
#pragma unroll
            for (int n = 0; n < 8; ++n) { const bf16x8 B = trfrag(lds + HG_V, HP, 32 * ks, 16 * n, lane); acc[n] = MFMA16(A, B, acc[n]); }
        }
        const int fr = lane & 15, fq = lane >> 4;
        float* lo = loc + (size_t)unit * 16384 + (16 * wave + 4 * fq) * 128 + fr;
#pragma unroll
        for (int n = 0; n < 8; ++n)
#pragma unroll
            for (int r = 0; r < 4; ++r) lo[r * 128 + 16 * n] = acc[n][r];
        __syncthreads();
    }
}
__device__ __forceinline__ void hg_pass_b(const Args& a, int tid, int G) {
    const float* loc = a.out; const float* dec = (const float*)(a.ws + WS_DEC); bf16* st = (bf16*)(a.ws + WS_S);
    for (int idx = blockIdx.x * NT + tid; idx < 32 * 128 * 32; idx += G * NT) {
        const int bh = idx >> 12, k = (idx >> 5) & 127, v4 = idx & 31;
        f32x4 S = (f32x4){0.f, 0.f, 0.f, 0.f};
        const size_t e0 = (size_t)bh * 64 * 16384 + k * 128 + v4 * 4;
#pragma unroll 8
        for (int c = 0; c < 64; ++c) {
            const f32x4 L = *(const f32x4*)(loc + e0 + (size_t)c * 16384); const float d = dec[(bh * 64 + c) * 128 + k];
            v2u w; w.x = pk2(S.x, S.y); w.y = pk2(S.z, S.w);
            *(v2u*)(st + e0 + (size_t)c * 16384) = w;
            S = S * d + L;
        }
    }
}
__device__ __forceinline__ void hg_pass_c(const Args& a, LAS unsigned char* lds, int tid, int lane, int wave, int G) {
    const bf16* p = (const bf16*)(a.ws + WS_P); const bf16* stg = (const bf16*)(a.ws + WS_S); bf16* y = (bf16*)(a.ws + WS_H);
    const float* gain = a.in[10];
    const int fr = lane & 15, fq = lane >> 4;
    for (int unit = blockIdx.x; unit < 2048; unit += G) {
        const int b = unit >> 8, h = (unit >> 6) & 3, c = unit & 63, m0 = b * SEQ + c * 64;
        {
            float cum[16], kk[16], mid, last;
            hg_cum(a, lds, tid, m0, h, cum, kk, mid, last);
            const int k = tid & 127, seg = tid >> 7;
            const bf16* qp = p + (size_t)(m0 + seg * 16) * NIN0 + 1536 + h * 128 + k;
#pragma unroll
            for (int i = 0; i < 16; ++i) {
                const float q = bf2f(qp[(size_t)i * NIN0]);
                const int o = (seg * 16 + i) * HP + k * 2;
                *(LAS unsigned short*)(lds + HG_QD + o) = f2bf(q * __expf(cum[i]));
                *(LAS unsigned short*)(lds + HG_QR + o) = f2bf(q * __expf(fminf(cum[i] - mid, 80.f)));
                *(LAS unsigned short*)(lds + HG_KR + o) = f2bf(kk[i] * __expf(fminf(mid - cum[i], 80.f)));
            }
        }
        load_tile128(lds + HG_V, p + (size_t)m0 * NIN0 + 2560 + h * 128, NIN0, 64, tid);
        load_tile128(lds + HG_S, stg + (size_t)unit * 16384, 128, 128, tid);
        __syncthreads();
        {
            const int tt = wave >> 1;
#pragma unroll
            for (int j = 0; j < 2; ++j) {
                const int stl = (wave & 1) * 2 + j;
                f32x4 sc = (f32x4){0.f, 0.f, 0.f, 0.f};
                if (stl <= tt) {
#pragma unroll
                    for (int ks = 0; ks < 4; ++ks) sc = MFMA16(rowfrag(lds + HG_QR, HP, 16 * tt, 32 * ks, fr, fq), rowfrag(lds + HG_KR, HP, 16 * stl, 32 * ks, fr, fq), sc);
                }
#pragma unroll
                for (int r = 0; r < 4; ++r) { const int t = 16 * tt + 4 * fq + r, s = 16 * stl + fr;
                    *(LAS unsigned short*)(lds + HG_P + t * PP + s * 2) = f2bf(s <= t ? sc[r] : 0.f); }
            }
        }
        __syncthreads();
        {
            const int tt = wave >> 1, n0 = (wave & 1) * 4;
            f32x4 acc[4];
#pragma unroll
            for (int n = 0; n < 4; ++n) acc[n] = (f32x4){0.f, 0.f, 0.f, 0.f};
#pragma unroll
            for (int ks = 0; ks < 4; ++ks) { const bf16x8 A = rowfrag(lds + HG_QD, HP, 16 * tt, 32 * ks, fr, fq);
#pragma unroll
                for (int n = 0; n < 4; ++n) acc[n] = MFMA16(A, trfrag(lds + HG_S, HP, 32 * ks, 16 * (n0 + n), lane), acc[n]); }
#pragma unroll
            for (int ks = 0; ks < 2; ++ks) { const bf16x8 A = rowfrag(lds + HG_P, PP, 16 * tt, 32 * ks, fr, fq);
#pragma unroll
                for (int n = 0; n < 4; ++n) acc[n] = MFMA16(A, trfrag(lds + HG_V, HP, 32 * ks, 16 * (n0 + n), lane), acc[n]); }
#pragma unroll
            for (int n = 0; n < 4; ++n)
#pragma unroll
                for (int r = 0; r < 4; ++r) *(LAS float*)(lds + HG_O + (16 * tt + 4 * fq + r) * OP + (16 * (n0 + n) + fr) * 4) = acc[n][r];
        }
        __syncthreads();
        {
            const int t = tid >> 3, part = tid & 7, v0 = part * 16;
            f32x4 o[4]; float ss = 0.f;
#pragma unroll
            for (int j = 0; j < 4; ++j) { o[j] = *(LAS const f32x4*)(lds + HG_O + t * OP + (v0 + 4 * j) * 4); ss += (o[j].x * o[j].x + o[j].y * o[j].y) + (o[j].z * o[j].z + o[j].w * o[j].w); }
            ss += __shfl_xor(ss, 1); ss += __shfl_xor(ss, 2); ss += __shfl_xor(ss, 4);
            const float inv = 1.0f / sqrtf(ss * (1.0f / 128.0f) + EPS);
            const bf16* gp = p + (size_t)(m0 + t) * NIN0 + 3072 + h * 128 + v0;
            const v4u g0 = *(const v4u*)gp, g1 = *(const v4u*)(gp + 8);
            const float* gn = gain + h * 128 + v0;
            v4u w0, w1;
#pragma unroll
            for (int i = 0; i < 4; ++i) {
                const float ga = bflo(g0[i]), gb = bfhi(g0[i]), gc = bflo(g1[i]), gd = bfhi(g1[i]);
                const int e = 2 * i;
                const float oa = o[e >> 2][e & 3], ob = o[(e + 1) >> 2][(e + 1) & 3], oc = o[(8 + e) >> 2][(8 + e) & 3], od = o[(9 + e) >> 2][(9 + e) & 3];
                w0[i] = pk2(oa * inv * gn[e] * siluf_(ga), ob * inv * gn[e + 1] * siluf_(gb));
                w1[i] = pk2(oc * inv * gn[8 + e] * siluf_(gc), od * inv * gn[9 + e] * siluf_(gd));
            }
            bf16* yo = y + (size_t)(m0 + t) * 1024 + 512 + h * 128 + v0;
            *(v4u*)yo = w0; *(v4u*)(yo + 8) = w1;
        }
        __syncthreads();
    }
}

constexpr int SG_STAT = 0, SG_W = 1024, SG_V = 35840, SGVP = 528;
__device__ __forceinline__ void phase_sgu(const Args& a, LAS unsigned char* lds, int tid, int lane, int wave, int G) {
    const bf16* z = (const bf16*)(a.ws + WS_P); bf16* y = (bf16*)(a.ws + WS_H);
    const float* lng = a.in[14]; const float* lnb = a.in[15]; const float* ws = a.in[16]; const float* bs = a.in[17];
    const int fr = lane & 15, fq = lane >> 4;
    for (int unit = blockIdx.x; unit < 256; unit += G) {
        const int m0 = unit * 128;
        LAS float* stt = (LAS float*)(lds + SG_STAT);
        for (int r = wave; r < 128; r += 8) {
            const bf16* vr = z + (size_t)(m0 + r) * NIN1 + 1024 + lane * 8;
            const v4u a0 = *(const v4u*)vr, a1 = *(const v4u*)(vr + 512);
            float x[16];
#pragma unroll
            for (int i = 0; i < 4; ++i) { x[2 * i] = bflo(a0[i]); x[2 * i + 1] = bfhi(a0[i]); x[8 + 2 * i] = bflo(a1[i]); x[9 + 2 * i] = bfhi(a1[i]); }
            float s = 0.f;
#pragma unroll
            for (int i = 0; i < 16; ++i) s += x[i];
            const float mean = wave_sum(s) * (1.0f / 1024.0f);
            float q = 0.f;
#pragma unroll
            for (int i = 0; i < 16; ++i) { const float d = x[i] - mean; q += d * d; }
            const float rstd = 1.0f / sqrtf(wave_sum(q) * (1.0f / 1024.0f) + EPS);
            if (lane == 0) { stt[2 * r] = mean; stt[2 * r + 1] = rstd; }
        }
        __syncthreads();
        for (int g = 0; g < 4; ++g) {
            {
                const int t = tid >> 2, s0 = (tid & 3) * 32;
                const float* wr = ws + (size_t)g * 16384 + t * 128 + s0;
#pragma unroll
                for (int j = 0; j < 4; ++j) {
                    const f32x4 w0 = *(const f32x4*)(wr + 8 * j), w1 = *(const f32x4*)(wr + 8 * j + 4);
                    const int s = s0 + 8 * j;
                    v4u o;
                    o.x = pk2(s + 0 <= t ? w0.x : 0.f, s + 1 <= t ? w0.y : 0.f); o.y = pk2(s + 2 <= t ? w0.z : 0.f, s + 3 <= t ? w0.w : 0.f);
                    o.z = pk2(s + 4 <= t ? w1.x : 0.f, s + 5 <= t ? w1.y : 0.f); o.w = pk2(s + 6 <= t ? w1.z : 0.f, s + 7 <= t ? w1.w : 0.f);
                    *(LAS v4u*)(lds + SG_W + t * HP + s * 2) = o;
                }
            }
#pragma unroll 2
            for (int i = 0; i < 8; ++i) {
                const int id = tid + NT * i, s = id >> 5, dc = (id & 31) * 8, col = g * 256 + dc;
                const v4u vv = *(const v4u*)(z + (size_t)(m0 + s) * NIN1 + 1024 + col);
                const float mean = stt[2 * s], rstd = stt[2 * s + 1];
                const f32x4 g0 = *(const f32x4*)(lng + col), g1 = *(const f32x4*)(lng + col + 4), b0 = *(const f32x4*)(lnb + col), b1 = *(const f32x4*)(lnb + col + 4);
                v4u o;
                o.x = pk2((bflo(vv.x) - mean) * rstd * g0.x + b0.x, (bfhi(vv.x) - mean) * rstd * g0.y + b0.y);
                o.y = pk2((bflo(vv.y) - mean) * rstd * g0.z + b0.z, (bfhi(vv.y) - mean) * rstd * g0.w + b0.w);
                o.z = pk2((bflo(vv.z) - mean) * rstd * g1.x + b1.x, (bfhi(vv.z) - mean) * rstd * g1.y + b1.y);
                o.w = pk2((bflo(vv.w) - mean) * rstd * g1.z + b1.z, (bfhi(vv.w) - mean) * rstd * g1.w + b1.w);
                *(LAS v4u*)(lds + SG_V + s * SGVP + dc * 2) = o;
            }
            __syncthreads();
            f32x4 acc[16];
#pragma unroll
            for (int n = 0; n < 16; ++n) acc[n] = (f32x4){0.f, 0.f, 0.f, 0.f};
            for (int ks = 0; ks < 4; ++ks) {
                if (32 * ks > 16 * wave + 15) break;
                const bf16x8 A = rowfrag(lds + SG_W, HP, 16 * wave, 32 * ks, fr, fq);
#pragma unroll
                for (int n = 0; n < 16; ++n) acc[n] = MFMA16(A, trfrag(lds + SG_V, SGVP, 32 * ks, 16 * n, lane), acc[n]);
            }
#pragma unroll
            for (int r = 0; r < 4; ++r) {
                const int t = 16 * wave + 4 * fq + r; const float bsv = bs[g * 128 + t];
                const bf16* ur = z + (size_t)(m0 + t) * NIN1 + g * 256 + fr; bf16* yr = y + (size_t)(m0 + t) * 1024 + g * 256 + fr;
#pragma unroll
                for (int n = 0; n < 16; ++n) yr[16 * n] = f2bf((acc[n][r] + bsv) * bf2f(ur[16 * n]));
            }
            __syncthreads();
        }
    }
}

#ifndef MK_N_LAUNCHES
#define MK_N_LAUNCHES 1
#endif

__global__ void __launch_bounds__(512, 2) fwd(Args a) {
    extern __shared__ __attribute__((aligned(16))) unsigned char lds_raw[];
    LAS unsigned char* lds = (LAS unsigned char*)lds_raw;
    cg::grid_group grid = cg::this_grid();
    const int lo = a.ph_lo, hi = a.ph_hi;
#define IN(k) (lo <= (k) && (k) < hi)
#define SEAM(k) do { if (IN(k) && IN((k) + 1)) grid.sync(); } while (0)
#define PHASE_VARS int tid = threadIdx.x; asm volatile("" : "+v"(tid)); int G = gridDim.x; asm volatile("" : "+s"(G)); \
    const int lane = tid & 63, wave = __builtin_amdgcn_readfirstlane(tid >> 6); (void)lane; (void)wave; \
    bf16* const H = (bf16*)(a.ws + WS_H); bf16* const P = (bf16*)(a.ws + WS_P); const float* const modf = (const float*)(a.ws + WS_MODF); (void)H; (void)P; (void)modf;
#define GEMM_RES(ph, l, ffn) if (IN(ph)) { PHASE_VARS \
        const bf16* Bt = (ffn) ? (const bf16*)(a.ws + WS_WFF2) + (size_t)(l) * 1024 * 4096 : (const bf16*)(a.ws + ((l) ? WS_WOUT1 : WS_WOUT0)); \
        pg8::Gemm g{(ffn) ? P : H, Bt, M, 1024, (ffn) ? 4096 : 1024}; pg8::StaticOrder S; S.init(M, 1024, G, (int)blockIdx.x); \
        pg8::EpiResGate E{(ph) == 6 ? a.in[0] : a.out, a.out, modf + (size_t)(l) * 8 * 6144 + ((ffn) ? 5 : 2) * 1024}; \
        pg8::gemm_phase<pg8::EpiResGate, pg8::StaticOrder, true, true>(lds, g, S, E); } SEAM(ph);
#define GEMM_FF1(ph, l) if (IN(ph)) { PHASE_VARS \
        pg8::Gemm g{H, (const bf16*)(a.ws + WS_WFF1) + (size_t)(l) * 4096 * 1024, M, FF, 1024}; pg8::StaticOrder S; S.init(M, FF, G, (int)blockIdx.x); \
        pg8::EpiBf16<2> E{P, FF, nullptr}; \
        pg8::gemm_phase<pg8::EpiBf16<2>, pg8::StaticOrder, true, true>(lds, g, S, E); } SEAM(ph);
#define NORM(ph, l, ffn) if (IN(ph)) { PHASE_VARS \
        phase_norm<false>(a, a.out, ((ffn) ? a.in[5] : a.in[4]) + (l) * 1024, (l), (ffn) ? 3 : 0, (ffn) ? 4 : 1, tid, lane, wave, G); } SEAM(ph);

    if (IN(0)) { PHASE_VARS phase_prologue(a, lds, tid, lane, wave, G); } SEAM(0);
    if (IN(1)) { PHASE_VARS phase_norm<true>(a, a.in[0], a.in[4], 0, 0, 1, tid, lane, wave, G); } SEAM(1);
    if (IN(2)) { PHASE_VARS
        pg8::Gemm g{H, (const bf16*)(a.ws + WS_WIN0), M, NIN0, 1024}; pg8::StaticOrder S; S.init(M, NIN0, G, (int)blockIdx.x);
        pg8::EpiBf16<0> E{P, NIN0, nullptr};
        pg8::gemm_phase<pg8::EpiBf16<0>, pg8::StaticOrder, true, true>(lds, g, S, E); } SEAM(2);
    if (IN(3)) { PHASE_VARS conv_mixer(a, tid, G); hg_pass_a(a, lds, tid, lane, wave, G); } SEAM(3);
    if (IN(4)) { PHASE_VARS hg_pass_b(a, tid, G); } SEAM(4);
    if (IN(5)) { PHASE_VARS hg_pass_c(a, lds, tid, lane, wave, G); } SEAM(5);
    GEMM_RES(6, 0, false)
    NORM(7, 0, true)
    GEMM_FF1(8, 0)
    GEMM_RES(9, 0, true)
    NORM(10, 1, false)
    if (IN(11)) { PHASE_VARS
        pg8::Gemm g{H, (const bf16*)(a.ws + WS_WIN1), M, NIN1, 1024}; pg8::StaticOrder S; S.init(M, NIN1, G, (int)blockIdx.x);
        pg8::EpiBf16<1> E{P, NIN1, a.in[13]};
        pg8::gemm_phase<pg8::EpiBf16<1>, pg8::StaticOrder, true, true>(lds, g, S, E); } SEAM(11);
    if (IN(12)) { PHASE_VARS phase_sgu(a, lds, tid, lane, wave, G); } SEAM(12);
    GEMM_RES(13, 1, false)
    NORM(14, 1, true)
    GEMM_FF1(15, 1)
    GEMM_RES(16, 1, true)
    if (IN(17)) { PHASE_VARS phase_final_norm(a, lane, wave, G); }
}
}

extern "C" void kernel_launch(void* const* d_in, const int* in_sizes, int n_in, void* d_out, int out_size, void* d_ws, size_t ws_size, hipStream_t stream) {
    using namespace mk;
    static int grid = 0;
    if (grid == 0) {
        if (n_in != 22 || out_size != M * D || ws_size < WS_END) { fprintf(stderr, "kernel_launch: unexpected shapes (n_in %d out %d ws %zu)\n", n_in, out_size, ws_size); grid = -1; return; }
        int dev = 0, cus = 0, per_cu = 0;
        (void)hipGetDevice(&dev); (void)hipDeviceGetAttribute(&cus, hipDeviceAttributeMultiprocessorCount, dev);
        if (hipFuncSetAttribute((const void*)fwd, hipFuncAttributeMaxDynamicSharedMemorySize, LDS_BYTES) != hipSuccess) fprintf(stderr, "kernel_launch: hipFuncSetAttribute failed\n");
        if (hipOccupancyMaxActiveBlocksPerMultiprocessor(&per_cu, (const void*)fwd, NT, LDS_BYTES) != hipSuccess || per_cu < 1) { fprintf(stderr, "kernel_launch: occupancy query says %d\n", per_cu); per_cu = 1; }
        (void)hipGetLastError();
        grid = cus * per_cu;
        if (grid <= 0) grid = 256;
    }
    if (grid < 0) return;
    Args a{};
    for (int i = 0; i < 22; ++i) a.in[i] = (const float*)d_in[i];
    a.out = (float*)d_out; a.ws = (unsigned char*)d_ws;
#if MK_N_LAUNCHES == 1
    a.ph_lo = 0; a.ph_hi = NPH;
    void* args[] = {&a};
    hipError_t e = hipLaunchCooperativeKernel((const void*)fwd, dim3(grid), dim3(NT), args, LDS_BYTES, stream);
    if (e != hipSuccess) fprintf(stderr, "cooperative launch failed: %s (grid %d)\n", hipGetErrorString(e), grid);
#else
    for (int ph = 0; ph < NPH; ++ph) {
        a.ph_lo = ph; a.ph_hi = ph + 1;
        hipLaunchKernelGGL(fwd, dim3(grid), dim3(NT), LDS_BYTES, stream, a);
    }
#endif
}
```

```cpp
#include <hip/hip_runtime.h>
#include <hip/hip_cooperative_groups.h>
#include <cstdio>
#include <cstdint>
namespace cg = cooperative_groups;
namespace pg8 {
#define PG8_LAS __attribute__((address_space(3)))
typedef unsigned short bf16_t;
typedef short bf16x8 __attribute__((ext_vector_type(8)));
typedef float f32x4 __attribute__((ext_vector_type(4)));
typedef unsigned u32x4 __attribute__((ext_vector_type(4)));
constexpr int BM = 256, BK = 64, HALF = 128, HTB = HALF * BK * 2  , STAGE_BYTES = 8 * HTB, NXCD = 8, WGM = 8;

__host__ __device__ __forceinline__ int lds_byte(int r, int c) { const int st = (r >> 4) * 2 + (c >> 5), rr = r & 15, cc = c & 31, ob = rr * 64 + cc * 2; return st * 1024 + (ob ^ (((ob >> 9) & 1) << 5)); }
__host__ __device__ __forceinline__ void stage_rc(int b, int& R, int& C) { const int st = b / 1024, sb = b % 1024, swz = sb ^ (((sb >> 9) & 1) << 5); R = (st >> 1) * 16 + swz / 64; C = (st & 1) * 32 + (swz % 64) / 2; }
__host__ __device__ __forceinline__ int perm32(int rho) { const int n = rho >> 4, i = rho & 15; return 8 * (i >> 2) + 4 * n + (i & 3); }

struct Unit { int pm, pn; };
struct Gemm { const bf16_t* A; const bf16_t* Bt; int M, N, K; };

struct StaticOrder {
    int nM, nN, nwg, G, c;
    __host__ __device__ void init(int M, int N, int G_, int c_) { nM = M / BM; nN = N / BM; nwg = nM * nN; G = G_; c = c_; }
    __host__ __device__ bool next(int i, Unit& u) const {
        const long L = (long)i * G + c; if (L >= nwg) return false;
        int wgid = (int)L; { const int q = nwg / NXCD, r = nwg % NXCD, xcd = wgid % NXCD, off = wgid / NXCD; wgid = (xcd < r ? xcd * (q + 1) : r * (q + 1) + (xcd - r) * q) + off; }
        const int nig = WGM * nN, gid = wgid / nig, fm = gid * WGM, gsz = (nM - fm) < WGM ? (nM - fm) : WGM;
        u.pm = fm + ((wgid % nig) % gsz); u.pn = (wgid % nig) / gsz; return true;
    }
    __device__ __forceinline__ void a_ready(const Unit&) const {}
    __device__ __forceinline__ void done(const Unit&) const {}
};

__device__ __forceinline__ unsigned cvt_pk_bf16(float lo, float hi) { unsigned r; asm volatile("v_cvt_pk_bf16_f32 %0, %1, %2" : "=v"(r) : "v"(lo), "v"(hi)); return r; }
typedef float f32x2 __attribute__((ext_vector_type(2)));
__device__ __forceinline__ float gelu_tanh(float x) {
    const float u = 0.7978845608f * (x + 0.044715f * x * x * x);
    const float e = __builtin_amdgcn_exp2f(-2.0f * 1.4426950408889634f * u);
    return x * __builtin_amdgcn_rcpf(1.0f + e);
}
template <int ACT> struct EpiBf16 {
    static constexpr bool PERM = true, AFTER_DRAIN = false;
    bf16_t* O; int ldc; const float* bias;
    __device__ __forceinline__ void operator()(const f32x4 (&acc)[2][2][4][2], const Unit& u, int wr, int wc, int fr, int fq) const {
        const int row0 = u.pm * BM + wr * 64 + fr; const int col0 = u.pn * BM + wc * 32 + 8 * fq;
        f32x4 bv[2][2];
#pragma unroll
        for (int bj = 0; bj < 2; ++bj)
#pragma unroll
            for (int n = 0; n < 2; ++n) bv[bj][n] = bias ? *(const f32x4*)(bias + col0 + bj * HALF + 4 * n) : (f32x4){0.f, 0.f, 0.f, 0.f};
#pragma unroll
        for (int ai = 0; ai < 2; ++ai)
#pragma unroll
            for (int m = 0; m < 4; ++m) { bf16_t* rowp = O + (size_t)(row0 + ai * HALF + m * 16) * ldc + col0;
#pragma unroll
                for (int bj = 0; bj < 2; ++bj) { f32x4 v0 = acc[ai][bj][m][0] + bv[bj][0], v1 = acc[ai][bj][m][1] + bv[bj][1];
                    if (ACT == 1) {
#pragma unroll
                        for (int i = 0; i < 4; ++i) { v0[i] = gelu_tanh(v0[i]); v1[i] = gelu_tanh(v1[i]); } }
                    if (ACT == 2) {
#pragma unroll
                        for (int i = 0; i < 4; ++i) { const float a = fmaxf(v0[i], 0.f), b = fmaxf(v1[i], 0.f); v0[i] = a * a; v1[i] = b * b; } }
                    u32x4 w; w.x = cvt_pk_bf16(v0[0], v0[1]); w.y = cvt_pk_bf16(v0[2], v0[3]); w.z = cvt_pk_bf16(v1[0], v1[1]); w.w = cvt_pk_bf16(v1[2], v1[3]);
                    *(u32x4*)(rowp + bj * HALF) = w; } }
    }
};
struct EpiResGate {
    static constexpr bool PERM = false, AFTER_DRAIN = false;
    const float* base; float* out; const float* gate;
    __device__ __forceinline__ void operator()(const f32x4 (&acc)[2][2][4][2], const Unit& u, int wr, int wc, int fr, int fq) const {
        const int row0 = u.pm * BM + wr * 64 + fr; const int col0 = u.pn * BM + wc * 32 + 4 * fq; const int b = u.pm >> 4;
        f32x4 gv[2][2];
#pragma unroll
        for (int bj = 0; bj < 2; ++bj)
#pragma unroll
            for (int n = 0; n < 2; ++n) gv[bj][n] = *(const f32x4*)(gate + (size_t)b * 6144 + col0 + bj * HALF + n * 16);
#pragma unroll
        for (int ai = 0; ai < 2; ++ai)
#pragma unroll
            for (int m = 0; m < 4; ++m) { const size_t off = (size_t)(row0 + ai * HALF + m * 16) * 1024 + col0;
#pragma unroll
                for (int bj = 0; bj < 2; ++bj)
#pragma unroll
                    for (int n = 0; n < 2; ++n) { const f32x4 bs = *(const f32x4*)(base + off + bj * HALF + n * 16);
                        *(f32x4*)(out + off + bj * HALF + n * 16) = bs + gv[bj][n] * acc[ai][bj][m][n]; }
                asm volatile("" ::: "memory"); }
    }
};
template <class Epi, class Sched, bool ALIGN_EPI = false, bool SP2 = false>
__device__ __forceinline__ void gemm_phase(PG8_LAS unsigned char* lds, const Gemm g, const Sched& S, const Epi& E) {
    const int tid = threadIdx.x, wid = __builtin_amdgcn_readfirstlane(tid >> 6), lane = tid & 63, wr = wid >> 2, wc = wid & 3, fr = lane & 15, fq = lane >> 4;
    const int K = g.K, nt = K / BK;
    unsigned voffA[2], voffB[2];
#pragma unroll
    for (int i = 0; i < 2; ++i) { int R, C; stage_rc(tid * 16 + i * 8192, R, C); const int Rb = Epi::PERM ? ((R & ~31) + perm32(R & 31)) : R;
        voffA[i] = (unsigned)(R * K + C) * 2u; voffB[i] = (unsigned)(Rb * K + C) * 2u; }
    const size_t kstep = (size_t)(BK * 2);
    const size_t hstep = (size_t)HALF * K * 2;
    const size_t tstep = 2 * hstep;
    const unsigned ldsw = (unsigned)wid * 1024u;
    const int aoff = lds_byte(wr * 64 + fr, fq * 8), boff = lds_byte(wc * 32 + fr, fq * 8);
#define PG8_SA(b, h) (((b) * 2 + (h)) * HTB)
#define PG8_SB(b, h) ((4 + (b) * 2 + (h)) * HTB)
#define PG8_STAGE(bufoff, gbase, voff) do { _Pragma("unroll") for (int _i = 0; _i < 2; ++_i) \
        __builtin_amdgcn_global_load_lds((const unsigned*)((const char*)(gbase) + (voff)[_i]), (PG8_LAS unsigned*)(lds + (bufoff) + ldsw + _i * 8192), 16, 0, 0); } while (0)
#define PG8_LDA(dst, b, h) do { _Pragma("unroll") for (int m = 0; m < 4; ++m) _Pragma("unroll") for (int k = 0; k < 2; ++k) dst[m][k] = *(const PG8_LAS bf16x8*)(lds + PG8_SA(b, h) + aoff + m * 2048 + k * 1024); } while (0)
#define PG8_LDB(dst, b, h) do { _Pragma("unroll") for (int n = 0; n < 2; ++n) _Pragma("unroll") for (int k = 0; k < 2; ++k) dst[n][k] = *(const PG8_LAS bf16x8*)(lds + PG8_SB(b, h) + boff + n * 2048 + k * 1024); } while (0)
#define PG8_MMA(ai, bj, At, Bt) do { __builtin_amdgcn_s_setprio(1); _Pragma("unroll") for (int m = 0; m < 4; ++m) _Pragma("unroll") for (int n = 0; n < 2; ++n) _Pragma("unroll") for (int k = 0; k < 2; ++k) \
        acc[ai][bj][m][n] = __builtin_amdgcn_mfma_f32_16x16x32_bf16(Bt[n][k], At[m][k], acc[ai][bj][m][n], 0, 0, 0); __builtin_amdgcn_s_setprio(0); } while (0)
#define PG8_WAIT_V(n) asm volatile("s_waitcnt vmcnt(" #n ")" ::: "memory")
#define PG8_WAIT_L(n) asm volatile("s_waitcnt lgkmcnt(" #n ")" ::: "memory")
#define PG8_BAR __builtin_amdgcn_s_barrier()
#define PG8_SCHED __builtin_amdgcn_sched_barrier(0)
    Unit cur, nxt; int ui = 0;
    if (!S.next(0, cur)) return;
    f32x4 acc[2][2][4][2];
#pragma unroll
    for (int a = 0; a < 2; ++a)
#pragma unroll
        for (int b = 0; b < 2; ++b)
#pragma unroll
            for (int m = 0; m < 4; ++m)
#pragma unroll
                for (int n = 0; n < 2; ++n) acc[a][b][m][n] = (f32x4){0.f, 0.f, 0.f, 0.f};
    bf16x8 At[4][2], B0[2][2], B1[2][2];
    const char* cA = (const char*)g.A + (size_t)cur.pm * tstep; const char* cB = (const char*)g.Bt + (size_t)cur.pn * tstep;
    S.a_ready(cur);
    if constexpr (SP2) {
        PG8_STAGE(PG8_SB(0, 0), cB, voffB); PG8_STAGE(PG8_SB(0, 1), cB + hstep, voffB); PG8_STAGE(PG8_SA(0, 0), cA, voffA); PG8_STAGE(PG8_SA(0, 1), cA + hstep, voffA);
        if (wr == 1) PG8_BAR;
        PG8_WAIT_V(2); PG8_BAR;
        PG8_STAGE(PG8_SB(1, 0), cB + kstep, voffB); PG8_STAGE(PG8_SA(1, 0), cA + kstep, voffA); PG8_STAGE(PG8_SB(1, 1), cB + hstep + kstep, voffB);
        PG8_WAIT_V(6); PG8_BAR;
    } else {
        PG8_STAGE(PG8_SB(0, 0), cB, voffB); PG8_STAGE(PG8_SA(0, 0), cA, voffA); PG8_STAGE(PG8_SB(0, 1), cB + hstep, voffB); PG8_STAGE(PG8_SA(0, 1), cA + hstep, voffA);
        if (wr == 1) PG8_BAR;
        PG8_WAIT_V(4); PG8_BAR;
        PG8_STAGE(PG8_SB(1, 0), cB + kstep, voffB); PG8_STAGE(PG8_SA(1, 0), cA + kstep, voffA); PG8_STAGE(PG8_SB(1, 1), cB + hstep + kstep, voffB);
        PG8_WAIT_V(6); PG8_BAR;
    }
    for (;;) {
        const bool has_next = S.next(ui + 1, nxt);
        const char* nA = has_next ? (const char*)g.A + (size_t)nxt.pm * tstep : cA; const char* nB = has_next ? (const char*)g.Bt + (size_t)nxt.pn * tstep : cB;
        for (int t = 0; t < nt; t += 2) {
            const bool last = (t == nt - 2);
            const char* a1 = cA + (size_t)(t + 1) * kstep;
            const char* a2 = last ? nA : cA + (size_t)(t + 2) * kstep; const char* b2 = last ? nB : cB + (size_t)(t + 2) * kstep;
            const char* a3 = a2 + kstep; const char* b3 = b2 + kstep;
            if (last && has_next) S.a_ready(nxt);
            if constexpr (SP2) {
            PG8_LDB(B0, 0, 0); PG8_LDB(B1, 0, 1); PG8_SCHED; PG8_LDA(At, 0, 0); PG8_STAGE(PG8_SA(1, 1), a1 + hstep, voffA);
            PG8_WAIT_V(8); PG8_WAIT_L(0); PG8_BAR; PG8_MMA(0, 0, At, B0); PG8_MMA(0, 1, At, B1); PG8_BAR; PG8_SCHED;
            PG8_LDA(At, 0, 1); PG8_STAGE(PG8_SB(0, 0), b2, voffB); PG8_STAGE(PG8_SB(0, 1), b2 + hstep, voffB); PG8_STAGE(PG8_SA(0, 0), a2, voffA);
            PG8_WAIT_V(8); PG8_WAIT_L(0); PG8_BAR; PG8_MMA(1, 0, At, B0); PG8_MMA(1, 1, At, B1); PG8_BAR; PG8_SCHED;
            PG8_LDB(B0, 1, 0); PG8_LDB(B1, 1, 1); PG8_SCHED; PG8_LDA(At, 1, 0); PG8_STAGE(PG8_SA(0, 1), a2 + hstep, voffA);
            PG8_WAIT_V(8); PG8_WAIT_L(0); PG8_BAR; PG8_MMA(0, 0, At, B0); PG8_MMA(0, 1, At, B1); PG8_BAR; PG8_SCHED;
            PG8_LDA(At, 1, 1); PG8_STAGE(PG8_SB(1, 0), b3, voffB); PG8_STAGE(PG8_SB(1, 1), b3 + hstep, voffB); PG8_STAGE(PG8_SA(1, 0), a3, voffA);
            PG8_WAIT_V(8); PG8_WAIT_L(0); PG8_BAR; PG8_MMA(1, 0, At, B0); PG8_MMA(1, 1, At, B1); PG8_BAR; PG8_SCHED;
            } else {
            PG8_LDB(B0, 0, 0); PG8_SCHED; PG8_LDA(At, 0, 0); PG8_STAGE(PG8_SA(1, 1), a1 + hstep, voffA);
            PG8_WAIT_L(8); PG8_BAR; PG8_WAIT_L(0); PG8_MMA(0, 0, At, B0); PG8_BAR; PG8_SCHED;
            PG8_LDB(B1, 0, 1); PG8_STAGE(PG8_SB(0, 0), b2, voffB);
            PG8_BAR; PG8_WAIT_L(0); PG8_MMA(0, 1, At, B1); PG8_BAR;
            PG8_LDA(At, 0, 1); PG8_STAGE(PG8_SA(0, 0), a2, voffA);
            PG8_BAR; PG8_WAIT_L(0); PG8_MMA(1, 0, At, B0); PG8_BAR; PG8_SCHED;
            PG8_STAGE(PG8_SB(0, 1), b2 + hstep, voffB);
            PG8_WAIT_V(6); PG8_BAR; PG8_MMA(1, 1, At, B1); PG8_BAR;
            PG8_LDB(B0, 1, 0); PG8_SCHED; PG8_LDA(At, 1, 0); PG8_STAGE(PG8_SA(0, 1), a2 + hstep, voffA);
            PG8_WAIT_L(8); PG8_BAR; PG8_WAIT_L(0); PG8_MMA(0, 0, At, B0); PG8_BAR; PG8_SCHED;
            PG8_LDB(B1, 1, 1); PG8_STAGE(PG8_SB(1, 0), b3, voffB);
            PG8_BAR; PG8_WAIT_L(0); PG8_MMA(0, 1, At, B1); PG8_BAR;
            PG8_LDA(At, 1, 1); PG8_STAGE(PG8_SA(1, 0), a3, voffA);
            PG8_BAR; PG8_WAIT_L(0); PG8_MMA(1, 0, At, B0); PG8_BAR; PG8_SCHED;
            PG8_STAGE(PG8_SB(1, 1), b3 + hstep, voffB);
            PG8_WAIT_V(6); PG8_BAR; PG8_MMA(1, 1, At, B1); PG8_BAR;
            }
        }
        if constexpr (ALIGN_EPI) { if (wr == 0) PG8_BAR; }
        if constexpr (!Epi::AFTER_DRAIN) { E(acc, cur, wr, wc, fr, fq); S.done(cur); }
        if (!has_next) break;
#pragma unroll
        for (int a = 0; a < 2; ++a)
#pragma unroll
            for (int b = 0; b < 2; ++b)
#pragma unroll
                for (int m = 0; m < 4; ++m)
#pragma unroll
                    for (int n = 0; n < 2; ++n) acc[a][b][m][n] = (f32x4){0.f, 0.f, 0.f, 0.f};
        cur = nxt; cA = nA; cB = nB; ++ui;
        if constexpr (ALIGN_EPI) { if (wr == 1) PG8_BAR; }
    }
    PG8_WAIT_V(0);
    if constexpr (!ALIGN_EPI) { if (wr == 0) PG8_BAR; }
    PG8_BAR;
    if constexpr (Epi::AFTER_DRAIN) { E.fused(acc, cur, wr, wc, fr, fq, lds, wid, lane); S.done(cur); }
#undef PG8_SA
#undef PG8_SB
#undef PG8_STAGE
#undef PG8_LDA
#undef PG8_LDB
#undef PG8_MMA
#undef PG8_WAIT_V
#undef PG8_WAIT_L
#undef PG8_BAR
#undef PG8_SCHED
}
}
namespace mk {
#define LAS __attribute__((address_space(3)))
typedef unsigned short bf16;
typedef short bf16x8 __attribute__((ext_vector_type(8)));
typedef short s16x4 __attribute__((ext_vector_type(4)));
typedef float f32x4 __attribute__((ext_vector_type(4)));
typedef unsigned v4u __attribute__((ext_vector_type(4)));
typedef unsigned v2u __attribute__((ext_vector_type(2)));

constexpr int BATCH = 8, SEQ = 4096, D = 1024, M = BATCH * SEQ, FF = 4096, NIN0 = 3584, NIN1 = 2048;
constexpr int NT = 512;
constexpr float EPS = 1e-6f;
constexpr size_t MiB = 1u << 20;
constexpr size_t WS_MODP = 0;
constexpr size_t WS_MODF = 3 * MiB;
constexpr size_t WS_DEC = 4 * MiB;
constexpr size_t WS_BAR = 5 * MiB, BAR_ZERO_BYTES = 16384;
constexpr int MISC_OFF = 131072;
constexpr size_t WS_WIN0 = 8 * MiB, WS_WOUT0 = 15 * MiB, WS_WIN1 = 17 * MiB, WS_WOUT1 = 21 * MiB, WS_WFF1 = 23 * MiB, WS_WFF2 = 39 * MiB;
constexpr size_t WS_H = 56 * MiB;
constexpr size_t WS_P = 120 * MiB;
constexpr size_t WS_S = 376 * MiB;
constexpr size_t WS_END = 440 * MiB;
constexpr int LDS_BYTES = 147456;
constexpr int NPH = 18;

struct Args { const float* in[22]; float* out; unsigned char* ws; int ph_lo, ph_hi; };

__device__ __forceinline__ float bf2f(unsigned u) { return __builtin_bit_cast(float, u << 16); }
__device__ __forceinline__ float bflo(unsigned w) { return __builtin_bit_cast(float, w << 16); }
__device__ __forceinline__ float bfhi(unsigned w) { return __builtin_bit_cast(float, w & 0xffff0000u); }
__device__ __forceinline__ unsigned pk2(float lo, float hi) { return pg8::cvt_pk_bf16(lo, hi); }
__device__ __forceinline__ unsigned short f2bf(float f) { return (unsigned short)(pg8::cvt_pk_bf16(f, 0.f) & 0xffffu); }
__device__ __forceinline__ float wave_sum(float v) {
#pragma unroll
    for (int o = 1; o < 64; o <<= 1) v += __shfl_xor(v, o);
    return v;
}
__device__ __forceinline__ float sigmoidf_(float x) { return __builtin_amdgcn_rcpf(1.0f + __expf(-x)); }
__device__ __forceinline__ float siluf_(float x) { return x * sigmoidf_(x); }

__device__ __forceinline__ bf16x8 rowfrag(LAS const unsigned char* T, int pitchB, int r0, int k0, int fr, int fq) {
    return *(LAS const bf16x8*)(T + (r0 + fr) * pitchB + (k0 + 8 * fq) * 2);
}
typedef short v4i16_t __attribute__((ext_vector_type(4)));
__device__ __forceinline__ bf16x8 trfrag(LAS const unsigned char* T, int pitchB, int k0, int n0, int lane) {
    const int g = lane >> 4, q = (lane & 15) >> 2, pp = lane & 3;
    LAS const unsigned char* p0 = T + (k0 + 8 * g + q) * pitchB + (n0 + 4 * pp) * 2;
    const v4i16_t a = __builtin_amdgcn_ds_read_tr16_b64_v4i16((LAS v4i16_t*)p0);
    const v4i16_t b = __builtin_amdgcn_ds_read_tr16_b64_v4i16((LAS v4i16_t*)(p0 + 4 * pitchB));
    return (bf16x8){a.x, a.y, a.z, a.w, b.x, b.y, b.z, b.w};
}
#define MFMA16(a, b, c) __builtin_amdgcn_mfma_f32_16x16x32_bf16((a), (b), (c), 0, 0, 0)

#define XB_TMO      128
#define XB_XCNT(j)  (256  + 64 * (j))
#define XB_XSUB(j)  (1280 + 64 * (j))
#define XB_XGEN(j)  (2304 + 64 * (j))
#define XB_TOP      3328
#define XB_TOPGEN   3392
#define XCD_BAR_WORDS 3456
#define XB_SPIN_CAP (1u << 18)

__device__ __forceinline__ unsigned xb_ld(unsigned* p)              { return __hip_atomic_load(p, __ATOMIC_RELAXED, __HIP_MEMORY_SCOPE_AGENT); }
__device__ __forceinline__ unsigned xb_add(unsigned* p, unsigned v) { return __hip_atomic_fetch_add(p, v, __ATOMIC_RELAXED, __HIP_MEMORY_SCOPE_AGENT); }
__device__ __forceinline__ unsigned xb_xcc_id() { return (unsigned)__builtin_amdgcn_s_getreg((3 << 11) | 20) & 0xFu; }
#define XB_SPIN(cond, bar) do { unsigned _sp = 0; while (cond) { __builtin_amdgcn_s_sleep(1); \
    if ((++_sp & 255u) == 0u) { if (xb_ld(&(bar)[XB_TMO])) break; if (_sp > XB_SPIN_CAP) { atomicAdd(&(bar)[XB_TMO], 1u); break; } } } } while (0)

struct XcdBarrier {
    unsigned* bar; unsigned x;
    volatile LAS unsigned* st;
};

__device__ __forceinline__ XcdBarrier xcd_barrier_post(unsigned* bar, volatile LAS unsigned* st) {
    XcdBarrier b; b.bar = bar; b.x = xb_xcc_id(); b.st = st;
    if (threadIdx.x == 0) (void)xb_add(&bar[XB_XCNT(b.x)], 1u);
    return b;
}
__device__ __forceinline__ void xcd_barrier_complete(unsigned* bar, unsigned x, unsigned& nloc, unsigned& nx) {
    const unsigned G = gridDim.x * gridDim.y * gridDim.z;
    unsigned sum, cnt, mine, sp = 0u;
    for (;;) {
        sum = 0u; cnt = 0u; mine = 0u;
#pragma unroll
        for (unsigned j = 0; j < 16; ++j) { const unsigned c = xb_ld(&bar[XB_XCNT(j)]); sum += c; cnt += (c > 0u) ? 1u : 0u; mine = (j == x) ? c : mine; }
        if (sum == G) break;
        __builtin_amdgcn_s_sleep(1);
        if ((++sp & 255u) == 0u) { if (xb_ld(&bar[XB_TMO])) break; if (sp > XB_SPIN_CAP) { atomicAdd(&bar[XB_TMO], 1u); break; } }
    }
    nloc = mine > 0u ? mine : 1u; nx = cnt > 0u ? cnt : 1u;
}

__device__ __forceinline__ void xcd_barrier(const XcdBarrier& b) {
    asm volatile("s_waitcnt vmcnt(0)" ::: "memory");
    __syncthreads();
    if (threadIdx.x == 0) {
        unsigned* bar = b.bar;
        __builtin_amdgcn_s_waitcnt(0);
        unsigned nloc = b.st[0], nx = b.st[1];
        if (nloc == 0u) { xcd_barrier_complete(bar, b.x, nloc, nx); b.st[0] = nloc; b.st[1] = nx; }
        const unsigned old = xb_add(&bar[XB_XSUB(b.x)], 1u);
        const unsigned gen = old / nloc;
        if (old + 1u == (gen + 1u) * nloc) {
            __builtin_amdgcn_fence(__ATOMIC_RELEASE, "agent");
            asm volatile("s_waitcnt vmcnt(0)" ::: "memory");
            const unsigned og = xb_add(&bar[XB_TOP], 1u);
            const unsigned tg = og / nx;
            if (og + 1u == (tg + 1u) * nx) xb_add(&bar[XB_TOPGEN], 1u);
            else XB_SPIN(xb_ld(&bar[XB_TOPGEN]) == tg, bar);
            __builtin_amdgcn_fence(__ATOMIC_ACQUIRE, "agent");
            xb_add(&bar[XB_XGEN(b.x)], 1u);
            asm volatile("s_waitcnt vmcnt(0)" ::: "memory");
        } else {
            XB_SPIN(xb_ld(&bar[XB_XGEN(b.x)]) == gen, bar);
            __builtin_amdgcn_fence(__ATOMIC_ACQUIRE, "agent");
            asm volatile("s_waitcnt vmcnt(0)" ::: "memory");
        }
    }
    __syncthreads();
}

__device__ __forceinline__ void transpose_item(const float* W, int K, int N, bf16* WT, LAS float* scr, int item, int lane) {
    const int nblk = N / 32, kb = item / nblk, nb = item % nblk, k0 = 64 * kb, n0 = 32 * nb;
#pragma unroll 8
    for (int i = 0; i < 32; ++i) { const int kk = 2 * i + (lane >> 5); scr[kk * 33 + (lane & 31)] = W[(size_t)(k0 + kk) * N + n0 + (lane & 31)]; }
    asm volatile("s_waitcnt lgkmcnt(0)" ::: "memory");
    const int c = lane & 7;
#pragma unroll
    for (int j = 0; j < 4; ++j) { const int n = (lane >> 3) + 8 * j; const LAS float* s = scr + (8 * c) * 33 + n;
        v4u o; o.x = pk2(s[0 * 33], s[1 * 33]); o.y = pk2(s[2 * 33], s[3 * 33]); o.z = pk2(s[4 * 33], s[5 * 33]); o.w = pk2(s[6 * 33], s[7 * 33]);
        *(v4u*)(WT + (size_t)(n0 + n) * K + k0 + 8 * c) = o; }
    asm volatile("s_waitcnt lgkmcnt(0)" ::: "memory");
}
__device__ __forceinline__ void phase_prologue(const Args& a, LAS unsigned char* lds, int tid, int lane, int wave, int G) {
    LAS float* sc = (LAS float*)lds;
    const float* c = a.in[1];
    for (int i = tid; i < 8192; i += NT) sc[i] = siluf_(c[i]);
    __syncthreads();
    float* modp = (float*)(a.ws + WS_MODP);
    for (int it = blockIdx.x; it < 192; it += G) {
        const int l = it / 96, r = it % 96, ch = r / 12, eb = r % 12, e = eb * 512 + tid;
        const float* w = a.in[2] + ((size_t)l * 1024 + ch * 128) * 6144 + e;
        float acc0 = 0.f, acc1 = 0.f, acc2 = 0.f, acc3 = 0.f, acc4 = 0.f, acc5 = 0.f, acc6 = 0.f, acc7 = 0.f;
        const LAS float* s = sc + ch * 128;
#pragma unroll 8
        for (int d = 0; d < 128; ++d) { const float wv = w[(size_t)d * 6144];
            acc0 += s[d] * wv; acc1 += s[1024 + d] * wv; acc2 += s[2048 + d] * wv; acc3 += s[3072 + d] * wv;
            acc4 += s[4096 + d] * wv; acc5 += s[5120 + d] * wv; acc6 += s[6144 + d] * wv; acc7 += s[7168 + d] * wv; }
        float* o = modp + (size_t)((ch * 2 + l) * 8) * 6144 + e;
        o[0] = acc0; o[6144] = acc1; o[2 * 6144] = acc2; o[3 * 6144] = acc3; o[4 * 6144] = acc4; o[5 * 6144] = acc5; o[6 * 6144] = acc6; o[7 * 6144] = acc7;
    }
    __syncthreads();
    LAS float* scr = (LAS float*)(lds + 32768 + wave * 8704);
    const int gw = blockIdx.x * 8 + wave, NGW = G * 8;
    constexpr int I0 = 1792, I1 = 512, I2 = 1024, I3 = 512, I4 = 2048, I5 = 2048;
    constexpr int NITEMS = I0 + I1 + I2 + I3 + 2 * I4 + 2 * I5;
    for (int it = gw; it < NITEMS; it += NGW) {
        int r = it;
        if (r < I0) { transpose_item(a.in[6], 1024, NIN0, (bf16*)(a.ws + WS_WIN0), scr, r, lane); continue; } r -= I0;
        if (r < I1) { transpose_item(a.in[11], 1024, 1024, (bf16*)(a.ws + WS_WOUT0), scr, r, lane); continue; } r -= I1;
        if (r < I2) { transpose_item(a.in[12], 1024, NIN1, (bf16*)(a.ws + WS_WIN1), scr, r, lane); continue; } r -= I2;
        if (r < I3) { transpose_item(a.in[18], 1024, 1024, (bf16*)(a.ws + WS_WOUT1), scr, r, lane); continue; } r -= I3;
        if (r < 2 * I4) { const int l = r / I4; transpose_item(a.in[19] + (size_t)l * 1024 * 4096, 1024, 4096, (bf16*)(a.ws + WS_WFF1) + (size_t)l * 4096 * 1024, scr, r % I4, lane); continue; } r -= 2 * I4;
        { const int l = r / I5; transpose_item(a.in[20] + (size_t)l * 4096 * 1024, 4096, 1024, (bf16*)(a.ws + WS_WFF2) + (size_t)l * 1024 * 4096, scr, r % I5, lane); }
    }
}

template <bool PARTIAL>
__device__ __forceinline__ float modval(const Args& a, int l, int b, int idx) {
    if (PARTIAL) {
        const float* modp = (const float*)(a.ws + WS_MODP);
        float s = a.in[3][l * 6144 + idx];
#pragma unroll
        for (int ch = 0; ch < 8; ++ch) s += modp[(size_t)((ch * 2 + l) * 8 + b) * 6144 + idx];
        return s;
    } else {
        return ((const float*)(a.ws + WS_MODF))[(size_t)(l * 8 + b) * 6144 + idx];
    }
}
template <bool PARTIAL>
__device__ __forceinline__ void phase_norm(const Args& a, const float* xsrc, const float* gvec, int l, int jshift, int jscale, int tid, int lane, int wave, int G) {
    bf16* h = (bf16*)(a.ws + WS_H);
    if (PARTIAL) {
        float* modf = (float*)(a.ws + WS_MODF);
        for (int i = blockIdx.x * NT + tid; i < 2 * 8 * 6144; i += G * NT) { const int ll = i / 49152, bb = (i / 6144) % 8, idx = i % 6144; modf[i] = modval<true>(a, ll, bb, idx); }
    }
    for (int blk = blockIdx.x; blk < 256; blk += G) {
        const int b = blk >> 5;
        f32x4 gs[4], sh[4];
#pragma unroll
        for (int j = 0; j < 4; ++j) { const int col = lane * 4 + 256 * j;
#pragma unroll
            for (int i = 0; i < 4; ++i) { gs[j][i] = gvec[col + i] * (1.0f + modval<PARTIAL>(a, l, b, jscale * 1024 + col + i)); sh[j][i] = modval<PARTIAL>(a, l, b, jshift * 1024 + col + i); } }
        for (int r = wave; r < 128; r += 8) {
            const size_t m = (size_t)blk * 128 + r;
            const f32x4* xr = (const f32x4*)(xsrc + m * 1024) + lane;
            f32x4 v[4]; float ss = 0.f;
#pragma unroll
            for (int j = 0; j < 4; ++j) { v[j] = xr[64 * j]; ss += (v[j].x * v[j].x + v[j].y * v[j].y) + (v[j].z * v[j].z + v[j].w * v[j].w); }
            const float inv = 1.0f / sqrtf(wave_sum(ss) * (1.0f / 1024.0f) + EPS);
            v2u* o8 = (v2u*)(h + m * 1024) + lane;
#pragma unroll
            for (int j = 0; j < 4; ++j) { const f32x4 o = v[j] * inv * gs[j] + sh[j]; v2u w; w.x = pk2(o.x, o.y); w.y = pk2(o.z, o.w); o8[64 * j] = w; }
        }
    }
}
__device__ __forceinline__ void phase_final_norm(const Args& a, int lane, int wave, int G) {
    const float* g = a.in[21];
    f32x4 gs[4];
#pragma unroll
    for (int j = 0; j < 4; ++j) gs[j] = *(const f32x4*)(g + lane * 4 + 256 * j);
    for (int m = blockIdx.x * 8 + wave; m < M; m += G * 8) {
        f32x4* xr = (f32x4*)(a.out + (size_t)m * 1024) + lane;
        f32x4 v[4]; float ss = 0.f;
#pragma unroll
        for (int j = 0; j < 4; ++j) { v[j] = xr[64 * j]; ss += (v[j].x * v[j].x + v[j].y * v[j].y) + (v[j].z * v[j].z + v[j].w * v[j].w); }
        const float inv = 1.0f / sqrtf(wave_sum(ss) * (1.0f / 1024.0f) + EPS);
#pragma unroll
        for (int j = 0; j < 4; ++j) xr[64 * j] = v[j] * inv * gs[j];
    }
}

__device__ __forceinline__ void conv_mixer(const Args& a, int tid, int G) {
    const bf16* p = (const bf16*)(a.ws + WS_P); bf16* y = (bf16*)(a.ws + WS_H);
    const float* cw = a.in[7]; const float* cb = a.in[8];
    for (int it = blockIdx.x * NT + tid; it < M * 64; it += G * NT) {
        const int m = it >> 6, c0 = (it & 63) * 8, t = m & (SEQ - 1);
        const bf16* pr = p + (size_t)m * NIN0 + c0;
        float conv[8];
#pragma unroll
        for (int i = 0; i < 8; ++i) conv[i] = cb[c0 + i];
#pragma unroll
        for (int tap = 0; tap < 3; ++tap) {
            const int dt = 2 - tap;
            if (t - dt >= 0) {
                const v4u cc = *(const v4u*)(pr - (size_t)dt * NIN0 + 512), hh = *(const v4u*)(pr - (size_t)dt * NIN0 + 1024);
#pragma unroll
                for (int i = 0; i < 4; ++i) {
                    conv[2 * i] += cw[tap * 512 + c0 + 2 * i] * (bflo(cc[i]) * bflo(hh[i]));
                    conv[2 * i + 1] += cw[tap * 512 + c0 + 2 * i + 1] * (bfhi(cc[i]) * bfhi(hh[i]));
                }
            }
        }
        const v4u bb = *(const v4u*)pr;
        v4u o;
#pragma unroll
        for (int i = 0; i < 4; ++i) o[i] = pk2(bflo(bb[i]) * conv[2 * i], bfhi(bb[i]) * conv[2 * i + 1]);
        *(v4u*)(y + (size_t)m * 1024 + c0) = o;
    }
}
constexpr int HP = 272;
constexpr int HG_SEG = 0, HG_QD = 2048, HG_QR = 19456, HG_KR = 36864, HG_V = 54272, HG_S = 71680, HG_P = 106496, HG_O = 19456;
constexpr int PP = 144;
constexpr int OP = 528;
__device__ __forceinline__ void hg_cum(const Args& a, LAS unsigned char* lds, int tid, int m0, int h, float (&cum)[16], float (&kk)[16], float& mid, float& last) {
    const int k = tid & 127, seg = tid >> 7, ch = h * 128 + k;
    const float* lbp = a.in[9];
    const float l0 = lbp[ch], l1 = lbp[512 + ch], l2 = lbp[1024 + ch], mx = fmaxf(l0, fmaxf(l1, l2));
    const float e0 = __expf(l0 - mx), e1 = __expf(l1 - mx), e2 = __expf(l2 - mx), lb = e0 / (e0 + e1 + e2);
    const bf16* p = (const bf16*)(a.ws + WS_P) + (size_t)(m0 + seg * 16) * NIN0 + 2048 + ch;
    float run = 0.f;
#pragma unroll
    for (int i = 0; i < 16; ++i) { const float x = bf2f(p[(size_t)i * NIN0]); const float f = lb + (1.0f - lb) * sigmoidf_(x); run += __logf(f); cum[i] = run; kk[i] = 1.0f - f; }
    LAS float* st = (LAS float*)(lds + HG_SEG);
    st[seg * 128 + k] = run;
    __syncthreads();
    const float s0 = st[k], s1 = st[128 + k], s2 = st[256 + k], s3 = st[384 + k];
    const float off = seg == 0 ? 0.f : (seg == 1 ? s0 : (seg == 2 ? s0 + s1 : s0 + s1 + s2));
    mid = s0 + s1; last = (s0 + s1) + (s2 + s3);
#pragma unroll
    for (int i = 0; i < 16; ++i) cum[i] += off;
}
__device__ __forceinline__ void load_tile128(LAS unsigned char* dst, const bf16* src, size_t src_pitch, int rows, int tid) {
    for (int id = tid; id < rows * 16; id += NT) { const int r = id >> 4, c = id & 15; *(LAS v4u*)(dst + r * HP + c * 16) = *(const v4u*)(src + (size_t)r * src_pitch + c * 8); }
}
__device__ __forceinline__ void hg_pass_a(const Args& a, LAS unsigned char* lds, int tid, int lane, int wave, int G) {
    const bf16* p = (const bf16*)(a.ws + WS_P);
    float* loc = a.out; float* dec = (float*)(a.ws + WS_DEC);
    for (int unit = blockIdx.x; unit < 2048; unit += G) {
        const int b = unit >> 8, h = (unit >> 6) & 3, c = unit & 63, m0 = b * SEQ + c * 64;
        float cum[16], kk[16], mid, last;
        hg_cum(a, lds, tid, m0, h, cum, kk, mid, last);
        const int k = tid & 127, seg = tid >> 7;
#pragma unroll
        for (int i = 0; i < 16; ++i) *(LAS unsigned short*)(lds + HG_KR + (seg * 16 + i) * HP + k * 2) = f2bf(kk[i] * __expf(last - cum[i]));
        if (seg == 0) dec[unit * 128 + k] = __expf(last);
        load_tile128(lds + HG_V, p + (size_t)m0 * NIN0 + 2560 + h * 128, NIN0, 64, tid);
        __syncthreads();
        f32x4 acc[8];
#pragma unroll
        for (int n = 0; n < 8; ++n) acc[n] = (f32x4){0.f, 0.f, 0.f, 0.f};
#pragma unroll
        for (int ks = 0; ks < 2; ++ks) {
            const bf16x8 A = trfrag(lds + HG_KR, HP, 32 * ks, 16 * wave, lane);
#pragma unroll
            for (int n = 0; n < 8; ++n) { const bf16x8 B = trfrag(lds + HG_V, HP, 32 * ks, 16 * n, lane); acc[n] = MFMA16(A, B, acc[n]); }
        }
        const int fr = lane & 15, fq = lane >> 4;
        float* lo = loc + (size_t)unit * 16384 + (16 * wave + 4 * fq) * 128 + fr;
#pragma unroll
        for (int n = 0; n < 8; ++n)
#pragma unroll
            for (int r = 0; r < 4; ++r) lo[r * 128 + 16 * n] = acc[n][r];
        __syncthreads();
    }
}
__device__ __forceinline__ void hg_pass_b(const Args& a, int tid, int G) {
    const float* loc = a.out; const float* dec = (const float*)(a.ws + WS_DEC); bf16* st = (bf16*)(a.ws + WS_S);
    for (int idx = blockIdx.x * NT + tid; idx < 32 * 128 * 32; idx += G * NT) {
        const int bh = idx >> 12, k = (idx >> 5) & 127, v4 = idx & 31;
        f32x4 S = (f32x4){0.f, 0.f, 0.f, 0.f};
        const size_t e0 = (size_t)bh * 64 * 16384 + k * 128 + v4 * 4;
#pragma unroll 8
        for (int c = 0; c < 64; ++c) {
            const f32x4 L = *(const f32x4*)(loc + e0 + (size_t)c * 16384); const float d = dec[(bh * 64 + c) * 128 + k];
            v2u w; w.x = pk2(S.x, S.y); w.y = pk2(S.z, S.w);
            *(v2u*)(st + e0 + (size_t)c * 16384) = w;
            S = S * d + L;
        }
    }
}
__device__ __forceinline__ void hg_pass_c(const Args& a, LAS unsigned char* lds, int tid, int lane, int wave, int G) {
    const bf16* p = (const bf16*)(a.ws + WS_P); const bf16* stg = (const bf16*)(a.ws + WS_S); bf16* y = (bf16*)(a.ws + WS_H);
    const float* gain = a.in[10];
    const int fr = lane & 15, fq = lane >> 4;
    for (int unit = blockIdx.x; unit < 2048; unit += G) {
        const int b = unit >> 8, h = (unit >> 6) & 3, c = unit & 63, m0 = b * SEQ + c * 64;
        {
            float cum[16], kk[16], mid, last;
            hg_cum(a, lds, tid, m0, h, cum, kk, mid, last);
            const int k = tid & 127, seg = tid >> 7;
            const bf16* qp = p + (size_t)(m0 + seg * 16) * NIN0 + 1536 + h * 128 + k;
#pragma unroll
            for (int i = 0; i < 16; ++i) {
                const float q = bf2f(qp[(size_t)i * NIN0]);
                const int o = (seg * 16 + i) * HP + k * 2;
                *(LAS unsigned short*)(lds + HG_QD + o) = f2bf(q * __expf(cum[i]));
                *(LAS unsigned short*)(lds + HG_QR + o) = f2bf(q * __expf(fminf(cum[i] - mid, 80.f)));
                *(LAS unsigned short*)(lds + HG_KR + o) = f2bf(kk[i] * __expf(fminf(mid - cum[i], 80.f)));
            }
        }
        load_tile128(lds + HG_V, p + (size_t)m0 * NIN0 + 2560 + h * 128, NIN0, 64, tid);
        load_tile128(lds + HG_S, stg + (size_t)unit * 16384, 128, 128, tid);
        __syncthreads();
        {
            const int tt = wave >> 1;
#pragma unroll
            for (int j = 0; j < 2; ++j) {
                const int stl = (wave & 1) * 2 + j;
                f32x4 sc = (f32x4){0.f, 0.f, 0.f, 0.f};
                if (stl <= tt) {
#pragma unroll
                    for (int ks = 0; ks < 4; ++ks) sc = MFMA16(rowfrag(lds + HG_QR, HP, 16 * tt, 32 * ks, fr, fq), rowfrag(lds + HG_KR, HP, 16 * stl, 32 * ks, fr, fq), sc);
                }
#pragma unroll
                for (int r = 0; r < 4; ++r) { const int t = 16 * tt + 4 * fq + r, s = 16 * stl + fr;
                    *(LAS unsigned short*)(lds + HG_P + t * PP + s * 2) = f2bf(s <= t ? sc[r] : 0.f); }
            }
        }
        __syncthreads();
        {
            const int tt = wave >> 1, n0 = (wave & 1) * 4;
            f32x4 acc[4];
#pragma unroll
            for (int n = 0; n < 4; ++n) acc[n] = (f32x4){0.f, 0.f, 0.f, 0.f};
#pragma unroll
            for (int ks = 0; ks < 4; ++ks) { const bf16x8 A = rowfrag(lds + HG_QD, HP, 16 * tt, 32 * ks, fr, fq);
#pragma unroll
                for (int n = 0; n < 4; ++n) acc[n] = MFMA16(A, trfrag(lds + HG_S, HP, 32 * ks, 16 * (n0 + n), lane), acc[n]); }
#pragma unroll
            for (int ks = 0; ks < 2; ++ks) { const bf16x8 A = rowfrag(lds + HG_P, PP, 16 * tt, 32 * ks, fr, fq);
#pragma unroll
                for (int n = 0; n < 4; ++n) acc[n] = MFMA16(A, trfrag(lds + HG_V, HP, 32 * ks, 16 * (n0 + n), lane), acc[n]); }
#pragma unroll
            for (int n = 0; n < 4; ++n)
#pragma unroll
                for (int r = 0; r < 4; ++r) *(LAS float*)(lds + HG_O + (16 * tt + 4 * fq + r) * OP + (16 * (n0 + n) + fr) * 4) = acc[n][r];
        }
        __syncthreads();
        {
            const int t = tid >> 3, part = tid & 7, v0 = part * 16;
            f32x4 o[4]; float ss = 0.f;
#pragma unroll
            for (int j = 0; j < 4; ++j) { o[j] = *(LAS const f32x4*)(lds + HG_O + t * OP + (v0 + 4 * j) * 4); ss += (o[j].x * o[j].x + o[j].y * o[j].y) + (o[j].z * o[j].z + o[j].w * o[j].w); }
            ss += __shfl_xor(ss, 1); ss += __shfl_xor(ss, 2); ss += __shfl_xor(ss, 4);
            const float inv = 1.0f / sqrtf(ss * (1.0f / 128.0f) + EPS);
            const bf16* gp = p + (size_t)(m0 + t) * NIN0 + 3072 + h * 128 + v0;
            const v4u g0 = *(const v4u*)gp, g1 = *(const v4u*)(gp + 8);
            const float* gn = gain + h * 128 + v0;
            v4u w0, w1;
#pragma unroll
            for (int i = 0; i < 4; ++i) {
                const float ga = bflo(g0[i]), gb = bfhi(g0[i]), gc = bflo(g1[i]), gd = bfhi(g1[i]);
                const int e = 2 * i;
                const float oa = o[e >> 2][e & 3], ob = o[(e + 1) >> 2][(e + 1) & 3], oc = o[(8 + e) >> 2][(8 + e) & 3], od = o[(9 + e) >> 2][(9 + e) & 3];
                w0[i] = pk2(oa * inv * gn[e] * siluf_(ga), ob * inv * gn[e + 1] * siluf_(gb));
                w1[i] = pk2(oc * inv * gn[8 + e] * siluf_(gc), od * inv * gn[9 + e] * siluf_(gd));
            }
            bf16* yo = y + (size_t)(m0 + t) * 1024 + 512 + h * 128 + v0;
            *(v4u*)yo = w0; *(v4u*)(yo + 8) = w1;
        }
        __syncthreads();
    }
}

constexpr int SG_STAT = 0, SG_W = 1024, SG_V = 35840, SGVP = 528;
__device__ __forceinline__ void phase_sgu(const Args& a, LAS unsigned char* lds, int tid, int lane, int wave, int G) {
    const bf16* z = (const bf16*)(a.ws + WS_P); bf16* y = (bf16*)(a.ws + WS_H);
    const float* lng = a.in[14]; const float* lnb = a.in[15]; const float* ws = a.in[16]; const float* bs = a.in[17];
    const int fr = lane & 15, fq = lane >> 4;
    for (int unit = blockIdx.x; unit < 256; unit += G) {
        const int m0 = unit * 128;
        LAS float* stt = (LAS float*)(lds + SG_STAT);
        for (int r = wave; r < 128; r += 8) {
            const bf16* vr = z + (size_t)(m0 + r) * NIN1 + 1024 + lane * 8;
            const v4u a0 = *(const v4u*)vr, a1 = *(const v4u*)(vr + 512);
            float x[16];
#pragma unroll
            for (int i = 0; i < 4; ++i) { x[2 * i] = bflo(a0[i]); x[2 * i + 1] = bfhi(a0[i]); x[8 + 2 * i] = bflo(a1[i]); x[9 + 2 * i] = bfhi(a1[i]); }
            float s = 0.f;
#pragma unroll
            for (int i = 0; i < 16; ++i) s += x[i];
            const float mean = wave_sum(s) * (1.0f / 1024.0f);
            float q = 0.f;
#pragma unroll
            for (int i = 0; i < 16; ++i) { const float d = x[i] - mean; q += d * d; }
            const float rstd = 1.0f / sqrtf(wave_sum(q) * (1.0f / 1024.0f) + EPS);
            if (lane == 0) { stt[2 * r] = mean; stt[2 * r + 1] = rstd; }
        }
        __syncthreads();
        for (int g = 0; g < 4; ++g) {
            {
                const int t = tid >> 2, s0 = (tid & 3) * 32;
                const float* wr = ws + (size_t)g * 16384 + t * 128 + s0;
#pragma unroll
                for (int j = 0; j < 4; ++j) {
                    const f32x4 w0 = *(const f32x4*)(wr + 8 * j), w1 = *(const f32x4*)(wr + 8 * j + 4);
                    const int s = s0 + 8 * j;
                    v4u o;
                    o.x = pk2(s + 0 <= t ? w0.x : 0.f, s + 1 <= t ? w0.y : 0.f); o.y = pk2(s + 2 <= t ? w0.z : 0.f, s + 3 <= t ? w0.w : 0.f);
                    o.z = pk2(s + 4 <= t ? w1.x : 0.f, s + 5 <= t ? w1.y : 0.f); o.w = pk2(s + 6 <= t ? w1.z : 0.f, s + 7 <= t ? w1.w : 0.f);
                    *(LAS v4u*)(lds + SG_W + t * HP + s * 2) = o;
                }
            }
#pragma unroll 2
            for (int i = 0; i < 8; ++i) {
                const int id = tid + NT * i, s = id >> 5, dc = (id & 31) * 8, col = g * 256 + dc;
                const v4u vv = *(const v4u*)(z + (size_t)(m0 + s) * NIN1 + 1024 + col);
                const float mean = stt[2 * s], rstd = stt[2 * s + 1];
                const f32x4 g0 = *(const f32x4*)(lng + col), g1 = *(const f32x4*)(lng + col + 4), b0 = *(const f32x4*)(lnb + col), b1 = *(const f32x4*)(lnb + col + 4);
                v4u o;
                o.x = pk2((bflo(vv.x) - mean) * rstd * g0.x + b0.x, (bfhi(vv.x) - mean) * rstd * g0.y + b0.y);
                o.y = pk2((bflo(vv.y) - mean) * rstd * g0.z + b0.z, (bfhi(vv.y) - mean) * rstd * g0.w + b0.w);
                o.z = pk2((bflo(vv.z) - mean) * rstd * g1.x + b1.x, (bfhi(vv.z) - mean) * rstd * g1.y + b1.y);
                o.w = pk2((bflo(vv.w) - mean) * rstd * g1.z + b1.z, (bfhi(vv.w) - mean) * rstd * g1.w + b1.w);
                *(LAS v4u*)(lds + SG_V + s * SGVP + dc * 2) = o;
            }
            __syncthreads();
            f32x4 acc[16];
#pragma unroll
            for (int n = 0; n < 16; ++n) acc[n] = (f32x4){0.f, 0.f, 0.f, 0.f};
            for (int ks = 0; ks < 4; ++ks) {
                if (32 * ks > 16 * wave + 15) break;
                const bf16x8 A = rowfrag(lds + SG_W, HP, 16 * wave, 32 * ks, fr, fq);
#pragma unroll
                for (int n = 0; n < 16; ++n) acc[n] = MFMA16(A, trfrag(lds + SG_V, SGVP, 32 * ks, 16 * n, lane), acc[n]);
            }
#pragma unroll
            for (int r = 0; r < 4; ++r) {
                const int t = 16 * wave + 4 * fq + r; const float bsv = bs[g * 128 + t];
                const bf16* ur = z + (size_t)(m0 + t) * NIN1 + g * 256 + fr; bf16* yr = y + (size_t)(m0 + t) * 1024 + g * 256 + fr;
#pragma unroll
                for (int n = 0; n < 16; ++n) yr[16 * n] = f2bf((acc[n][r] + bsv) * bf2f(ur[16 * n]));
            }
            __syncthreads();
        }
    }
}

#ifndef MK_N_LAUNCHES
#define MK_N_LAUNCHES 1
#endif

__global__ void __launch_bounds__(512, 2) fwd(Args a) {
    extern __shared__ __attribute__((aligned(16))) unsigned char lds_raw[];
    LAS unsigned char* lds = (LAS unsigned char*)lds_raw;
    cg::grid_group grid = cg::this_grid();
    volatile LAS unsigned* MISC = (volatile LAS unsigned*)(lds + MISC_OFF);
    if (threadIdx.x < 16) MISC[threadIdx.x] = 0u;
    __syncthreads();
    const XcdBarrier xbar = xcd_barrier_post((unsigned*)(a.ws + WS_BAR), MISC + 8);
    const int lo = a.ph_lo, hi = a.ph_hi;
#define IN(k) (lo <= (k) && (k) < hi)
#ifndef DBL_MASK
#define DBL_MASK 0
#endif
#define REP(k) _Pragma("unroll 1") for (int rep_ = 0; rep_ <= ((DBL_MASK >> (k)) & 1); ++rep_)
#define SEAM(k) do { if (IN(k) && IN((k) + 1)) { if ((k) == 0) grid.sync(); else xcd_barrier(xbar); } } while (0)
#define PHASE_VARS int tid = threadIdx.x; asm volatile("" : "+v"(tid)); int G = gridDim.x; asm volatile("" : "+s"(G)); \
    const int lane = tid & 63, wave = __builtin_amdgcn_readfirstlane(tid >> 6); (void)lane; (void)wave; \
    bf16* const H = (bf16*)(a.ws + WS_H); bf16* const P = (bf16*)(a.ws + WS_P); const float* const modf = (const float*)(a.ws + WS_MODF); (void)H; (void)P; (void)modf;
#define GEMM_RES(ph, l, ffn) if (IN(ph)) REP(ph) { PHASE_VARS \
        const bf16* Bt = (ffn) ? (const bf16*)(a.ws + WS_WFF2) + (size_t)(l) * 1024 * 4096 : (const bf16*)(a.ws + ((l) ? WS_WOUT1 : WS_WOUT0)); \
        pg8::Gemm g{(ffn) ? P : H, Bt, M, 1024, (ffn) ? 4096 : 1024}; pg8::StaticOrder S; S.init(M, 1024, G, (int)blockIdx.x); \
        pg8::EpiResGate E{(ph) == 6 ? a.in[0] : a.out, a.out, modf + (size_t)(l) * 8 * 6144 + ((ffn) ? 5 : 2) * 1024}; \
        pg8::gemm_phase<pg8::EpiResGate, pg8::StaticOrder, true, true>(lds, g, S, E); } SEAM(ph);
#define GEMM_FF1(ph, l) if (IN(ph)) REP(ph) { PHASE_VARS \
        pg8::Gemm g{H, (const bf16*)(a.ws + WS_WFF1) + (size_t)(l) * 4096 * 1024, M, FF, 1024}; pg8::StaticOrder S; S.init(M, FF, G, (int)blockIdx.x); \
        pg8::EpiBf16<2> E{P, FF, nullptr}; \
        pg8::gemm_phase<pg8::EpiBf16<2>, pg8::StaticOrder, true, true>(lds, g, S, E); } SEAM(ph);
#define NORM(ph, l, ffn) if (IN(ph)) REP(ph) { PHASE_VARS \
        phase_norm<false>(a, a.out, ((ffn) ? a.in[5] : a.in[4]) + (l) * 1024, (l), (ffn) ? 3 : 0, (ffn) ? 4 : 1, tid, lane, wave, G); } SEAM(ph);

    if (IN(0)) REP(0) { PHASE_VARS phase_prologue(a, lds, tid, lane, wave, G); } SEAM(0);
    if (IN(1)) REP(1) { PHASE_VARS phase_norm<true>(a, a.in[0], a.in[4], 0, 0, 1, tid, lane, wave, G); } SEAM(1);
    if (IN(2)) REP(2) { PHASE_VARS
        pg8::Gemm g{H, (const bf16*)(a.ws + WS_WIN0), M, NIN0, 1024}; pg8::StaticOrder S; S.init(M, NIN0, G, (int)blockIdx.x);
        pg8::EpiBf16<0> E{P, NIN0, nullptr};
        pg8::gemm_phase<pg8::EpiBf16<0>, pg8::StaticOrder, true, true>(lds, g, S, E); } SEAM(2);
    if (IN(3)) REP(3) { PHASE_VARS conv_mixer(a, tid, G); hg_pass_a(a, lds, tid, lane, wave, G); } SEAM(3);
    if (IN(4)) REP(4) { PHASE_VARS hg_pass_b(a, tid, G); } SEAM(4);
    if (IN(5)) REP(5) { PHASE_VARS hg_pass_c(a, lds, tid, lane, wave, G); } SEAM(5);
    GEMM_RES(6, 0, false)
    NORM(7, 0, true)
    GEMM_FF1(8, 0)
    GEMM_RES(9, 0, true)
    NORM(10, 1, false)
    if (IN(11)) REP(11) { PHASE_VARS
        pg8::Gemm g{H, (const bf16*)(a.ws + WS_WIN1), M, NIN1, 1024}; pg8::StaticOrder S; S.init(M, NIN1, G, (int)blockIdx.x);
        pg8::EpiBf16<1> E{P, NIN1, a.in[13]};
        pg8::gemm_phase<pg8::EpiBf16<1>, pg8::StaticOrder, true, true>(lds, g, S, E); } SEAM(11);
    if (IN(12)) REP(12) { PHASE_VARS phase_sgu(a, lds, tid, lane, wave, G); } SEAM(12);
    GEMM_RES(13, 1, false)
    NORM(14, 1, true)
    GEMM_FF1(15, 1)
    GEMM_RES(16, 1, true)
    if (IN(17)) REP(17) { PHASE_VARS phase_final_norm(a, lane, wave, G); }
}
}

extern "C" void kernel_launch(void* const* d_in, const int* in_sizes, int n_in, void* d_out, int out_size, void* d_ws, size_t ws_size, hipStream_t stream) {
    using namespace mk;
    static int grid = 0;
    if (grid == 0) {
        if (n_in != 22 || out_size != M * D || ws_size < WS_END) { fprintf(stderr, "kernel_launch: unexpected shapes (n_in %d out %d ws %zu)\n", n_in, out_size, ws_size); grid = -1; return; }
        int dev = 0, cus = 0, per_cu = 0;
        (void)hipGetDevice(&dev); (void)hipDeviceGetAttribute(&cus, hipDeviceAttributeMultiprocessorCount, dev);
        if (hipFuncSetAttribute((const void*)fwd, hipFuncAttributeMaxDynamicSharedMemorySize, LDS_BYTES) != hipSuccess) fprintf(stderr, "kernel_launch: hipFuncSetAttribute failed\n");
        if (hipOccupancyMaxActiveBlocksPerMultiprocessor(&per_cu, (const void*)fwd, NT, LDS_BYTES) != hipSuccess || per_cu < 1) { fprintf(stderr, "kernel_launch: occupancy query says %d\n", per_cu); per_cu = 1; }
        (void)hipGetLastError();
        grid = cus * per_cu;
        if (grid <= 0) grid = 256;
    }
    if (grid < 0) return;
    if (hipMemsetAsync((char*)d_ws + WS_BAR, 0, BAR_ZERO_BYTES, stream) != hipSuccess) fprintf(stderr, "kernel_launch: memset of barrier words failed\n");
    Args a{};
    for (int i = 0; i < 22; ++i) a.in[i] = (const float*)d_in[i];
    a.out = (float*)d_out; a.ws = (unsigned char*)d_ws;
#if MK_N_LAUNCHES == 1
    a.ph_lo = 0; a.ph_hi = NPH;
    void* args[] = {&a};
    hipError_t e = hipLaunchCooperativeKernel((const void*)fwd, dim3(grid), dim3(NT), args, LDS_BYTES, stream);
    if (e != hipSuccess) fprintf(stderr, "cooperative launch failed: %s (grid %d)\n", hipGetErrorString(e), grid);
#else
    for (int ph = 0; ph < NPH; ++ph) {
        a.ph_lo = ph; a.ph_hi = ph + 1;
        hipLaunchKernelGGL(fwd, dim3(grid), dim3(NT), LDS_BYTES, stream, a);
    }
#endif
}
```

```cpp
#include <hip/hip_runtime.h>
#include <hip/hip_cooperative_groups.h>
#include <cstdio>
#include <cstdint>
namespace cg = cooperative_groups;
namespace pg8 {
#define PG8_LAS __attribute__((address_space(3)))
typedef unsigned short bf16_t;
typedef short bf16x8 __attribute__((ext_vector_type(8)));
typedef float f32x4 __attribute__((ext_vector_type(4)));
typedef unsigned u32x4 __attribute__((ext_vector_type(4)));
constexpr int BM = 256, BK = 64, HALF = 128, HTB = HALF * BK * 2  , STAGE_BYTES = 8 * HTB, NXCD = 8, WGM = 8;

__host__ __device__ __forceinline__ int lds_byte(int r, int c) { const int st = (r >> 4) * 2 + (c >> 5), rr = r & 15, cc = c & 31, ob = rr * 64 + cc * 2; return st * 1024 + (ob ^ (((ob >> 9) & 1) << 5)); }
__host__ __device__ __forceinline__ void stage_rc(int b, int& R, int& C) { const int st = b / 1024, sb = b % 1024, swz = sb ^ (((sb >> 9) & 1) << 5); R = (st >> 1) * 16 + swz / 64; C = (st & 1) * 32 + (swz % 64) / 2; }
__host__ __device__ __forceinline__ int perm32(int rho) { const int n = rho >> 4, i = rho & 15; return 8 * (i >> 2) + 4 * n + (i & 3); }

struct Unit { int pm, pn; };
struct Gemm { const bf16_t* A; const bf16_t* Bt; int M, N, K; };

struct StaticOrder {
    int nM, nN, nwg, G, c;
    __host__ __device__ void init(int M, int N, int G_, int c_) { nM = M / BM; nN = N / BM; nwg = nM * nN; G = G_; c = c_; }
    __host__ __device__ bool next(int i, Unit& u) const {
        const long L = (long)i * G + c; if (L >= nwg) return false;
        int wgid = (int)L; { const int q = nwg / NXCD, r = nwg % NXCD, xcd = wgid % NXCD, off = wgid / NXCD; wgid = (xcd < r ? xcd * (q + 1) : r * (q + 1) + (xcd - r) * q) + off; }
        const int nig = WGM * nN, gid = wgid / nig, fm = gid * WGM, gsz = (nM - fm) < WGM ? (nM - fm) : WGM;
        u.pm = fm + ((wgid % nig) % gsz); u.pn = (wgid % nig) / gsz; return true;
    }
    __device__ __forceinline__ void a_ready(const Unit&) const {}
    __device__ __forceinline__ void done(const Unit&) const {}
};

__device__ __forceinline__ unsigned cvt_pk_bf16(float lo, float hi) { unsigned r; asm volatile("v_cvt_pk_bf16_f32 %0, %1, %2" : "=v"(r) : "v"(lo), "v"(hi)); return r; }
typedef float f32x2 __attribute__((ext_vector_type(2)));
__device__ __forceinline__ float gelu_tanh(float x) {
    const float u = 0.7978845608f * (x + 0.044715f * x * x * x);
    const float e = __builtin_amdgcn_exp2f(-2.0f * 1.4426950408889634f * u);
    return x * __builtin_amdgcn_rcpf(1.0f + e);
}
template <int ACT> struct EpiBf16 {
    static constexpr bool PERM = true, AFTER_DRAIN = false;
    bf16_t* O; int ldc; const float* bias;
    __device__ __forceinline__ void operator()(const f32x4 (&acc)[2][2][4][2], const Unit& u, int wr, int wc, int fr, int fq) const {
        const int row0 = u.pm * BM + wr * 64 + fr; const int col0 = u.pn * BM + wc * 32 + 8 * fq;
        f32x4 bv[2][2];
#pragma unroll
        for (int bj = 0; bj < 2; ++bj)
#pragma unroll
            for (int n = 0; n < 2; ++n) bv[bj][n] = bias ? *(const f32x4*)(bias + col0 + bj * HALF + 4 * n) : (f32x4){0.f, 0.f, 0.f, 0.f};
#pragma unroll
        for (int ai = 0; ai < 2; ++ai)
#pragma unroll
            for (int m = 0; m < 4; ++m) { bf16_t* rowp = O + (size_t)(row0 + ai * HALF + m * 16) * ldc + col0;
#pragma unroll
                for (int bj = 0; bj < 2; ++bj) { f32x4 v0 = acc[ai][bj][m][0] + bv[bj][0], v1 = acc[ai][bj][m][1] + bv[bj][1];
                    if (ACT == 1) {
#pragma unroll
                        for (int i = 0; i < 4; ++i) { v0[i] = gelu_tanh(v0[i]); v1[i] = gelu_tanh(v1[i]); } }
                    if (ACT == 2) {
#pragma unroll
                        for (int i = 0; i < 4; ++i) { const float a = fmaxf(v0[i], 0.f), b = fmaxf(v1[i], 0.f); v0[i] = a * a; v1[i] = b * b; } }
                    u32x4 w; w.x = cvt_pk_bf16(v0[0], v0[1]); w.y = cvt_pk_bf16(v0[2], v0[3]); w.z = cvt_pk_bf16(v1[0], v1[1]); w.w = cvt_pk_bf16(v1[2], v1[3]);
                    *(u32x4*)(rowp + bj * HALF) = w; } }
    }
};
struct EpiResGate {
    static constexpr bool PERM = false, AFTER_DRAIN = false;
    const float* base; float* out; const float* gate;
    __device__ __forceinline__ void operator()(const f32x4 (&acc)[2][2][4][2], const Unit& u, int wr, int wc, int fr, int fq) const {
        const int row0 = u.pm * BM + wr * 64 + fr; const int col0 = u.pn * BM + wc * 32 + 4 * fq; const int b = u.pm >> 4;
        f32x4 gv[2][2];
#pragma unroll
        for (int bj = 0; bj < 2; ++bj)
#pragma unroll
            for (int n = 0; n < 2; ++n) gv[bj][n] = *(const f32x4*)(gate + (size_t)b * 6144 + col0 + bj * HALF + n * 16);
#pragma unroll
        for (int ai = 0; ai < 2; ++ai) {
            f32x4 bs[4][2][2];
#pragma unroll
            for (int m = 0; m < 4; ++m) { const size_t off = (size_t)(row0 + ai * HALF + m * 16) * 1024 + col0;
#pragma unroll
                for (int bj = 0; bj < 2; ++bj)
#pragma unroll
                    for (int n = 0; n < 2; ++n) bs[m][bj][n] = *(const f32x4*)(base + off + bj * HALF + n * 16); }
#pragma unroll
            for (int m = 0; m < 4; ++m) { const size_t off = (size_t)(row0 + ai * HALF + m * 16) * 1024 + col0;
#pragma unroll
                for (int bj = 0; bj < 2; ++bj)
#pragma unroll
                    for (int n = 0; n < 2; ++n) *(f32x4*)(out + off + bj * HALF + n * 16) = bs[m][bj][n] + gv[bj][n] * acc[ai][bj][m][n]; }
            asm volatile("" ::: "memory"); }
    }
};
template <bool BASE_F32> struct EpiResGateBf {
    static constexpr bool PERM = true, AFTER_DRAIN = false;
    const void* base; bf16_t* out; const float* gate;
    __device__ __forceinline__ void operator()(const f32x4 (&acc)[2][2][4][2], const Unit& u, int wr, int wc, int fr, int fq) const {
        const int row0 = u.pm * BM + wr * 64 + fr; const int col0 = u.pn * BM + wc * 32 + 8 * fq; const int b = u.pm >> 4;
        f32x4 gv[2][2];
#pragma unroll
        for (int bj = 0; bj < 2; ++bj)
#pragma unroll
            for (int n = 0; n < 2; ++n) gv[bj][n] = *(const f32x4*)(gate + (size_t)b * 6144 + col0 + bj * HALF + 4 * n);
#pragma unroll
        for (int ai = 0; ai < 2; ++ai) {
            f32x4 bs[4][2][2];
#pragma unroll
            for (int m = 0; m < 4; ++m) { const size_t off = (size_t)(row0 + ai * HALF + m * 16) * 1024 + col0;
#pragma unroll
                for (int bj = 0; bj < 2; ++bj) {
                    if (BASE_F32) { bs[m][bj][0] = *(const f32x4*)((const float*)base + off + bj * HALF); bs[m][bj][1] = *(const f32x4*)((const float*)base + off + bj * HALF + 4); }
                    else { const u32x4 w = *(const u32x4*)((const bf16_t*)base + off + bj * HALF);
                        bs[m][bj][0] = (f32x4){__builtin_bit_cast(float, w.x << 16), __builtin_bit_cast(float, w.x & 0xffff0000u), __builtin_bit_cast(float, w.y << 16), __builtin_bit_cast(float, w.y & 0xffff0000u)};
                        bs[m][bj][1] = (f32x4){__builtin_bit_cast(float, w.z << 16), __builtin_bit_cast(float, w.z & 0xffff0000u), __builtin_bit_cast(float, w.w << 16), __builtin_bit_cast(float, w.w & 0xffff0000u)}; } } }
#pragma unroll
            for (int m = 0; m < 4; ++m) { const size_t off = (size_t)(row0 + ai * HALF + m * 16) * 1024 + col0;
#pragma unroll
                for (int bj = 0; bj < 2; ++bj) { const f32x4 v0 = bs[m][bj][0] + gv[bj][0] * acc[ai][bj][m][0], v1 = bs[m][bj][1] + gv[bj][1] * acc[ai][bj][m][1];
                    u32x4 w; w.x = cvt_pk_bf16(v0[0], v0[1]); w.y = cvt_pk_bf16(v0[2], v0[3]); w.z = cvt_pk_bf16(v1[0], v1[1]); w.w = cvt_pk_bf16(v1[2], v1[3]);
                    *(u32x4*)(out + off + bj * HALF) = w; } }
            asm volatile("" ::: "memory"); }
    }
};
template <class Epi, class Sched, bool ALIGN_EPI = false, bool SP2 = false>
__device__ __forceinline__ void gemm_phase(PG8_LAS unsigned char* lds, const Gemm g, const Sched& S, const Epi& E) {
    const int tid = threadIdx.x, wid = __builtin_amdgcn_readfirstlane(tid >> 6), lane = tid & 63, wr = wid >> 2, wc = wid & 3, fr = lane & 15, fq = lane >> 4;
    const int K = g.K, nt = K / BK;
    unsigned voffA[2], voffB[2];
#pragma unroll
    for (int i = 0; i < 2; ++i) { int R, C; stage_rc(tid * 16 + i * 8192, R, C); const int Rb = Epi::PERM ? ((R & ~31) + perm32(R & 31)) : R;
        voffA[i] = (unsigned)(R * K + C) * 2u; voffB[i] = (unsigned)(Rb * K + C) * 2u; }
    const size_t kstep = (size_t)(BK * 2);
    const size_t hstep = (size_t)HALF * K * 2;
    const size_t tstep = 2 * hstep;
    const unsigned ldsw = (unsigned)wid * 1024u;
    const int aoff = lds_byte(wr * 64 + fr, fq * 8), boff = lds_byte(wc * 32 + fr, fq * 8);
#define PG8_SA(b, h) (((b) * 2 + (h)) * HTB)
#define PG8_SB(b, h) ((4 + (b) * 2 + (h)) * HTB)
#define PG8_STAGE(bufoff, gbase, voff) do { _Pragma("unroll") for (int _i = 0; _i < 2; ++_i) \
        __builtin_amdgcn_global_load_lds((const unsigned*)((const char*)(gbase) + (voff)[_i]), (PG8_LAS unsigned*)(lds + (bufoff) + ldsw + _i * 8192), 16, 0, 0); } while (0)
#define PG8_LDA(dst, b, h) do { _Pragma("unroll") for (int m = 0; m < 4; ++m) _Pragma("unroll") for (int k = 0; k < 2; ++k) dst[m][k] = *(const PG8_LAS bf16x8*)(lds + PG8_SA(b, h) + aoff + m * 2048 + k * 1024); } while (0)
#define PG8_LDB(dst, b, h) do { _Pragma("unroll") for (int n = 0; n < 2; ++n) _Pragma("unroll") for (int k = 0; k < 2; ++k) dst[n][k] = *(const PG8_LAS bf16x8*)(lds + PG8_SB(b, h) + boff + n * 2048 + k * 1024); } while (0)
#define PG8_MMA(ai, bj, At, Bt) do { __builtin_amdgcn_s_setprio(1); _Pragma("unroll") for (int m = 0; m < 4; ++m) _Pragma("unroll") for (int n = 0; n < 2; ++n) _Pragma("unroll") for (int k = 0; k < 2; ++k) \
        acc[ai][bj][m][n] = __builtin_amdgcn_mfma_f32_16x16x32_bf16(Bt[n][k], At[m][k], acc[ai][bj][m][n], 0, 0, 0); __builtin_amdgcn_s_setprio(0); } while (0)
#define PG8_WAIT_V(n) asm volatile("s_waitcnt vmcnt(" #n ")" ::: "memory")
#define PG8_WAIT_L(n) asm volatile("s_waitcnt lgkmcnt(" #n ")" ::: "memory")
#define PG8_BAR __builtin_amdgcn_s_barrier()
#define PG8_SCHED __builtin_amdgcn_sched_barrier(0)
    Unit cur, nxt; int ui = 0;
    if (!S.next(0, cur)) return;
    f32x4 acc[2][2][4][2];
#pragma unroll
    for (int a = 0; a < 2; ++a)
#pragma unroll
        for (int b = 0; b < 2; ++b)
#pragma unroll
            for (int m = 0; m < 4; ++m)
#pragma unroll
                for (int n = 0; n < 2; ++n) acc[a][b][m][n] = (f32x4){0.f, 0.f, 0.f, 0.f};
    bf16x8 At[4][2], B0[2][2], B1[2][2];
    const char* cA = (const char*)g.A + (size_t)cur.pm * tstep; const char* cB = (const char*)g.Bt + (size_t)cur.pn * tstep;
    S.a_ready(cur);
    if constexpr (SP2) {
        PG8_STAGE(PG8_SB(0, 0), cB, voffB); PG8_STAGE(PG8_SB(0, 1), cB + hstep, voffB); PG8_STAGE(PG8_SA(0, 0), cA, voffA); PG8_STAGE(PG8_SA(0, 1), cA + hstep, voffA);
        if (wr == 1) PG8_BAR;
        PG8_WAIT_V(2); PG8_BAR;
        PG8_STAGE(PG8_SB(1, 0), cB + kstep, voffB); PG8_STAGE(PG8_SA(1, 0), cA + kstep, voffA); PG8_STAGE(PG8_SB(1, 1), cB + hstep + kstep, voffB);
        PG8_WAIT_V(6); PG8_BAR;
    } else {
        PG8_STAGE(PG8_SB(0, 0), cB, voffB); PG8_STAGE(PG8_SA(0, 0), cA, voffA); PG8_STAGE(PG8_SB(0, 1), cB + hstep, voffB); PG8_STAGE(PG8_SA(0, 1), cA + hstep, voffA);
        if (wr == 1) PG8_BAR;
        PG8_WAIT_V(4); PG8_BAR;
        PG8_STAGE(PG8_SB(1, 0), cB + kstep, voffB); PG8_STAGE(PG8_SA(1, 0), cA + kstep, voffA); PG8_STAGE(PG8_SB(1, 1), cB + hstep + kstep, voffB);
        PG8_WAIT_V(6); PG8_BAR;
    }
    for (;;) {
        const bool has_next = S.next(ui + 1, nxt);
        const char* nA = has_next ? (const char*)g.A + (size_t)nxt.pm * tstep : cA; const char* nB = has_next ? (const char*)g.Bt + (size_t)nxt.pn * tstep : cB;
        for (int t = 0; t < nt; t += 2) {
            const bool last = (t == nt - 2);
            const char* a1 = cA + (size_t)(t + 1) * kstep;
            const char* a2 = last ? nA : cA + (size_t)(t + 2) * kstep; const char* b2 = last ? nB : cB + (size_t)(t + 2) * kstep;
            const char* a3 = a2 + kstep; const char* b3 = b2 + kstep;
            if (last && has_next) S.a_ready(nxt);
            if constexpr (SP2) {
            PG8_LDB(B0, 0, 0); PG8_LDB(B1, 0, 1); PG8_SCHED; PG8_LDA(At, 0, 0); PG8_STAGE(PG8_SA(1, 1), a1 + hstep, voffA);
            PG8_WAIT_V(8); PG8_WAIT_L(0); PG8_BAR; PG8_MMA(0, 0, At, B0); PG8_MMA(0, 1, At, B1); PG8_BAR; PG8_SCHED;
            PG8_LDA(At, 0, 1); PG8_STAGE(PG8_SB(0, 0), b2, voffB); PG8_STAGE(PG8_SB(0, 1), b2 + hstep, voffB); PG8_STAGE(PG8_SA(0, 0), a2, voffA);
            PG8_WAIT_V(8); PG8_WAIT_L(0); PG8_BAR; PG8_MMA(1, 0, At, B0); PG8_MMA(1, 1, At, B1); PG8_BAR; PG8_SCHED;
            PG8_LDB(B0, 1, 0); PG8_LDB(B1, 1, 1); PG8_SCHED; PG8_LDA(At, 1, 0); PG8_STAGE(PG8_SA(0, 1), a2 + hstep, voffA);
            PG8_WAIT_V(8); PG8_WAIT_L(0); PG8_BAR; PG8_MMA(0, 0, At, B0); PG8_MMA(0, 1, At, B1); PG8_BAR; PG8_SCHED;
            PG8_LDA(At, 1, 1); PG8_STAGE(PG8_SB(1, 0), b3, voffB); PG8_STAGE(PG8_SB(1, 1), b3 + hstep, voffB); PG8_STAGE(PG8_SA(1, 0), a3, voffA);
            PG8_WAIT_V(8); PG8_WAIT_L(0); PG8_BAR; PG8_MMA(1, 0, At, B0); PG8_MMA(1, 1, At, B1); PG8_BAR; PG8_SCHED;
            } else {
            PG8_LDB(B0, 0, 0); PG8_SCHED; PG8_LDA(At, 0, 0); PG8_STAGE(PG8_SA(1, 1), a1 + hstep, voffA);
            PG8_WAIT_L(8); PG8_BAR; PG8_WAIT_L(0); PG8_MMA(0, 0, At, B0); PG8_BAR; PG8_SCHED;
            PG8_LDB(B1, 0, 1); PG8_STAGE(PG8_SB(0, 0), b2, voffB);
            PG8_BAR; PG8_WAIT_L(0); PG8_MMA(0, 1, At, B1); PG8_BAR;
            PG8_LDA(At, 0, 1); PG8_STAGE(PG8_SA(0, 0), a2, voffA);
            PG8_BAR; PG8_WAIT_L(0); PG8_MMA(1, 0, At, B0); PG8_BAR; PG8_SCHED;
            PG8_STAGE(PG8_SB(0, 1), b2 + hstep, voffB);
            PG8_WAIT_V(6); PG8_BAR; PG8_MMA(1, 1, At, B1); PG8_BAR;
            PG8_LDB(B0, 1, 0); PG8_SCHED; PG8_LDA(At, 1, 0); PG8_STAGE(PG8_SA(0, 1), a2 + hstep, voffA);
            PG8_WAIT_L(8); PG8_BAR; PG8_WAIT_L(0); PG8_MMA(0, 0, At, B0); PG8_BAR; PG8_SCHED;
            PG8_LDB(B1, 1, 1); PG8_STAGE(PG8_SB(1, 0), b3, voffB);
            PG8_BAR; PG8_WAIT_L(0); PG8_MMA(0, 1, At, B1); PG8_BAR;
            PG8_LDA(At, 1, 1); PG8_STAGE(PG8_SA(1, 0), a3, voffA);
            PG8_BAR; PG8_WAIT_L(0); PG8_MMA(1, 0, At, B0); PG8_BAR; PG8_SCHED;
            PG8_STAGE(PG8_SB(1, 1), b3 + hstep, voffB);
            PG8_WAIT_V(6); PG8_BAR; PG8_MMA(1, 1, At, B1); PG8_BAR;
            }
        }
        if constexpr (ALIGN_EPI) { if (wr == 0) PG8_BAR; }
        if constexpr (!Epi::AFTER_DRAIN) { E(acc, cur, wr, wc, fr, fq); S.done(cur); }
        if (!has_next) break;
#pragma unroll
        for (int a = 0; a < 2; ++a)
#pragma unroll
            for (int b = 0; b < 2; ++b)
#pragma unroll
                for (int m = 0; m < 4; ++m)
#pragma unroll
                    for (int n = 0; n < 2; ++n) acc[a][b][m][n] = (f32x4){0.f, 0.f, 0.f, 0.f};
        cur = nxt; cA = nA; cB = nB; ++ui;
        if constexpr (ALIGN_EPI) { if (wr == 1) PG8_BAR; }
    }
    PG8_WAIT_V(0);
    if constexpr (!ALIGN_EPI) { if (wr == 0) PG8_BAR; }
    PG8_BAR;
    if constexpr (Epi::AFTER_DRAIN) { E.fused(acc, cur, wr, wc, fr, fq, lds, wid, lane); S.done(cur); }
#undef PG8_SA
#undef PG8_SB
#undef PG8_STAGE
#undef PG8_LDA
#undef PG8_LDB
#undef PG8_MMA
#undef PG8_WAIT_V
#undef PG8_WAIT_L
#undef PG8_BAR
#undef PG8_SCHED
}
}
namespace mk {
#define LAS __attribute__((address_space(3)))
typedef unsigned short bf16;
typedef short bf16x8 __attribute__((ext_vector_type(8)));
typedef short s16x4 __attribute__((ext_vector_type(4)));
typedef float f32x4 __attribute__((ext_vector_type(4)));
typedef unsigned v4u __attribute__((ext_vector_type(4)));
typedef unsigned v2u __attribute__((ext_vector_type(2)));

constexpr int BATCH = 8, SEQ = 4096, D = 1024, M = BATCH * SEQ, FF = 4096, NIN0 = 3584, NIN1 = 2048;
constexpr int NT = 512;
constexpr float EPS = 1e-6f;
constexpr size_t MiB = 1u << 20;
constexpr size_t WS_MODP = 440 * MiB;
constexpr int NCH = 16;
constexpr size_t WS_MODF = 3 * MiB;
constexpr size_t WS_DEC = 4 * MiB;
constexpr size_t WS_BAR = 5 * MiB, BAR_ZERO_BYTES = 16384;
constexpr int MISC_OFF = 131072;
constexpr size_t WS_WIN0 = 8 * MiB, WS_WOUT0 = 15 * MiB, WS_WIN1 = 17 * MiB, WS_WOUT1 = 21 * MiB, WS_WFF1 = 23 * MiB, WS_WFF2 = 39 * MiB;
constexpr size_t WS_H = 56 * MiB;
constexpr size_t WS_P = 120 * MiB;
constexpr size_t WS_S = 376 * MiB;
constexpr size_t WS_XR = 376 * MiB;
constexpr size_t WS_END = 448 * MiB;
constexpr int LDS_BYTES = 147456;
constexpr int NPH = 18;

struct Args { const float* in[22]; float* out; unsigned char* ws; int ph_lo, ph_hi; };

__device__ __forceinline__ float bf2f(unsigned u) { return __builtin_bit_cast(float, u << 16); }
__device__ __forceinline__ float bflo(unsigned w) { return __builtin_bit_cast(float, w << 16); }
__device__ __forceinline__ float bfhi(unsigned w) { return __builtin_bit_cast(float, w & 0xffff0000u); }
__device__ __forceinline__ unsigned pk2(float lo, float hi) { return pg8::cvt_pk_bf16(lo, hi); }
__device__ __forceinline__ unsigned short f2bf(float f) { return (unsigned short)(pg8::cvt_pk_bf16(f, 0.f) & 0xffffu); }
__device__ __forceinline__ float wave_sum(float v) {
#pragma unroll
    for (int o = 1; o < 64; o <<= 1) v += __shfl_xor(v, o);
    return v;
}
__device__ __forceinline__ float sigmoidf_(float x) { return __builtin_amdgcn_rcpf(1.0f + __expf(-x)); }
__device__ __forceinline__ float siluf_(float x) { return x * sigmoidf_(x); }

__device__ __forceinline__ bf16x8 rowfrag(LAS const unsigned char* T, int pitchB, int r0, int k0, int fr, int fq) {
    return *(LAS const bf16x8*)(T + (r0 + fr) * pitchB + (k0 + 8 * fq) * 2);
}
typedef short v4i16_t __attribute__((ext_vector_type(4)));
__device__ __forceinline__ bf16x8 trfrag(LAS const unsigned char* T, int pitchB, int k0, int n0, int lane) {
    const int g = lane >> 4, q = (lane & 15) >> 2, pp = lane & 3;
    LAS const unsigned char* p0 = T + (k0 + 8 * g + q) * pitchB + (n0 + 4 * pp) * 2;
    const v4i16_t a = __builtin_amdgcn_ds_read_tr16_b64_v4i16((LAS v4i16_t*)p0);
    const v4i16_t b = __builtin_amdgcn_ds_read_tr16_b64_v4i16((LAS v4i16_t*)(p0 + 4 * pitchB));
    return (bf16x8){a.x, a.y, a.z, a.w, b.x, b.y, b.z, b.w};
}
#define MFMA16(a, b, c) __builtin_amdgcn_mfma_f32_16x16x32_bf16((a), (b), (c), 0, 0, 0)

#define XB_TMO      128
#define XB_XCNT(j)  (256  + 64 * (j))
#define XB_XSUB(j)  (1280 + 64 * (j))
#define XB_XGEN(j)  (2304 + 64 * (j))
#define XB_TOP      3328
#define XB_TOPGEN   3392
#define XCD_BAR_WORDS 3456
#define XB_SPIN_CAP (1u << 18)

__device__ __forceinline__ unsigned xb_ld(unsigned* p)              { return __hip_atomic_load(p, __ATOMIC_RELAXED, __HIP_MEMORY_SCOPE_AGENT); }
__device__ __forceinline__ unsigned xb_add(unsigned* p, unsigned v) { return __hip_atomic_fetch_add(p, v, __ATOMIC_RELAXED, __HIP_MEMORY_SCOPE_AGENT); }
__device__ __forceinline__ unsigned xb_xcc_id() { return (unsigned)__builtin_amdgcn_s_getreg((3 << 11) | 20) & 0xFu; }
#define XB_SPIN(cond, bar) do { unsigned _sp = 0; while (cond) { __builtin_amdgcn_s_sleep(1); \
    if ((++_sp & 255u) == 0u) { if (xb_ld(&(bar)[XB_TMO])) break; if (_sp > XB_SPIN_CAP) { atomicAdd(&(bar)[XB_TMO], 1u); break; } } } } while (0)

struct XcdBarrier {
    unsigned* bar; unsigned x;
    volatile LAS unsigned* st;
};

__device__ __forceinline__ XcdBarrier xcd_barrier_post(unsigned* bar, volatile LAS unsigned* st) {
    XcdBarrier b; b.bar = bar; b.x = xb_xcc_id(); b.st = st;
    if (threadIdx.x == 0) (void)xb_add(&bar[XB_XCNT(b.x)], 1u);
    return b;
}
__device__ __forceinline__ void xcd_barrier_complete(unsigned* bar, unsigned x, unsigned& nloc, unsigned& nx) {
    const unsigned G = gridDim.x * gridDim.y * gridDim.z;
    unsigned sum, cnt, mine, sp = 0u;
    for (;;) {
        sum = 0u; cnt = 0u; mine = 0u;
#pragma unroll
        for (unsigned j = 0; j < 16; ++j) { const unsigned c = xb_ld(&bar[XB_XCNT(j)]); sum += c; cnt += (c > 0u) ? 1u : 0u; mine = (j == x) ? c : mine; }
        if (sum == G) break;
        __builtin_amdgcn_s_sleep(1);
        if ((++sp & 255u) == 0u) { if (xb_ld(&bar[XB_TMO])) break; if (sp > XB_SPIN_CAP) { atomicAdd(&bar[XB_TMO], 1u); break; } }
    }
    nloc = mine > 0u ? mine : 1u; nx = cnt > 0u ? cnt : 1u;
}

__device__ __forceinline__ void xcd_barrier(const XcdBarrier& b) {
    asm volatile("s_waitcnt vmcnt(0)" ::: "memory");
    __syncthreads();
    if (threadIdx.x == 0) {
        unsigned* bar = b.bar;
        __builtin_amdgcn_s_waitcnt(0);
        unsigned nloc = b.st[0], nx = b.st[1];
        if (nloc == 0u) { xcd_barrier_complete(bar, b.x, nloc, nx); b.st[0] = nloc; b.st[1] = nx; }
        const unsigned old = xb_add(&bar[XB_XSUB(b.x)], 1u);
        const unsigned gen = old / nloc;
        if (old + 1u == (gen + 1u) * nloc) {
            __builtin_amdgcn_fence(__ATOMIC_RELEASE, "agent");
            asm volatile("s_waitcnt vmcnt(0)" ::: "memory");
            const unsigned og = xb_add(&bar[XB_TOP], 1u);
            const unsigned tg = og / nx;
            if (og + 1u == (tg + 1u) * nx) xb_add(&bar[XB_TOPGEN], 1u);
            else XB_SPIN(xb_ld(&bar[XB_TOPGEN]) == tg, bar);
            __builtin_amdgcn_fence(__ATOMIC_ACQUIRE, "agent");
            xb_add(&bar[XB_XGEN(b.x)], 1u);
            asm volatile("s_waitcnt vmcnt(0)" ::: "memory");
        } else {
            XB_SPIN(xb_ld(&bar[XB_XGEN(b.x)]) == gen, bar);
            __builtin_amdgcn_fence(__ATOMIC_ACQUIRE, "agent");
            asm volatile("s_waitcnt vmcnt(0)" ::: "memory");
        }
    }
    __syncthreads();
}

__device__ __forceinline__ void transpose_item(const float* W, int K, int N, bf16* WT, LAS float* scr, int item, int lane) {
    const int nblk = N / 32, kb = item / nblk, nb = item % nblk, k0 = 64 * kb, n0 = 32 * nb;
    float tv[32];
#pragma unroll
    for (int i = 0; i < 32; ++i) tv[i] = W[(size_t)(k0 + 2 * i + (lane >> 5)) * N + n0 + (lane & 31)];
#pragma unroll
    for (int i = 0; i < 32; ++i) scr[(2 * i + (lane >> 5)) * 33 + (lane & 31)] = tv[i];
    asm volatile("s_waitcnt lgkmcnt(0)" ::: "memory");
    const int c = lane & 7;
#pragma unroll
    for (int j = 0; j < 4; ++j) { const int n = (lane >> 3) + 8 * j; const LAS float* s = scr + (8 * c) * 33 + n;
        v4u o; o.x = pk2(s[0 * 33], s[1 * 33]); o.y = pk2(s[2 * 33], s[3 * 33]); o.z = pk2(s[4 * 33], s[5 * 33]); o.w = pk2(s[6 * 33], s[7 * 33]);
        *(v4u*)(WT + (size_t)(n0 + n) * K + k0 + 8 * c) = o; }
    asm volatile("s_waitcnt lgkmcnt(0)" ::: "memory");
}
__device__ __forceinline__ void phase_prologue(const Args& a, LAS unsigned char* lds, int tid, int lane, int wave, int G) {
    LAS float* sc = (LAS float*)lds;
    const float* c = a.in[1];
    for (int i = tid; i < 8192; i += NT) sc[i] = siluf_(c[i]);
    __syncthreads();
    float* modp = (float*)(a.ws + WS_MODP);
    for (int it = blockIdx.x; it < 2 * NCH * 12; it += G) {
        const int l = it / (NCH * 12), r = it % (NCH * 12), ch = r / 12, eb = r % 12, e = eb * 512 + tid;
        const float* w = a.in[2] + ((size_t)l * 1024 + ch * 64) * 6144 + e;
        float acc0 = 0.f, acc1 = 0.f, acc2 = 0.f, acc3 = 0.f, acc4 = 0.f, acc5 = 0.f, acc6 = 0.f, acc7 = 0.f;
        const LAS float* s = sc + ch * 64;
#pragma unroll 16
        for (int d = 0; d < 64; ++d) { const float wv = w[(size_t)d * 6144];
            acc0 += s[d] * wv; acc1 += s[1024 + d] * wv; acc2 += s[2048 + d] * wv; acc3 += s[3072 + d] * wv;
            acc4 += s[4096 + d] * wv; acc5 += s[5120 + d] * wv; acc6 += s[6144 + d] * wv; acc7 += s[7168 + d] * wv; }
        float* o = modp + (size_t)((ch * 2 + l) * 8) * 6144 + e;
        o[0] = acc0; o[6144] = acc1; o[2 * 6144] = acc2; o[3 * 6144] = acc3; o[4 * 6144] = acc4; o[5 * 6144] = acc5; o[6 * 6144] = acc6; o[7 * 6144] = acc7;
    }
    __syncthreads();
    LAS float* scr = (LAS float*)(lds + 32768 + wave * 8704);
    const int gw = blockIdx.x * 8 + wave, NGW = G * 8;
    constexpr int I0 = 1792, I1 = 512, I2 = 1024, I3 = 512, I4 = 2048, I5 = 2048;
    constexpr int NITEMS = I0 + I1 + I2 + I3 + 2 * I4 + 2 * I5;
    for (int it = gw; it < NITEMS; it += NGW) {
        int r = it;
        if (r < I0) { transpose_item(a.in[6], 1024, NIN0, (bf16*)(a.ws + WS_WIN0), scr, r, lane); continue; } r -= I0;
        if (r < I1) { transpose_item(a.in[11], 1024, 1024, (bf16*)(a.ws + WS_WOUT0), scr, r, lane); continue; } r -= I1;
        if (r < I2) { transpose_item(a.in[12], 1024, NIN1, (bf16*)(a.ws + WS_WIN1), scr, r, lane); continue; } r -= I2;
        if (r < I3) { transpose_item(a.in[18], 1024, 1024, (bf16*)(a.ws + WS_WOUT1), scr, r, lane); continue; } r -= I3;
        if (r < 2 * I4) { const int l = r / I4; transpose_item(a.in[19] + (size_t)l * 1024 * 4096, 1024, 4096, (bf16*)(a.ws + WS_WFF1) + (size_t)l * 4096 * 1024, scr, r % I4, lane); continue; } r -= 2 * I4;
        { const int l = r / I5; transpose_item(a.in[20] + (size_t)l * 4096 * 1024, 4096, 1024, (bf16*)(a.ws + WS_WFF2) + (size_t)l * 1024 * 4096, scr, r % I5, lane); }
    }
}

template <bool PARTIAL>
__device__ __forceinline__ float modval(const Args& a, int l, int b, int idx) {
    if (PARTIAL) {
        const float* modp = (const float*)(a.ws + WS_MODP);
        float s = a.in[3][l * 6144 + idx];
#pragma unroll
        for (int ch = 0; ch < NCH; ++ch) s += modp[(size_t)((ch * 2 + l) * 8 + b) * 6144 + idx];
        return s;
    } else {
        return ((const float*)(a.ws + WS_MODF))[(size_t)(l * 8 + b) * 6144 + idx];
    }
}
template <bool PARTIAL>
__device__ __forceinline__ void phase_norm(const Args& a, const float* xsrc, const float* gvec, int l, int jshift, int jscale, int tid, int lane, int wave, int G) {
    bf16* h = (bf16*)(a.ws + WS_H);
    if (PARTIAL) {
        float* modf = (float*)(a.ws + WS_MODF);
        for (int i = blockIdx.x * NT + tid; i < 2 * 8 * 6144; i += G * NT) { const int ll = i / 49152, bb = (i / 6144) % 8, idx = i % 6144; modf[i] = modval<true>(a, ll, bb, idx); }
    }
    for (int blk = blockIdx.x; blk < 256; blk += G) {
        const int b = blk >> 5;
        f32x4 gs[4], sh[4];
#pragma unroll
        for (int j = 0; j < 4; ++j) { const int col = lane * 4 + 256 * j;
#pragma unroll
            for (int i = 0; i < 4; ++i) { gs[j][i] = gvec[col + i] * (1.0f + modval<PARTIAL>(a, l, b, jscale * 1024 + col + i)); sh[j][i] = modval<PARTIAL>(a, l, b, jshift * 1024 + col + i); } }
        const float* xb = xsrc + (size_t)blk * 128 * 1024;
        f32x4 nx[4];
#pragma unroll
        for (int j = 0; j < 4; ++j) nx[j] = ((const f32x4*)(xb + (size_t)wave * 1024) + lane)[64 * j];
        for (int r = wave; r < 128; r += 8) {
            const size_t m = (size_t)blk * 128 + r;
            f32x4 v[4]; float ss = 0.f;
#pragma unroll
            for (int j = 0; j < 4; ++j) { v[j] = nx[j]; ss += (v[j].x * v[j].x + v[j].y * v[j].y) + (v[j].z * v[j].z + v[j].w * v[j].w); }
            if (r + 8 < 128) {
#pragma unroll
                for (int j = 0; j < 4; ++j) nx[j] = ((const f32x4*)(xb + (size_t)(r + 8) * 1024) + lane)[64 * j];
            }
            const float inv = 1.0f / sqrtf(wave_sum(ss) * (1.0f / 1024.0f) + EPS);
            v2u* o8 = (v2u*)(h + m * 1024) + lane;
#pragma unroll
            for (int j = 0; j < 4; ++j) { const f32x4 o = v[j] * inv * gs[j] + sh[j]; v2u w; w.x = pk2(o.x, o.y); w.y = pk2(o.z, o.w); o8[64 * j] = w; }
        }
    }
}
__device__ __forceinline__ void unpack8(const v4u w, float (&x)[16], int o) {
#pragma unroll
    for (int i = 0; i < 4; ++i) { x[o + 2 * i] = bflo(w[i]); x[o + 2 * i + 1] = bfhi(w[i]); }
}
__device__ __forceinline__ void phase_norm_bf(const Args& a, const float* gvec, int l, int jshift, int jscale, int tid, int lane, int wave, int G) {
    bf16* h = (bf16*)(a.ws + WS_H); const bf16* xr = (const bf16*)(a.ws + WS_XR);
    for (int blk = blockIdx.x; blk < 256; blk += G) {
        const int b = blk >> 5;
        float gs[16], sh[16];
#pragma unroll
        for (int j = 0; j < 2; ++j)
#pragma unroll
            for (int i = 0; i < 8; ++i) { const int col = lane * 8 + 512 * j + i; gs[8 * j + i] = gvec[col] * (1.0f + modval<false>(a, l, b, jscale * 1024 + col)); sh[8 * j + i] = modval<false>(a, l, b, jshift * 1024 + col); }
        const bf16* xb = xr + (size_t)blk * 128 * 1024 + lane * 8;
        v4u n0 = *(const v4u*)(xb + (size_t)wave * 1024), n1 = *(const v4u*)(xb + (size_t)wave * 1024 + 512);
        for (int r = wave; r < 128; r += 8) {
            float x[16]; unpack8(n0, x, 0); unpack8(n1, x, 8);
            if (r + 8 < 128) { n0 = *(const v4u*)(xb + (size_t)(r + 8) * 1024); n1 = *(const v4u*)(xb + (size_t)(r + 8) * 1024 + 512); }
            float ss = 0.f;
#pragma unroll
            for (int i = 0; i < 16; ++i) ss += x[i] * x[i];
            const float inv = 1.0f / sqrtf(wave_sum(ss) * (1.0f / 1024.0f) + EPS);
            bf16* ho = h + ((size_t)blk * 128 + r) * 1024 + lane * 8;
#pragma unroll
            for (int j = 0; j < 2; ++j) { v4u w;
#pragma unroll
                for (int i = 0; i < 4; ++i) w[i] = pk2(x[8 * j + 2 * i] * inv * gs[8 * j + 2 * i] + sh[8 * j + 2 * i], x[8 * j + 2 * i + 1] * inv * gs[8 * j + 2 * i + 1] + sh[8 * j + 2 * i + 1]);
                *(v4u*)(ho + 512 * j) = w; }
        }
    }
}
__device__ __forceinline__ void phase_final_norm(const Args& a, int lane, int wave, int G) {
    const float* g = a.in[21]; const bf16* xr = (const bf16*)(a.ws + WS_XR);
    float gs[16];
#pragma unroll
    for (int j = 0; j < 2; ++j)
#pragma unroll
        for (int i = 0; i < 8; ++i) gs[8 * j + i] = g[lane * 8 + 512 * j + i];
    int m = blockIdx.x * 8 + wave;
    v4u n0 = (v4u){0u, 0u, 0u, 0u}, n1 = n0;
    if (m < M) { n0 = *(const v4u*)(xr + (size_t)m * 1024 + lane * 8); n1 = *(const v4u*)(xr + (size_t)m * 1024 + lane * 8 + 512); }
    for (; m < M; m += G * 8) {
        float x[16]; unpack8(n0, x, 0); unpack8(n1, x, 8);
        if (m + G * 8 < M) { n0 = *(const v4u*)(xr + (size_t)(m + G * 8) * 1024 + lane * 8); n1 = *(const v4u*)(xr + (size_t)(m + G * 8) * 1024 + lane * 8 + 512); }
        float ss = 0.f;
#pragma unroll
        for (int i = 0; i < 16; ++i) ss += x[i] * x[i];
        const float inv = 1.0f / sqrtf(wave_sum(ss) * (1.0f / 1024.0f) + EPS);
        float* o = a.out + (size_t)m * 1024 + lane * 8;
#pragma unroll
        for (int j = 0; j < 2; ++j) {
            *(f32x4*)(o + 512 * j) = (f32x4){x[8 * j] * inv * gs[8 * j], x[8 * j + 1] * inv * gs[8 * j + 1], x[8 * j + 2] * inv * gs[8 * j + 2], x[8 * j + 3] * inv * gs[8 * j + 3]};
            *(f32x4*)(o + 512 * j + 4) = (f32x4){x[8 * j + 4] * inv * gs[8 * j + 4], x[8 * j + 5] * inv * gs[8 * j + 5], x[8 * j + 6] * inv * gs[8 * j + 6], x[8 * j + 7] * inv * gs[8 * j + 7]};
        }
    }
}

__device__ __forceinline__ void conv_mixer(const Args& a, int tid, int G) {
    const bf16* p = (const bf16*)(a.ws + WS_P); bf16* y = (bf16*)(a.ws + WS_H);
    const float* cw = a.in[7]; const float* cb = a.in[8];
    for (int it = blockIdx.x * NT + tid; it < M * 64; it += G * NT) {
        const int m = it >> 6, c0 = (it & 63) * 8, t = m & (SEQ - 1);
        const bf16* pr = p + (size_t)m * NIN0 + c0;
        float conv[8];
#pragma unroll
        for (int i = 0; i < 8; ++i) conv[i] = cb[c0 + i];
#pragma unroll
        for (int tap = 0; tap < 3; ++tap) {
            const int dt = 2 - tap;
            if (t - dt >= 0) {
                const v4u cc = *(const v4u*)(pr - (size_t)dt * NIN0 + 512), hh = *(const v4u*)(pr - (size_t)dt * NIN0 + 1024);
#pragma unroll
                for (int i = 0; i < 4; ++i) {
                    conv[2 * i] += cw[tap * 512 + c0 + 2 * i] * (bflo(cc[i]) * bflo(hh[i]));
                    conv[2 * i + 1] += cw[tap * 512 + c0 + 2 * i + 1] * (bfhi(cc[i]) * bfhi(hh[i]));
                }
            }
        }
        const v4u bb = *(const v4u*)pr;
        v4u o;
#pragma unroll
        for (int i = 0; i < 4; ++i) o[i] = pk2(bflo(bb[i]) * conv[2 * i], bfhi(bb[i]) * conv[2 * i + 1]);
        *(v4u*)(y + (size_t)m * 1024 + c0) = o;
    }
}
constexpr int HP = 272;
constexpr int HG_SEG = 0, HG_QD = 2048, HG_QR = 19456, HG_KR = 36864, HG_V = 54272, HG_S = 71680, HG_P = 106496, HG_O = 19456;
constexpr int PP = 144;
constexpr int OP = 528;
__device__ __forceinline__ void hg_cum(const Args& a, LAS unsigned char* lds, int tid, int m0, int h, float (&cum)[16], float (&kk)[16], float& mid, float& last) {
    const int k = tid & 127, seg = tid >> 7, ch = h * 128 + k;
    const float* lbp = a.in[9];
    const float l0 = lbp[ch], l1 = lbp[512 + ch], l2 = lbp[1024 + ch], mx = fmaxf(l0, fmaxf(l1, l2));
    const float e0 = __expf(l0 - mx), e1 = __expf(l1 - mx), e2 = __expf(l2 - mx), lb = e0 / (e0 + e1 + e2);
    const bf16* p = (const bf16*)(a.ws + WS_P) + (size_t)(m0 + seg * 16) * NIN0 + 2048 + ch;
    float run = 0.f;
#pragma unroll
    for (int i = 0; i < 16; ++i) { const float x = bf2f(p[(size_t)i * NIN0]); const float f = lb + (1.0f - lb) * sigmoidf_(x); run += __logf(f); cum[i] = run; kk[i] = 1.0f - f; }
    LAS float* st = (LAS float*)(lds + HG_SEG);
    st[seg * 128 + k] = run;
    __syncthreads();
    const float s0 = st[k], s1 = st[128 + k], s2 = st[256 + k], s3 = st[384 + k];
    const float off = seg == 0 ? 0.f : (seg == 1 ? s0 : (seg == 2 ? s0 + s1 : s0 + s1 + s2));
    mid = s0 + s1; last = (s0 + s1) + (s2 + s3);
#pragma unroll
    for (int i = 0; i < 16; ++i) cum[i] += off;
}
__device__ __forceinline__ void load_tile128(LAS unsigned char* dst, const bf16* src, size_t src_pitch, int rows, int tid) {
    for (int id = tid; id < rows * 16; id += NT) { const int r = id >> 4, c = id & 15; *(LAS v4u*)(dst + r * HP + c * 16) = *(const v4u*)(src + (size_t)r * src_pitch + c * 8); }
}
__device__ __forceinline__ void hg_pass_a(const Args& a, LAS unsigned char* lds, int tid, int lane, int wave, int G) {
    const bf16* p = (const bf16*)(a.ws + WS_P);
    float* loc = a.out; float* dec = (float*)(a.ws + WS_DEC);
    for (int unit = blockIdx.x; unit < 2048; unit += G) {
        const int b = unit >> 8, h = (unit >> 6) & 3, c = unit & 63, m0 = b * SEQ + c * 64;
        float cum[16], kk[16], mid, last;
        hg_cum(a, lds, tid, m0, h, cum, kk, mid, last);
        const int k = tid & 127, seg = tid >> 7;
#pragma unroll
        for (int i = 0; i < 16; ++i) *(LAS unsigned short*)(lds + HG_KR + (seg * 16 + i) * HP + k * 2) = f2bf(kk[i] * __expf(last - cum[i]));
        if (seg == 0) dec[unit * 128 + k] = __expf(last);
        load_tile128(lds + HG_V, p + (size_t)m0 * NIN0 + 2560 + h * 128, NIN0, 64, tid);
        __syncthreads();
        f32x4 acc[8];
#pragma unroll
        for (int n = 0; n < 8; ++n) acc[n] = (f32x4){0.f, 0.f, 0.f, 0.f};
#pragma unroll
        for (int ks = 0; ks < 2; ++ks) {
            const bf16x8 A = trfrag(lds + HG_KR, HP, 32 * ks, 16 * wave, lane);
#pragma unroll
            for (int n = 0; n < 8; ++n) { const bf16x8 B = trfrag(lds + HG_V, HP, 32 * ks, 16 * n, lane); acc[n] = MFMA16(A, B, acc[n]); }
        }
        const int fr = lane & 15, fq = lane >> 4;
        float* lo = loc + (size_t)unit * 16384 + (16 * wave + 4 * fq) * 128 + fr;
#pragma unroll
        for (int n = 0; n < 8; ++n)
#pragma unroll
            for (int r = 0; r < 4; ++r) lo[r * 128 + 16 * n] = acc[n][r];
        __syncthreads();
    }
}
__device__ __forceinline__ void hg_pass_b(const Args& a, int tid, int G) {
    const float* loc = a.out; const float* dec = (const float*)(a.ws + WS_DEC); bf16* st = (bf16*)(a.ws + WS_S);
    for (int idx = blockIdx.x * NT + tid; idx < 32 * 128 * 32; idx += G * NT) {
        const int bh = idx >> 12, k = (idx >> 5) & 127, v4 = idx & 31;
        f32x4 S = (f32x4){0.f, 0.f, 0.f, 0.f};
        const size_t e0 = (size_t)bh * 64 * 16384 + k * 128 + v4 * 4;
#pragma unroll 8
        for (int c = 0; c < 64; ++c) {
            const f32x4 L = *(const f32x4*)(loc + e0 + (size_t)c * 16384); const float d = dec[(bh * 64 + c) * 128 + k];
            v2u w; w.x = pk2(S.x, S.y); w.y = pk2(S.z, S.w);
            *(v2u*)(st + e0 + (size_t)c * 16384) = w;
            S = S * d + L;
        }
    }
}
__device__ __forceinline__ void hg_pass_c(const Args& a, LAS unsigned char* lds, int tid, int lane, int wave, int G) {
    const bf16* p = (const bf16*)(a.ws + WS_P); const bf16* stg = (const bf16*)(a.ws + WS_S); bf16* y = (bf16*)(a.ws + WS_H);
    const float* gain = a.in[10];
    const int fr = lane & 15, fq = lane >> 4;
    for (int unit = blockIdx.x; unit < 2048; unit += G) {
        const int b = unit >> 8, h = (unit >> 6) & 3, c = unit & 63, m0 = b * SEQ + c * 64;
        {
            float cum[16], kk[16], mid, last;
            hg_cum(a, lds, tid, m0, h, cum, kk, mid, last);
            const int k = tid & 127, seg = tid >> 7;
            const bf16* qp = p + (size_t)(m0 + seg * 16) * NIN0 + 1536 + h * 128 + k;
#pragma unroll
            for (int i = 0; i < 16; ++i) {
                const float q = bf2f(qp[(size_t)i * NIN0]);
                const int o = (seg * 16 + i) * HP + k * 2;
                *(LAS unsigned short*)(lds + HG_QD + o) = f2bf(q * __expf(cum[i]));
                *(LAS unsigned short*)(lds + HG_QR + o) = f2bf(q * __expf(fminf(cum[i] - mid, 80.f)));
                *(LAS unsigned short*)(lds + HG_KR + o) = f2bf(kk[i] * __expf(fminf(mid - cum[i], 80.f)));
            }
        }
        load_tile128(lds + HG_V, p + (size_t)m0 * NIN0 + 2560 + h * 128, NIN0, 64, tid);
        load_tile128(lds + HG_S, stg + (size_t)unit * 16384, 128, 128, tid);
        __syncthreads();
        {
            const int tt = wave >> 1;
#pragma unroll
            for (int j = 0; j < 2; ++j) {
                const int stl = (wave & 1) * 2 + j;
                f32x4 sc = (f32x4){0.f, 0.f, 0.f, 0.f};
                if (stl <= tt) {
#pragma unroll
                    for (int ks = 0; ks < 4; ++ks) sc = MFMA16(rowfrag(lds + HG_QR, HP, 16 * tt, 32 * ks, fr, fq), rowfrag(lds + HG_KR, HP, 16 * stl, 32 * ks, fr, fq), sc);
                }
#pragma unroll
                for (int r = 0; r < 4; ++r) { const int t = 16 * tt + 4 * fq + r, s = 16 * stl + fr;
                    *(LAS unsigned short*)(lds + HG_P + t * PP + s * 2) = f2bf(s <= t ? sc[r] : 0.f); }
            }
        }
        __syncthreads();
        {
            const int tt = wave >> 1, n0 = (wave & 1) * 4;
            f32x4 acc[4];
#pragma unroll
            for (int n = 0; n < 4; ++n) acc[n] = (f32x4){0.f, 0.f, 0.f, 0.f};
#pragma unroll
            for (int ks = 0; ks < 4; ++ks) { const bf16x8 A = rowfrag(lds + HG_QD, HP, 16 * tt, 32 * ks, fr, fq);
#pragma unroll
                for (int n = 0; n < 4; ++n) acc[n] = MFMA16(A, trfrag(lds + HG_S, HP, 32 * ks, 16 * (n0 + n), lane), acc[n]); }
#pragma unroll
            for (int ks = 0; ks < 2; ++ks) { const bf16x8 A = rowfrag(lds + HG_P, PP, 16 * tt, 32 * ks, fr, fq);
#pragma unroll
                for (int n = 0; n < 4; ++n) acc[n] = MFMA16(A, trfrag(lds + HG_V, HP, 32 * ks, 16 * (n0 + n), lane), acc[n]); }
#pragma unroll
            for (int n = 0; n < 4; ++n)
#pragma unroll
                for (int r = 0; r < 4; ++r) *(LAS float*)(lds + HG_O + (16 * tt + 4 * fq + r) * OP + (16 * (n0 + n) + fr) * 4) = acc[n][r];
        }
        __syncthreads();
        {
            const int t = tid >> 3, part = tid & 7, v0 = part * 16;
            f32x4 o[4]; float ss = 0.f;
#pragma unroll
            for (int j = 0; j < 4; ++j) { o[j] = *(LAS const f32x4*)(lds + HG_O + t * OP + (v0 + 4 * j) * 4); ss += (o[j].x * o[j].x + o[j].y * o[j].y) + (o[j].z * o[j].z + o[j].w * o[j].w); }
            ss += __shfl_xor(ss, 1); ss += __shfl_xor(ss, 2); ss += __shfl_xor(ss, 4);
            const float inv = 1.0f / sqrtf(ss * (1.0f / 128.0f) + EPS);
            const bf16* gp = p + (size_t)(m0 + t) * NIN0 + 3072 + h * 128 + v0;
            const v4u g0 = *(const v4u*)gp, g1 = *(const v4u*)(gp + 8);
            const float* gn = gain + h * 128 + v0;
            v4u w0, w1;
#pragma unroll
            for (int i = 0; i < 4; ++i) {
                const float ga = bflo(g0[i]), gb = bfhi(g0[i]), gc = bflo(g1[i]), gd = bfhi(g1[i]);
                const int e = 2 * i;
                const float oa = o[e >> 2][e & 3], ob = o[(e + 1) >> 2][(e + 1) & 3], oc = o[(8 + e) >> 2][(8 + e) & 3], od = o[(9 + e) >> 2][(9 + e) & 3];
                w0[i] = pk2(oa * inv * gn[e] * siluf_(ga), ob * inv * gn[e + 1] * siluf_(gb));
                w1[i] = pk2(oc * inv * gn[8 + e] * siluf_(gc), od * inv * gn[9 + e] * siluf_(gd));
            }
            bf16* yo = y + (size_t)(m0 + t) * 1024 + 512 + h * 128 + v0;
            *(v4u*)yo = w0; *(v4u*)(yo + 8) = w1;
        }
        __syncthreads();
    }
}

constexpr int SG_STAT = 0, SG_W = 1024, SG_V = 35840, SGVP = 528;
__device__ __forceinline__ void phase_sgu(const Args& a, LAS unsigned char* lds, int tid, int lane, int wave, int G) {
    const bf16* z = (const bf16*)(a.ws + WS_P); bf16* y = (bf16*)(a.ws + WS_H);
    const float* lng = a.in[14]; const float* lnb = a.in[15]; const float* ws = a.in[16]; const float* bs = a.in[17];
    const int fr = lane & 15, fq = lane >> 4;
    for (int unit = blockIdx.x; unit < 256; unit += G) {
        const int m0 = unit * 128;
        LAS float* stt = (LAS float*)(lds + SG_STAT);
        for (int r = wave; r < 128; r += 8) {
            const bf16* vr = z + (size_t)(m0 + r) * NIN1 + 1024 + lane * 8;
            const v4u a0 = *(const v4u*)vr, a1 = *(const v4u*)(vr + 512);
            float x[16];
#pragma unroll
            for (int i = 0; i < 4; ++i) { x[2 * i] = bflo(a0[i]); x[2 * i + 1] = bfhi(a0[i]); x[8 + 2 * i] = bflo(a1[i]); x[9 + 2 * i] = bfhi(a1[i]); }
            float s = 0.f;
#pragma unroll
            for (int i = 0; i < 16; ++i) s += x[i];
            const float mean = wave_sum(s) * (1.0f / 1024.0f);
            float q = 0.f;
#pragma unroll
            for (int i = 0; i < 16; ++i) { const float d = x[i] - mean; q += d * d; }
            const float rstd = 1.0f / sqrtf(wave_sum(q) * (1.0f / 1024.0f) + EPS);
            if (lane == 0) { stt[2 * r] = mean; stt[2 * r + 1] = rstd; }
        }
        __syncthreads();
        for (int g = 0; g < 4; ++g) {
            {
                const int t = tid >> 2, s0 = (tid & 3) * 32;
                const float* wr = ws + (size_t)g * 16384 + t * 128 + s0;
#pragma unroll
                for (int j = 0; j < 4; ++j) {
                    const f32x4 w0 = *(const f32x4*)(wr + 8 * j), w1 = *(const f32x4*)(wr + 8 * j + 4);
                    const int s = s0 + 8 * j;
                    v4u o;
                    o.x = pk2(s + 0 <= t ? w0.x : 0.f, s + 1 <= t ? w0.y : 0.f); o.y = pk2(s + 2 <= t ? w0.z : 0.f, s + 3 <= t ? w0.w : 0.f);
                    o.z = pk2(s + 4 <= t ? w1.x : 0.f, s + 5 <= t ? w1.y : 0.f); o.w = pk2(s + 6 <= t ? w1.z : 0.f, s + 7 <= t ? w1.w : 0.f);
                    *(LAS v4u*)(lds + SG_W + t * HP + s * 2) = o;
                }
            }
#pragma unroll 2
            for (int i = 0; i < 8; ++i) {
                const int id = tid + NT * i, s = id >> 5, dc = (id & 31) * 8, col = g * 256 + dc;
                const v4u vv = *(const v4u*)(z + (size_t)(m0 + s) * NIN1 + 1024 + col);
                const float mean = stt[2 * s], rstd = stt[2 * s + 1];
                const f32x4 g0 = *(const f32x4*)(lng + col), g1 = *(const f32x4*)(lng + col + 4), b0 = *(const f32x4*)(lnb + col), b1 = *(const f32x4*)(lnb + col + 4);
                v4u o;
                o.x = pk2((bflo(vv.x) - mean) * rstd * g0.x + b0.x, (bfhi(vv.x) - mean) * rstd * g0.y + b0.y);
                o.y = pk2((bflo(vv.y) - mean) * rstd * g0.z + b0.z, (bfhi(vv.y) - mean) * rstd * g0.w + b0.w);
                o.z = pk2((bflo(vv.z) - mean) * rstd * g1.x + b1.x, (bfhi(vv.z) - mean) * rstd * g1.y + b1.y);
                o.w = pk2((bflo(vv.w) - mean) * rstd * g1.z + b1.z, (bfhi(vv.w) - mean) * rstd * g1.w + b1.w);
                *(LAS v4u*)(lds + SG_V + s * SGVP + dc * 2) = o;
            }
            __syncthreads();
            f32x4 acc[16];
#pragma unroll
            for (int n = 0; n < 16; ++n) acc[n] = (f32x4){0.f, 0.f, 0.f, 0.f};
            for (int ks = 0; ks < 4; ++ks) {
                if (32 * ks > 16 * wave + 15) break;
                const bf16x8 A = rowfrag(lds + SG_W, HP, 16 * wave, 32 * ks, fr, fq);
#pragma unroll
                for (int n = 0; n < 16; ++n) acc[n] = MFMA16(A, trfrag(lds + SG_V, SGVP, 32 * ks, 16 * n, lane), acc[n]);
            }
#pragma unroll
            for (int r = 0; r < 4; ++r) {
                const int t = 16 * wave + 4 * fq + r; const float bsv = bs[g * 128 + t];
                const bf16* ur = z + (size_t)(m0 + t) * NIN1 + g * 256 + fr; bf16* yr = y + (size_t)(m0 + t) * 1024 + g * 256 + fr;
#pragma unroll
                for (int n = 0; n < 16; ++n) yr[16 * n] = f2bf((acc[n][r] + bsv) * bf2f(ur[16 * n]));
            }
            __syncthreads();
        }
    }
}

#ifndef MK_N_LAUNCHES
#define MK_N_LAUNCHES 1
#endif

__global__ void __launch_bounds__(512, 2) fwd(Args a) {
    extern __shared__ __attribute__((aligned(16))) unsigned char lds_raw[];
    LAS unsigned char* lds = (LAS unsigned char*)lds_raw;
    cg::grid_group grid = cg::this_grid();
    volatile LAS unsigned* MISC = (volatile LAS unsigned*)(lds + MISC_OFF);
    if (threadIdx.x < 16) MISC[threadIdx.x] = 0u;
    __syncthreads();
    const XcdBarrier xbar = xcd_barrier_post((unsigned*)(a.ws + WS_BAR), MISC + 8);
    const int lo = a.ph_lo, hi = a.ph_hi;
#define IN(k) (lo <= (k) && (k) < hi)
#ifndef DBL_MASK
#define DBL_MASK 0
#endif
#define REP(k) _Pragma("unroll 1") for (int rep_ = 0; rep_ <= ((DBL_MASK >> (k)) & 1); ++rep_)
#define SEAM(k) do { if (IN(k) && IN((k) + 1)) { xcd_barrier(xbar); } } while (0)
#define PHASE_VARS int tid = threadIdx.x; asm volatile("" : "+v"(tid)); int G = gridDim.x; asm volatile("" : "+s"(G)); \
    const int lane = tid & 63, wave = __builtin_amdgcn_readfirstlane(tid >> 6); (void)lane; (void)wave; \
    bf16* const H = (bf16*)(a.ws + WS_H); bf16* const P = (bf16*)(a.ws + WS_P); const float* const modf = (const float*)(a.ws + WS_MODF); (void)H; (void)P; (void)modf;
#define GEMM_RES(ph, l, ffn) if (IN(ph)) REP(ph) { PHASE_VARS \
        const bf16* Bt = (ffn) ? (const bf16*)(a.ws + WS_WFF2) + (size_t)(l) * 1024 * 4096 : (const bf16*)(a.ws + ((l) ? WS_WOUT1 : WS_WOUT0)); \
        pg8::Gemm g{(ffn) ? P : H, Bt, M, 1024, (ffn) ? 4096 : 1024}; pg8::StaticOrder S; S.init(M, 1024, G, (int)blockIdx.x); \
        if ((ph) == 6) { pg8::EpiResGateBf<true> E{a.in[0], (bf16*)(a.ws + WS_XR), modf + (size_t)(l) * 8 * 6144 + ((ffn) ? 5 : 2) * 1024}; \
            pg8::gemm_phase<pg8::EpiResGateBf<true>, pg8::StaticOrder, true, true>(lds, g, S, E); } \
        else { pg8::EpiResGateBf<false> E{a.ws + WS_XR, (bf16*)(a.ws + WS_XR), modf + (size_t)(l) * 8 * 6144 + ((ffn) ? 5 : 2) * 1024}; \
            pg8::gemm_phase<pg8::EpiResGateBf<false>, pg8::StaticOrder, true, true>(lds, g, S, E); } } SEAM(ph);
#define GEMM_FF1(ph, l) if (IN(ph)) REP(ph) { PHASE_VARS \
        pg8::Gemm g{H, (const bf16*)(a.ws + WS_WFF1) + (size_t)(l) * 4096 * 1024, M, FF, 1024}; pg8::StaticOrder S; S.init(M, FF, G, (int)blockIdx.x); \
        pg8::EpiBf16<2> E{P, FF, nullptr}; \
        pg8::gemm_phase<pg8::EpiBf16<2>, pg8::StaticOrder, true, true>(lds, g, S, E); } SEAM(ph);
#define NORM(ph, l, ffn) if (IN(ph)) REP(ph) { PHASE_VARS \
        phase_norm_bf(a, ((ffn) ? a.in[5] : a.in[4]) + (l) * 1024, (l), (ffn) ? 3 : 0, (ffn) ? 4 : 1, tid, lane, wave, G); } SEAM(ph);

    if (a.ph_hi > NPH) grid.sync();
    if (IN(0)) REP(0) { PHASE_VARS phase_prologue(a, lds, tid, lane, wave, G); } SEAM(0);
    if (IN(1)) REP(1) { PHASE_VARS phase_norm<true>(a, a.in[0], a.in[4], 0, 0, 1, tid, lane, wave, G); } SEAM(1);
    if (IN(2)) REP(2) { PHASE_VARS
        pg8::Gemm g{H, (const bf16*)(a.ws + WS_WIN0), M, NIN0, 1024}; pg8::StaticOrder S; S.init(M, NIN0, G, (int)blockIdx.x);
        pg8::EpiBf16<0> E{P, NIN0, nullptr};
        pg8::gemm_phase<pg8::EpiBf16<0>, pg8::StaticOrder, true, true>(lds, g, S, E); } SEAM(2);
    if (IN(3)) REP(3) { PHASE_VARS conv_mixer(a, tid, G); hg_pass_a(a, lds, tid, lane, wave, G); } SEAM(3);
    if (IN(4)) REP(4) { PHASE_VARS hg_pass_b(a, tid, G); } SEAM(4);
    if (IN(5)) REP(5) { PHASE_VARS hg_pass_c(a, lds, tid, lane, wave, G); } SEAM(5);
    GEMM_RES(6, 0, false)
    NORM(7, 0, true)
    GEMM_FF1(8, 0)
    GEMM_RES(9, 0, true)
    NORM(10, 1, false)
    if (IN(11)) REP(11) { PHASE_VARS
        pg8::Gemm g{H, (const bf16*)(a.ws + WS_WIN1), M, NIN1, 1024}; pg8::StaticOrder S; S.init(M, NIN1, G, (int)blockIdx.x);
        pg8::EpiBf16<1> E{P, NIN1, a.in[13]};
        pg8::gemm_phase<pg8::EpiBf16<1>, pg8::StaticOrder, true, true>(lds, g, S, E); } SEAM(11);
    if (IN(12)) REP(12) { PHASE_VARS phase_sgu(a, lds, tid, lane, wave, G); } SEAM(12);
    GEMM_RES(13, 1, false)
    NORM(14, 1, true)
    GEMM_FF1(15, 1)
    GEMM_RES(16, 1, true)
    if (IN(17)) REP(17) { PHASE_VARS phase_final_norm(a, lane, wave, G); }
}
}

extern "C" void kernel_launch(void* const* d_in, const int* in_sizes, int n_in, void* d_out, int out_size, void* d_ws, size_t ws_size, hipStream_t stream) {
    using namespace mk;
    static int grid = 0;
    if (grid == 0) {
        if (n_in != 22 || out_size != M * D || ws_size < WS_END) { fprintf(stderr, "kernel_launch: unexpected shapes (n_in %d out %d ws %zu)\n", n_in, out_size, ws_size); grid = -1; return; }
        int dev = 0, cus = 0, per_cu = 0;
        (void)hipGetDevice(&dev); (void)hipDeviceGetAttribute(&cus, hipDeviceAttributeMultiprocessorCount, dev);
        if (hipFuncSetAttribute((const void*)fwd, hipFuncAttributeMaxDynamicSharedMemorySize, LDS_BYTES) != hipSuccess) fprintf(stderr, "kernel_launch: hipFuncSetAttribute failed\n");
        if (hipOccupancyMaxActiveBlocksPerMultiprocessor(&per_cu, (const void*)fwd, NT, LDS_BYTES) != hipSuccess || per_cu < 1) { fprintf(stderr, "kernel_launch: occupancy query says %d\n", per_cu); per_cu = 1; }
        (void)hipGetLastError();
        grid = cus * per_cu;
        if (grid <= 0) grid = 256;
    }
    if (grid < 0) return;
    if (hipMemsetAsync((char*)d_ws + WS_BAR, 0, BAR_ZERO_BYTES, stream) != hipSuccess) fprintf(stderr, "kernel_launch: memset of barrier words failed\n");
    Args a{};
    for (int i = 0; i < 22; ++i) a.in[i] = (const float*)d_in[i];
    a.out = (float*)d_out; a.ws = (unsigned char*)d_ws;
#if MK_N_LAUNCHES == 1
    a.ph_lo = 0; a.ph_hi = NPH;
    void* args[] = {&a};
    hipError_t e = hipLaunchCooperativeKernel((const void*)fwd, dim3(grid), dim3(NT), args, LDS_BYTES, stream);
    if (e != hipSuccess) fprintf(stderr, "cooperative launch failed: %s (grid %d)\n", hipGetErrorString(e), grid);
#else
    for (int ph = 0; ph < NPH; ++ph) {
        a.ph_lo = ph; a.ph_hi = ph + 1;
        hipLaunchKernelGGL(fwd, dim3(grid), dim3(NT), LDS_BYTES, stream, a);
    }
#endif
}
```

```cpp
#include <hip/hip_runtime.h>
#include <hip/hip_cooperative_groups.h>
#include <cstdio>
#include <cstdint>
namespace cg = cooperative_groups;
namespace pg8 {
#define PG8_LAS __attribute__((address_space(3)))
typedef unsigned short bf16_t;
typedef short bf16x8 __attribute__((ext_vector_type(8)));
typedef float f32x4 __attribute__((ext_vector_type(4)));
typedef unsigned u32x4 __attribute__((ext_vector_type(4)));
constexpr int BM = 256, BK = 64, HALF = 128, HTB = HALF * BK * 2  , STAGE_BYTES = 8 * HTB, NXCD = 8, WGM = 8;

__host__ __device__ __forceinline__ int lds_byte(int r, int c) { const int st = (r >> 4) * 2 + (c >> 5), rr = r & 15, cc = c & 31, ob = rr * 64 + cc * 2; return st * 1024 + (ob ^ (((ob >> 9) & 1) << 5)); }
__host__ __device__ __forceinline__ void stage_rc(int b, int& R, int& C) { const int st = b / 1024, sb = b % 1024, swz = sb ^ (((sb >> 9) & 1) << 5); R = (st >> 1) * 16 + swz / 64; C = (st & 1) * 32 + (swz % 64) / 2; }
__host__ __device__ __forceinline__ int perm32(int rho) { const int n = rho >> 4, i = rho & 15; return 8 * (i >> 2) + 4 * n + (i & 3); }

struct Unit { int pm, pn; };
struct Gemm { const bf16_t* A; const bf16_t* Bt; int M, N, K; };

struct StaticOrder {
    int nM, nN, nwg, G, c;
    __host__ __device__ void init(int M, int N, int G_, int c_) { nM = M / BM; nN = N / BM; nwg = nM * nN; G = G_; c = c_; }
    __host__ __device__ bool next(int i, Unit& u) const {
        const long L = (long)i * G + c; if (L >= nwg) return false;
        int wgid = (int)L; { const int q = nwg / NXCD, r = nwg % NXCD, xcd = wgid % NXCD, off = wgid / NXCD; wgid = (xcd < r ? xcd * (q + 1) : r * (q + 1) + (xcd - r) * q) + off; }
        const int nig = WGM * nN, gid = wgid / nig, fm = gid * WGM, gsz = (nM - fm) < WGM ? (nM - fm) : WGM;
        u.pm = fm + ((wgid % nig) % gsz); u.pn = (wgid % nig) / gsz; return true;
    }
    __device__ __forceinline__ void a_ready(const Unit&) const {}
    __device__ __forceinline__ void done(const Unit&) const {}
};

__device__ __forceinline__ unsigned cvt_pk_bf16(float lo, float hi) { unsigned r; asm volatile("v_cvt_pk_bf16_f32 %0, %1, %2" : "=v"(r) : "v"(lo), "v"(hi)); return r; }
typedef float f32x2 __attribute__((ext_vector_type(2)));
__device__ __forceinline__ float gelu_tanh(float x) {
    const float u = 0.7978845608f * (x + 0.044715f * x * x * x);
    const float e = __builtin_amdgcn_exp2f(-2.0f * 1.4426950408889634f * u);
    return x * __builtin_amdgcn_rcpf(1.0f + e);
}
template <int ACT> struct EpiBf16 {
    static constexpr bool PERM = true, AFTER_DRAIN = false;
    bf16_t* O; int ldc; const float* bias;
    __device__ __forceinline__ void operator()(const f32x4 (&acc)[2][2][4][2], const Unit& u, int wr, int wc, int fr, int fq) const {
        const int row0 = u.pm * BM + wr * 64 + fr; const int col0 = u.pn * BM + wc * 32 + 8 * fq;
        f32x4 bv[2][2];
#pragma unroll
        for (int bj = 0; bj < 2; ++bj)
#pragma unroll
            for (int n = 0; n < 2; ++n) bv[bj][n] = bias ? *(const f32x4*)(bias + col0 + bj * HALF + 4 * n) : (f32x4){0.f, 0.f, 0.f, 0.f};
#pragma unroll
        for (int ai = 0; ai < 2; ++ai)
#pragma unroll
            for (int m = 0; m < 4; ++m) { bf16_t* rowp = O + (size_t)(row0 + ai * HALF + m * 16) * ldc + col0;
#pragma unroll
                for (int bj = 0; bj < 2; ++bj) { f32x4 v0 = acc[ai][bj][m][0] + bv[bj][0], v1 = acc[ai][bj][m][1] + bv[bj][1];
                    if (ACT == 1) {
#pragma unroll
                        for (int i = 0; i < 4; ++i) { v0[i] = gelu_tanh(v0[i]); v1[i] = gelu_tanh(v1[i]); } }
                    if (ACT == 2) {
#pragma unroll
                        for (int i = 0; i < 4; ++i) { const float a = fmaxf(v0[i], 0.f), b = fmaxf(v1[i], 0.f); v0[i] = a * a; v1[i] = b * b; } }
                    u32x4 w; w.x = cvt_pk_bf16(v0[0], v0[1]); w.y = cvt_pk_bf16(v0[2], v0[3]); w.z = cvt_pk_bf16(v1[0], v1[1]); w.w = cvt_pk_bf16(v1[2], v1[3]);
                    *(u32x4*)(rowp + bj * HALF) = w; } }
    }
};
struct EpiResGate {
    static constexpr bool PERM = false, AFTER_DRAIN = false;
    const float* base; float* out; const float* gate;
    __device__ __forceinline__ void operator()(const f32x4 (&acc)[2][2][4][2], const Unit& u, int wr, int wc, int fr, int fq) const {
        const int row0 = u.pm * BM + wr * 64 + fr; const int col0 = u.pn * BM + wc * 32 + 4 * fq; const int b = u.pm >> 4;
        f32x4 gv[2][2];
#pragma unroll
        for (int bj = 0; bj < 2; ++bj)
#pragma unroll
            for (int n = 0; n < 2; ++n) gv[bj][n] = *(const f32x4*)(gate + (size_t)b * 6144 + col0 + bj * HALF + n * 16);
#pragma unroll
        for (int ai = 0; ai < 2; ++ai) {
            f32x4 bs[4][2][2];
#pragma unroll
            for (int m = 0; m < 4; ++m) { const size_t off = (size_t)(row0 + ai * HALF + m * 16) * 1024 + col0;
#pragma unroll
                for (int bj = 0; bj < 2; ++bj)
#pragma unroll
                    for (int n = 0; n < 2; ++n) bs[m][bj][n] = *(const f32x4*)(base + off + bj * HALF + n * 16); }
#pragma unroll
            for (int m = 0; m < 4; ++m) { const size_t off = (size_t)(row0 + ai * HALF + m * 16) * 1024 + col0;
#pragma unroll
                for (int bj = 0; bj < 2; ++bj)
#pragma unroll
                    for (int n = 0; n < 2; ++n) *(f32x4*)(out + off + bj * HALF + n * 16) = bs[m][bj][n] + gv[bj][n] * acc[ai][bj][m][n]; }
            asm volatile("" ::: "memory"); }
    }
};
template <bool BASE_F32> struct EpiResGateBf {
    static constexpr bool PERM = true, AFTER_DRAIN = false;
    const void* base; bf16_t* out; const float* gate;
    __device__ __forceinline__ void operator()(const f32x4 (&acc)[2][2][4][2], const Unit& u, int wr, int wc, int fr, int fq) const {
        const int row0 = u.pm * BM + wr * 64 + fr; const int col0 = u.pn * BM + wc * 32 + 8 * fq; const int b = u.pm >> 4;
        f32x4 gv[2][2];
#pragma unroll
        for (int bj = 0; bj < 2; ++bj)
#pragma unroll
            for (int n = 0; n < 2; ++n) gv[bj][n] = *(const f32x4*)(gate + (size_t)b * 6144 + col0 + bj * HALF + 4 * n);
#pragma unroll
        for (int ai = 0; ai < 2; ++ai) {
            f32x4 bs[4][2][2];
#pragma unroll
            for (int m = 0; m < 4; ++m) { const size_t off = (size_t)(row0 + ai * HALF + m * 16) * 1024 + col0;
#pragma unroll
                for (int bj = 0; bj < 2; ++bj) {
                    if (BASE_F32) { bs[m][bj][0] = *(const f32x4*)((const float*)base + off + bj * HALF); bs[m][bj][1] = *(const f32x4*)((const float*)base + off + bj * HALF + 4); }
                    else { const u32x4 w = *(const u32x4*)((const bf16_t*)base + off + bj * HALF);
                        bs[m][bj][0] = (f32x4){__builtin_bit_cast(float, w.x << 16), __builtin_bit_cast(float, w.x & 0xffff0000u), __builtin_bit_cast(float, w.y << 16), __builtin_bit_cast(float, w.y & 0xffff0000u)};
                        bs[m][bj][1] = (f32x4){__builtin_bit_cast(float, w.z << 16), __builtin_bit_cast(float, w.z & 0xffff0000u), __builtin_bit_cast(float, w.w << 16), __builtin_bit_cast(float, w.w & 0xffff0000u)}; } } }
#pragma unroll
            for (int m = 0; m < 4; ++m) { const size_t off = (size_t)(row0 + ai * HALF + m * 16) * 1024 + col0;
#pragma unroll
                for (int bj = 0; bj < 2; ++bj) { const f32x4 v0 = bs[m][bj][0] + gv[bj][0] * acc[ai][bj][m][0], v1 = bs[m][bj][1] + gv[bj][1] * acc[ai][bj][m][1];
                    u32x4 w; w.x = cvt_pk_bf16(v0[0], v0[1]); w.y = cvt_pk_bf16(v0[2], v0[3]); w.z = cvt_pk_bf16(v1[0], v1[1]); w.w = cvt_pk_bf16(v1[2], v1[3]);
                    *(u32x4*)(out + off + bj * HALF) = w; } }
            asm volatile("" ::: "memory"); }
    }
};
template <class Epi, class Sched, bool ALIGN_EPI = false, bool SP2 = false>
__device__ __forceinline__ void gemm_phase(PG8_LAS unsigned char* lds, const Gemm g, const Sched& S, const Epi& E) {
    const int tid = threadIdx.x, wid = __builtin_amdgcn_readfirstlane(tid >> 6), lane = tid & 63, wr = wid >> 2, wc = wid & 3, fr = lane & 15, fq = lane >> 4;
    const int K = g.K, nt = K / BK;
    unsigned voffA[2], voffB[2];
#pragma unroll
    for (int i = 0; i < 2; ++i) { int R, C; stage_rc(tid * 16 + i * 8192, R, C); const int Rb = Epi::PERM ? ((R & ~31) + perm32(R & 31)) : R;
        voffA[i] = (unsigned)(R * K + C) * 2u; voffB[i] = (unsigned)(Rb * K + C) * 2u; }
    const size_t kstep = (size_t)(BK * 2);
    const size_t hstep = (size_t)HALF * K * 2;
    const size_t tstep = 2 * hstep;
    const unsigned ldsw = (unsigned)wid * 1024u;
    const int aoff = lds_byte(wr * 64 + fr, fq * 8), boff = lds_byte(wc * 32 + fr, fq * 8);
#define PG8_SA(b, h) (((b) * 2 + (h)) * HTB)
#define PG8_SB(b, h) ((4 + (b) * 2 + (h)) * HTB)
#define PG8_STAGE(bufoff, gbase, voff) do { _Pragma("unroll") for (int _i = 0; _i < 2; ++_i) \
        __builtin_amdgcn_global_load_lds((const unsigned*)((const char*)(gbase) + (voff)[_i]), (PG8_LAS unsigned*)(lds + (bufoff) + ldsw + _i * 8192), 16, 0, 0); } while (0)
#define PG8_LDA(dst, b, h) do { _Pragma("unroll") for (int m = 0; m < 4; ++m) _Pragma("unroll") for (int k = 0; k < 2; ++k) dst[m][k] = *(const PG8_LAS bf16x8*)(lds + PG8_SA(b, h) + aoff + m * 2048 + k * 1024); } while (0)
#define PG8_LDB(dst, b, h) do { _Pragma("unroll") for (int n = 0; n < 2; ++n) _Pragma("unroll") for (int k = 0; k < 2; ++k) dst[n][k] = *(const PG8_LAS bf16x8*)(lds + PG8_SB(b, h) + boff + n * 2048 + k * 1024); } while (0)
#define PG8_MMA(ai, bj, At, Bt) do { __builtin_amdgcn_s_setprio(1); _Pragma("unroll") for (int m = 0; m < 4; ++m) _Pragma("unroll") for (int n = 0; n < 2; ++n) _Pragma("unroll") for (int k = 0; k < 2; ++k) \
        acc[ai][bj][m][n] = __builtin_amdgcn_mfma_f32_16x16x32_bf16(Bt[n][k], At[m][k], acc[ai][bj][m][n], 0, 0, 0); __builtin_amdgcn_s_setprio(0); } while (0)
#define PG8_WAIT_V(n) asm volatile("s_waitcnt vmcnt(" #n ")" ::: "memory")
#define PG8_WAIT_L(n) asm volatile("s_waitcnt lgkmcnt(" #n ")" ::: "memory")
#define PG8_BAR __builtin_amdgcn_s_barrier()
#define PG8_SCHED __builtin_amdgcn_sched_barrier(0)
    Unit cur, nxt; int ui = 0;
    if (!S.next(0, cur)) return;
    f32x4 acc[2][2][4][2];
#pragma unroll
    for (int a = 0; a < 2; ++a)
#pragma unroll
        for (int b = 0; b < 2; ++b)
#pragma unroll
            for (int m = 0; m < 4; ++m)
#pragma unroll
                for (int n = 0; n < 2; ++n) acc[a][b][m][n] = (f32x4){0.f, 0.f, 0.f, 0.f};
    bf16x8 At[4][2], B0[2][2], B1[2][2];
    const char* cA = (const char*)g.A + (size_t)cur.pm * tstep; const char* cB = (const char*)g.Bt + (size_t)cur.pn * tstep;
    S.a_ready(cur);
    if constexpr (SP2) {
        PG8_STAGE(PG8_SB(0, 0), cB, voffB); PG8_STAGE(PG8_SB(0, 1), cB + hstep, voffB); PG8_STAGE(PG8_SA(0, 0), cA, voffA); PG8_STAGE(PG8_SA(0, 1), cA + hstep, voffA);
        if (wr == 1) PG8_BAR;
        PG8_WAIT_V(2); PG8_BAR;
        PG8_STAGE(PG8_SB(1, 0), cB + kstep, voffB); PG8_STAGE(PG8_SA(1, 0), cA + kstep, voffA); PG8_STAGE(PG8_SB(1, 1), cB + hstep + kstep, voffB);
        PG8_WAIT_V(6); PG8_BAR;
    } else {
        PG8_STAGE(PG8_SB(0, 0), cB, voffB); PG8_STAGE(PG8_SA(0, 0), cA, voffA); PG8_STAGE(PG8_SB(0, 1), cB + hstep, voffB); PG8_STAGE(PG8_SA(0, 1), cA + hstep, voffA);
        if (wr == 1) PG8_BAR;
        PG8_WAIT_V(4); PG8_BAR;
        PG8_STAGE(PG8_SB(1, 0), cB + kstep, voffB); PG8_STAGE(PG8_SA(1, 0), cA + kstep, voffA); PG8_STAGE(PG8_SB(1, 1), cB + hstep + kstep, voffB);
        PG8_WAIT_V(6); PG8_BAR;
    }
    for (;;) {
        const bool has_next = S.next(ui + 1, nxt);
        const char* nA = has_next ? (const char*)g.A + (size_t)nxt.pm * tstep : cA; const char* nB = has_next ? (const char*)g.Bt + (size_t)nxt.pn * tstep : cB;
        for (int t = 0; t < nt; t += 2) {
            const bool last = (t == nt - 2);
            const char* a1 = cA + (size_t)(t + 1) * kstep;
            const char* a2 = last ? nA : cA + (size_t)(t + 2) * kstep; const char* b2 = last ? nB : cB + (size_t)(t + 2) * kstep;
            const char* a3 = a2 + kstep; const char* b3 = b2 + kstep;
            if (last && has_next) S.a_ready(nxt);
            if constexpr (SP2) {
            PG8_LDB(B0, 0, 0); PG8_LDB(B1, 0, 1); PG8_SCHED; PG8_LDA(At, 0, 0); PG8_STAGE(PG8_SA(1, 1), a1 + hstep, voffA);
            PG8_WAIT_V(8); PG8_WAIT_L(0); PG8_BAR; PG8_MMA(0, 0, At, B0); PG8_MMA(0, 1, At, B1); PG8_BAR; PG8_SCHED;
            PG8_LDA(At, 0, 1); PG8_STAGE(PG8_SB(0, 0), b2, voffB); PG8_STAGE(PG8_SB(0, 1), b2 + hstep, voffB); PG8_STAGE(PG8_SA(0, 0), a2, voffA);
            PG8_WAIT_V(8); PG8_WAIT_L(0); PG8_BAR; PG8_MMA(1, 0, At, B0); PG8_MMA(1, 1, At, B1); PG8_BAR; PG8_SCHED;
            PG8_LDB(B0, 1, 0); PG8_LDB(B1, 1, 1); PG8_SCHED; PG8_LDA(At, 1, 0); PG8_STAGE(PG8_SA(0, 1), a2 + hstep, voffA);
            PG8_WAIT_V(8); PG8_WAIT_L(0); PG8_BAR; PG8_MMA(0, 0, At, B0); PG8_MMA(0, 1, At, B1); PG8_BAR; PG8_SCHED;
            PG8_LDA(At, 1, 1); PG8_STAGE(PG8_SB(1, 0), b3, voffB); PG8_STAGE(PG8_SB(1, 1), b3 + hstep, voffB); PG8_STAGE(PG8_SA(1, 0), a3, voffA);
            PG8_WAIT_V(8); PG8_WAIT_L(0); PG8_BAR; PG8_MMA(1, 0, At, B0); PG8_MMA(1, 1, At, B1); PG8_BAR; PG8_SCHED;
            } else {
            PG8_LDB(B0, 0, 0); PG8_SCHED; PG8_LDA(At, 0, 0); PG8_STAGE(PG8_SA(1, 1), a1 + hstep, voffA);
            PG8_WAIT_L(8); PG8_BAR; PG8_WAIT_L(0); PG8_MMA(0, 0, At, B0); PG8_BAR; PG8_SCHED;
            PG8_LDB(B1, 0, 1); PG8_STAGE(PG8_SB(0, 0), b2, voffB);
            PG8_BAR; PG8_WAIT_L(0); PG8_MMA(0, 1, At, B1); PG8_BAR;
            PG8_LDA(At, 0, 1); PG8_STAGE(PG8_SA(0, 0), a2, voffA);
            PG8_BAR; PG8_WAIT_L(0); PG8_MMA(1, 0, At, B0); PG8_BAR; PG8_SCHED;
            PG8_STAGE(PG8_SB(0, 1), b2 + hstep, voffB);
            PG8_WAIT_V(6); PG8_BAR; PG8_MMA(1, 1, At, B1); PG8_BAR;
            PG8_LDB(B0, 1, 0); PG8_SCHED; PG8_LDA(At, 1, 0); PG8_STAGE(PG8_SA(0, 1), a2 + hstep, voffA);
            PG8_WAIT_L(8); PG8_BAR; PG8_WAIT_L(0); PG8_MMA(0, 0, At, B0); PG8_BAR; PG8_SCHED;
            PG8_LDB(B1, 1, 1); PG8_STAGE(PG8_SB(1, 0), b3, voffB);
            PG8_BAR; PG8_WAIT_L(0); PG8_MMA(0, 1, At, B1); PG8_BAR;
            PG8_LDA(At, 1, 1); PG8_STAGE(PG8_SA(1, 0), a3, voffA);
            PG8_BAR; PG8_WAIT_L(0); PG8_MMA(1, 0, At, B0); PG8_BAR; PG8_SCHED;
            PG8_STAGE(PG8_SB(1, 1), b3 + hstep, voffB);
            PG8_WAIT_V(6); PG8_BAR; PG8_MMA(1, 1, At, B1); PG8_BAR;
            }
        }
        if constexpr (ALIGN_EPI) { if (wr == 0) PG8_BAR; }
        if constexpr (!Epi::AFTER_DRAIN) { E(acc, cur, wr, wc, fr, fq); S.done(cur); }
        if (!has_next) break;
#pragma unroll
        for (int a = 0; a < 2; ++a)
#pragma unroll
            for (int b = 0; b < 2; ++b)
#pragma unroll
                for (int m = 0; m < 4; ++m)
#pragma unroll
                    for (int n = 0; n < 2; ++n) acc[a][b][m][n] = (f32x4){0.f, 0.f, 0.f, 0.f};
        cur = nxt; cA = nA; cB = nB; ++ui;
        if constexpr (ALIGN_EPI) { if (wr == 1) PG8_BAR; }
    }
    PG8_WAIT_V(0);
    if constexpr (!ALIGN_EPI) { if (wr == 0) PG8_BAR; }
    PG8_BAR;
    if constexpr (Epi::AFTER_DRAIN) { E.fused(acc, cur, wr, wc, fr, fq, lds, wid, lane); S.done(cur); }
#undef PG8_SA
#undef PG8_SB
#undef PG8_STAGE
#undef PG8_LDA
#undef PG8_LDB
#undef PG8_MMA
#undef PG8_WAIT_V
#undef PG8_WAIT_L
#undef PG8_BAR
#undef PG8_SCHED
}
}
namespace mk {
#define LAS __attribute__((address_space(3)))
typedef unsigned short bf16;
typedef short bf16x8 __attribute__((ext_vector_type(8)));
typedef short s16x4 __attribute__((ext_vector_type(4)));
typedef float f32x4 __attribute__((ext_vector_type(4)));
typedef unsigned v4u __attribute__((ext_vector_type(4)));
typedef unsigned v2u __attribute__((ext_vector_type(2)));

constexpr int BATCH = 8, SEQ = 4096, D = 1024, M = BATCH * SEQ, FF = 4096, NIN0 = 3584, NIN1 = 2048;
constexpr int NT = 512;
constexpr float EPS = 1e-6f;
constexpr size_t MiB = 1u << 20;
constexpr size_t WS_MODP = 440 * MiB;
constexpr int NCH = 16;
constexpr size_t WS_MODF = 3 * MiB;
constexpr size_t WS_DEC = 4 * MiB;
constexpr size_t WS_BAR = 5 * MiB, BAR_ZERO_BYTES = 16384;
constexpr int MISC_OFF = 131072;
constexpr size_t WS_WIN0 = 8 * MiB, WS_WOUT0 = 15 * MiB, WS_WIN1 = 17 * MiB, WS_WOUT1 = 21 * MiB, WS_WFF1 = 23 * MiB, WS_WFF2 = 39 * MiB;
constexpr size_t WS_H = 56 * MiB;
constexpr size_t WS_P = 120 * MiB;
constexpr size_t WS_S = 376 * MiB;
constexpr size_t WS_XR = 376 * MiB;
constexpr size_t WS_END = 448 * MiB;
constexpr int LDS_BYTES = 147456;
constexpr int NPH = 18;

struct Args { const float* in[22]; float* out; unsigned char* ws; int ph_lo, ph_hi; };

__device__ __forceinline__ float bf2f(unsigned u) { return __builtin_bit_cast(float, u << 16); }
__device__ __forceinline__ float bflo(unsigned w) { return __builtin_bit_cast(float, w << 16); }
__device__ __forceinline__ float bfhi(unsigned w) { return __builtin_bit_cast(float, w & 0xffff0000u); }
__device__ __forceinline__ unsigned pk2(float lo, float hi) { return pg8::cvt_pk_bf16(lo, hi); }
__device__ __forceinline__ unsigned short f2bf(float f) { return (unsigned short)(pg8::cvt_pk_bf16(f, 0.f) & 0xffffu); }
__device__ __forceinline__ float wave_sum(float v) {
#pragma unroll
    for (int o = 1; o < 64; o <<= 1) v += __shfl_xor(v, o);
    return v;
}
__device__ __forceinline__ float sigmoidf_(float x) { return __builtin_amdgcn_rcpf(1.0f + __expf(-x)); }
__device__ __forceinline__ float siluf_(float x) { return x * sigmoidf_(x); }

__device__ __forceinline__ bf16x8 rowfrag(LAS const unsigned char* T, int pitchB, int r0, int k0, int fr, int fq) {
    return *(LAS const bf16x8*)(T + (r0 + fr) * pitchB + (k0 + 8 * fq) * 2);
}
typedef short v4i16_t __attribute__((ext_vector_type(4)));
__device__ __forceinline__ bf16x8 trfrag(LAS const unsigned char* T, int pitchB, int k0, int n0, int lane) {
    const int g = lane >> 4, q = (lane & 15) >> 2, pp = lane & 3;
    LAS const unsigned char* p0 = T + (k0 + 8 * g + q) * pitchB + (n0 + 4 * pp) * 2;
    const v4i16_t a = __builtin_amdgcn_ds_read_tr16_b64_v4i16((LAS v4i16_t*)p0);
    const v4i16_t b = __builtin_amdgcn_ds_read_tr16_b64_v4i16((LAS v4i16_t*)(p0 + 4 * pitchB));
    return (bf16x8){a.x, a.y, a.z, a.w, b.x, b.y, b.z, b.w};
}
#define MFMA16(a, b, c) __builtin_amdgcn_mfma_f32_16x16x32_bf16((a), (b), (c), 0, 0, 0)

#define XB_TMO      128
#define XB_XCNT(j)  (256  + 64 * (j))
#define XB_XSUB(j)  (1280 + 64 * (j))
#define XB_XGEN(j)  (2304 + 64 * (j))
#define XB_TOP      3328
#define XB_TOPGEN   3392
#define XCD_BAR_WORDS 3456
#define XB_SPIN_CAP (1u << 18)

__device__ __forceinline__ unsigned xb_ld(unsigned* p)              { return __hip_atomic_load(p, __ATOMIC_RELAXED, __HIP_MEMORY_SCOPE_AGENT); }
__device__ __forceinline__ unsigned xb_add(unsigned* p, unsigned v) { return __hip_atomic_fetch_add(p, v, __ATOMIC_RELAXED, __HIP_MEMORY_SCOPE_AGENT); }
__device__ __forceinline__ unsigned xb_xcc_id() { return (unsigned)__builtin_amdgcn_s_getreg((3 << 11) | 20) & 0xFu; }
#define XB_SPIN(cond, bar) do { unsigned _sp = 0; while (cond) { __builtin_amdgcn_s_sleep(1); \
    if ((++_sp & 255u) == 0u) { if (xb_ld(&(bar)[XB_TMO])) break; if (_sp > XB_SPIN_CAP) { atomicAdd(&(bar)[XB_TMO], 1u); break; } } } } while (0)

struct XcdBarrier {
    unsigned* bar; unsigned x;
    volatile LAS unsigned* st;
};

__device__ __forceinline__ XcdBarrier xcd_barrier_post(unsigned* bar, volatile LAS unsigned* st) {
    XcdBarrier b; b.bar = bar; b.x = xb_xcc_id(); b.st = st;
    if (threadIdx.x == 0) (void)xb_add(&bar[XB_XCNT(b.x)], 1u);
    return b;
}
__device__ __forceinline__ void xcd_barrier_complete(unsigned* bar, unsigned x, unsigned& nloc, unsigned& nx) {
    const unsigned G = gridDim.x * gridDim.y * gridDim.z;
    unsigned sum, cnt, mine, sp = 0u;
    for (;;) {
        sum = 0u; cnt = 0u; mine = 0u;
#pragma unroll
        for (unsigned j = 0; j < 16; ++j) { const unsigned c = xb_ld(&bar[XB_XCNT(j)]); sum += c; cnt += (c > 0u) ? 1u : 0u; mine = (j == x) ? c : mine; }
        if (sum == G) break;
        __builtin_amdgcn_s_sleep(1);
        if ((++sp & 255u) == 0u) { if (xb_ld(&bar[XB_TMO])) break; if (sp > XB_SPIN_CAP) { atomicAdd(&bar[XB_TMO], 1u); break; } }
    }
    nloc = mine > 0u ? mine : 1u; nx = cnt > 0u ? cnt : 1u;
}

__device__ __forceinline__ void xcd_barrier(const XcdBarrier& b) {
    asm volatile("s_waitcnt vmcnt(0)" ::: "memory");
    __syncthreads();
    if (threadIdx.x == 0) {
        unsigned* bar = b.bar;
        __builtin_amdgcn_s_waitcnt(0);
        unsigned nloc = b.st[0], nx = b.st[1];
        if (nloc == 0u) { xcd_barrier_complete(bar, b.x, nloc, nx); b.st[0] = nloc; b.st[1] = nx; }
        const unsigned old = xb_add(&bar[XB_XSUB(b.x)], 1u);
        const unsigned gen = old / nloc;
        if (old + 1u == (gen + 1u) * nloc) {
            __builtin_amdgcn_fence(__ATOMIC_RELEASE, "agent");
            asm volatile("s_waitcnt vmcnt(0)" ::: "memory");
            const unsigned og = xb_add(&bar[XB_TOP], 1u);
            const unsigned tg = og / nx;
            if (og + 1u == (tg + 1u) * nx) xb_add(&bar[XB_TOPGEN], 1u);
            else XB_SPIN(xb_ld(&bar[XB_TOPGEN]) == tg, bar);
            __builtin_amdgcn_fence(__ATOMIC_ACQUIRE, "agent");
            xb_add(&bar[XB_XGEN(b.x)], 1u);
            asm volatile("s_waitcnt vmcnt(0)" ::: "memory");
        } else {
            XB_SPIN(xb_ld(&bar[XB_XGEN(b.x)]) == gen, bar);
            __builtin_amdgcn_fence(__ATOMIC_ACQUIRE, "agent");
            asm volatile("s_waitcnt vmcnt(0)" ::: "memory");
        }
    }
    __syncthreads();
}

__device__ __forceinline__ void transpose_item(const float* W, int K, int N, bf16* WT, LAS float* scr, int item, int lane) {
    const int nblk = N / 32, kb = item / nblk, nb = item % nblk, k0 = 64 * kb, n0 = 32 * nb;
    float tv[32];
#pragma unroll
    for (int i = 0; i < 32; ++i) tv[i] = W[(size_t)(k0 + 2 * i + (lane >> 5)) * N + n0 + (lane & 31)];
#pragma unroll
    for (int i = 0; i < 32; ++i) scr[(2 * i + (lane >> 5)) * 33 + (lane & 31)] = tv[i];
    asm volatile("s_waitcnt lgkmcnt(0)" ::: "memory");
    const int c = lane & 7;
#pragma unroll
    for (int j = 0; j < 4; ++j) { const int n = (lane >> 3) + 8 * j; const LAS float* s = scr + (8 * c) * 33 + n;
        v4u o; o.x = pk2(s[0 * 33], s[1 * 33]); o.y = pk2(s[2 * 33], s[3 * 33]); o.z = pk2(s[4 * 33], s[5 * 33]); o.w = pk2(s[6 * 33], s[7 * 33]);
        *(v4u*)(WT + (size_t)(n0 + n) * K + k0 + 8 * c) = o; }
    asm volatile("s_waitcnt lgkmcnt(0)" ::: "memory");
}
__device__ __forceinline__ void phase_prologue(const Args& a, LAS unsigned char* lds, int tid, int lane, int wave, int G) {
    LAS float* sc = (LAS float*)lds;
    const float* c = a.in[1];
    for (int i = tid; i < 8192; i += NT) sc[i] = siluf_(c[i]);
    __syncthreads();
    float* modp = (float*)(a.ws + WS_MODP);
    for (int it = blockIdx.x; it < 2 * NCH * 12; it += G) {
        const int l = it / (NCH * 12), r = it % (NCH * 12), ch = r / 12, eb = r % 12, e = eb * 512 + tid;
        const float* w = a.in[2] + ((size_t)l * 1024 + ch * 64) * 6144 + e;
        float acc0 = 0.f, acc1 = 0.f, acc2 = 0.f, acc3 = 0.f, acc4 = 0.f, acc5 = 0.f, acc6 = 0.f, acc7 = 0.f;
        const LAS float* s = sc + ch * 64;
#pragma unroll 16
        for (int d = 0; d < 64; ++d) { const float wv = w[(size_t)d * 6144];
            acc0 += s[d] * wv; acc1 += s[1024 + d] * wv; acc2 += s[2048 + d] * wv; acc3 += s[3072 + d] * wv;
            acc4 += s[4096 + d] * wv; acc5 += s[5120 + d] * wv; acc6 += s[6144 + d] * wv; acc7 += s[7168 + d] * wv; }
        float* o = modp + (size_t)((ch * 2 + l) * 8) * 6144 + e;
        o[0] = acc0; o[6144] = acc1; o[2 * 6144] = acc2; o[3 * 6144] = acc3; o[4 * 6144] = acc4; o[5 * 6144] = acc5; o[6 * 6144] = acc6; o[7 * 6144] = acc7;
    }
    __syncthreads();
    LAS float* scr = (LAS float*)(lds + 32768 + wave * 8704);
    const int gw = blockIdx.x * 8 + wave, NGW = G * 8;
    constexpr int I0 = 1792, I1 = 512, I2 = 1024, I3 = 512, I4 = 2048, I5 = 2048;
    constexpr int NITEMS = I0 + I1 + I2 + I3 + 2 * I4 + 2 * I5;
    for (int it = gw; it < NITEMS; it += NGW) {
        int r = it;
        if (r < I0) { transpose_item(a.in[6], 1024, NIN0, (bf16*)(a.ws + WS_WIN0), scr, r, lane); continue; } r -= I0;
        if (r < I1) { transpose_item(a.in[11], 1024, 1024, (bf16*)(a.ws + WS_WOUT0), scr, r, lane); continue; } r -= I1;
        if (r < I2) { transpose_item(a.in[12], 1024, NIN1, (bf16*)(a.ws + WS_WIN1), scr, r, lane); continue; } r -= I2;
        if (r < I3) { transpose_item(a.in[18], 1024, 1024, (bf16*)(a.ws + WS_WOUT1), scr, r, lane); continue; } r -= I3;
        if (r < 2 * I4) { const int l = r / I4; transpose_item(a.in[19] + (size_t)l * 1024 * 4096, 1024, 4096, (bf16*)(a.ws + WS_WFF1) + (size_t)l * 4096 * 1024, scr, r % I4, lane); continue; } r -= 2 * I4;
        { const int l = r / I5; transpose_item(a.in[20] + (size_t)l * 4096 * 1024, 4096, 1024, (bf16*)(a.ws + WS_WFF2) + (size_t)l * 1024 * 4096, scr, r % I5, lane); }
    }
}

template <bool PARTIAL>
__device__ __forceinline__ float modval(const Args& a, int l, int b, int idx) {
    if (PARTIAL) {
        const float* modp = (const float*)(a.ws + WS_MODP);
        float s = a.in[3][l * 6144 + idx];
#pragma unroll
        for (int ch = 0; ch < NCH; ++ch) s += modp[(size_t)((ch * 2 + l) * 8 + b) * 6144 + idx];
        return s;
    } else {
        return ((const float*)(a.ws + WS_MODF))[(size_t)(l * 8 + b) * 6144 + idx];
    }
}
template <bool PARTIAL>
__device__ __forceinline__ void phase_norm(const Args& a, const float* xsrc, const float* gvec, int l, int jshift, int jscale, int tid, int lane, int wave, int G) {
    bf16* h = (bf16*)(a.ws + WS_H);
    if (PARTIAL) {
        float* modf = (float*)(a.ws + WS_MODF);
        for (int i = blockIdx.x * NT + tid; i < 2 * 8 * 6144; i += G * NT) { const int ll = i / 49152, bb = (i / 6144) % 8, idx = i % 6144; modf[i] = modval<true>(a, ll, bb, idx); }
    }
    for (int blk = blockIdx.x; blk < 256; blk += G) {
        const int b = blk >> 5;
        f32x4 gs[4], sh[4];
#pragma unroll
        for (int j = 0; j < 4; ++j) { const int col = lane * 4 + 256 * j;
#pragma unroll
            for (int i = 0; i < 4; ++i) { gs[j][i] = gvec[col + i] * (1.0f + modval<PARTIAL>(a, l, b, jscale * 1024 + col + i)); sh[j][i] = modval<PARTIAL>(a, l, b, jshift * 1024 + col + i); } }
        const float* xb = xsrc + (size_t)blk * 128 * 1024;
        f32x4 nx[4];
#pragma unroll
        for (int j = 0; j < 4; ++j) nx[j] = ((const f32x4*)(xb + (size_t)wave * 1024) + lane)[64 * j];
        for (int r = wave; r < 128; r += 8) {
            const size_t m = (size_t)blk * 128 + r;
            f32x4 v[4]; float ss = 0.f;
#pragma unroll
            for (int j = 0; j < 4; ++j) { v[j] = nx[j]; ss += (v[j].x * v[j].x + v[j].y * v[j].y) + (v[j].z * v[j].z + v[j].w * v[j].w); }
            if (r + 8 < 128) {
#pragma unroll
                for (int j = 0; j < 4; ++j) nx[j] = ((const f32x4*)(xb + (size_t)(r + 8) * 1024) + lane)[64 * j];
            }
            const float inv = 1.0f / sqrtf(wave_sum(ss) * (1.0f / 1024.0f) + EPS);
            v2u* o8 = (v2u*)(h + m * 1024) + lane;
#pragma unroll
            for (int j = 0; j < 4; ++j) { const f32x4 o = v[j] * inv * gs[j] + sh[j]; v2u w; w.x = pk2(o.x, o.y); w.y = pk2(o.z, o.w); o8[64 * j] = w; }
        }
    }
}
__device__ __forceinline__ void unpack8(const v4u w, float (&x)[16], int o) {
#pragma unroll
    for (int i = 0; i < 4; ++i) { x[o + 2 * i] = bflo(w[i]); x[o + 2 * i + 1] = bfhi(w[i]); }
}
__device__ __forceinline__ void phase_norm_bf(const Args& a, const float* gvec, int l, int jshift, int jscale, int tid, int lane, int wave, int G) {
    bf16* h = (bf16*)(a.ws + WS_H); const bf16* xr = (const bf16*)(a.ws + WS_XR);
    for (int blk = blockIdx.x; blk < 256; blk += G) {
        const int b = blk >> 5;
        float gs[16], sh[16];
#pragma unroll
        for (int j = 0; j < 2; ++j)
#pragma unroll
            for (int i = 0; i < 8; ++i) { const int col = lane * 8 + 512 * j + i; gs[8 * j + i] = gvec[col] * (1.0f + modval<false>(a, l, b, jscale * 1024 + col)); sh[8 * j + i] = modval<false>(a, l, b, jshift * 1024 + col); }
        const bf16* xb = xr + (size_t)blk * 128 * 1024 + lane * 8;
        v4u n0 = *(const v4u*)(xb + (size_t)wave * 1024), n1 = *(const v4u*)(xb + (size_t)wave * 1024 + 512);
        for (int r = wave; r < 128; r += 8) {
            float x[16]; unpack8(n0, x, 0); unpack8(n1, x, 8);
            if (r + 8 < 128) { n0 = *(const v4u*)(xb + (size_t)(r + 8) * 1024); n1 = *(const v4u*)(xb + (size_t)(r + 8) * 1024 + 512); }
            float ss = 0.f;
#pragma unroll
            for (int i = 0; i < 16; ++i) ss += x[i] * x[i];
            const float inv = 1.0f / sqrtf(wave_sum(ss) * (1.0f / 1024.0f) + EPS);
            bf16* ho = h + ((size_t)blk * 128 + r) * 1024 + lane * 8;
#pragma unroll
            for (int j = 0; j < 2; ++j) { v4u w;
#pragma unroll
                for (int i = 0; i < 4; ++i) w[i] = pk2(x[8 * j + 2 * i] * inv * gs[8 * j + 2 * i] + sh[8 * j + 2 * i], x[8 * j + 2 * i + 1] * inv * gs[8 * j + 2 * i + 1] + sh[8 * j + 2 * i + 1]);
                *(v4u*)(ho + 512 * j) = w; }
        }
    }
}
__device__ __forceinline__ void phase_final_norm(const Args& a, int lane, int wave, int G) {
    const float* g = a.in[21]; const bf16* xr = (const bf16*)(a.ws + WS_XR);
    float gs[16];
#pragma unroll
    for (int j = 0; j < 2; ++j)
#pragma unroll
        for (int i = 0; i < 8; ++i) gs[8 * j + i] = g[lane * 8 + 512 * j + i];
    int m = blockIdx.x * 8 + wave;
    v4u n0 = (v4u){0u, 0u, 0u, 0u}, n1 = n0;
    if (m < M) { n0 = *(const v4u*)(xr + (size_t)m * 1024 + lane * 8); n1 = *(const v4u*)(xr + (size_t)m * 1024 + lane * 8 + 512); }
    for (; m < M; m += G * 8) {
        float x[16]; unpack8(n0, x, 0); unpack8(n1, x, 8);
        if (m + G * 8 < M) { n0 = *(const v4u*)(xr + (size_t)(m + G * 8) * 1024 + lane * 8); n1 = *(const v4u*)(xr + (size_t)(m + G * 8) * 1024 + lane * 8 + 512); }
        float ss = 0.f;
#pragma unroll
        for (int i = 0; i < 16; ++i) ss += x[i] * x[i];
        const float inv = 1.0f / sqrtf(wave_sum(ss) * (1.0f / 1024.0f) + EPS);
        float* o = a.out + (size_t)m * 1024 + lane * 8;
#pragma unroll
        for (int j = 0; j < 2; ++j) {
            *(f32x4*)(o + 512 * j) = (f32x4){x[8 * j] * inv * gs[8 * j], x[8 * j + 1] * inv * gs[8 * j + 1], x[8 * j + 2] * inv * gs[8 * j + 2], x[8 * j + 3] * inv * gs[8 * j + 3]};
            *(f32x4*)(o + 512 * j + 4) = (f32x4){x[8 * j + 4] * inv * gs[8 * j + 4], x[8 * j + 5] * inv * gs[8 * j + 5], x[8 * j + 6] * inv * gs[8 * j + 6], x[8 * j + 7] * inv * gs[8 * j + 7]};
        }
    }
}

__device__ __forceinline__ void conv_mixer(const Args& a, int tid, int G) {
    const bf16* p = (const bf16*)(a.ws + WS_P); bf16* y = (bf16*)(a.ws + WS_H);
    const float* cw = a.in[7]; const float* cb = a.in[8];
    for (int it = blockIdx.x * NT + tid; it < M * 64; it += G * NT) {
        const int m = it >> 6, c0 = (it & 63) * 8, t = m & (SEQ - 1);
        const bf16* pr = p + (size_t)m * NIN0 + c0;
        float conv[8];
#pragma unroll
        for (int i = 0; i < 8; ++i) conv[i] = cb[c0 + i];
#pragma unroll
        for (int tap = 0; tap < 3; ++tap) {
            const int dt = 2 - tap;
            if (t - dt >= 0) {
                const v4u cc = *(const v4u*)(pr - (size_t)dt * NIN0 + 512), hh = *(const v4u*)(pr - (size_t)dt * NIN0 + 1024);
#pragma unroll
                for (int i = 0; i < 4; ++i) {
                    conv[2 * i] += cw[tap * 512 + c0 + 2 * i] * (bflo(cc[i]) * bflo(hh[i]));
                    conv[2 * i + 1] += cw[tap * 512 + c0 + 2 * i + 1] * (bfhi(cc[i]) * bfhi(hh[i]));
                }
            }
        }
        const v4u bb = *(const v4u*)pr;
        v4u o;
#pragma unroll
        for (int i = 0; i < 4; ++i) o[i] = pk2(bflo(bb[i]) * conv[2 * i], bfhi(bb[i]) * conv[2 * i + 1]);
        *(v4u*)(y + (size_t)m * 1024 + c0) = o;
    }
}
constexpr int HP = 272;
constexpr int HG_SEG = 0, HG_QD = 2048, HG_QR = 19456, HG_KR = 36864, HG_V = 54272, HG_S = 71680, HG_P = 106496, HG_O = 19456;
constexpr int PP = 144;
constexpr int OP = 528;
__device__ __forceinline__ void hg_cum(const Args& a, LAS unsigned char* lds, int tid, int m0, int h, float (&cum)[16], float (&kk)[16], float& mid, float& last) {
    const int k = tid & 127, seg = tid >> 7, ch = h * 128 + k;
    const float* lbp = a.in[9];
    const float l0 = lbp[ch], l1 = lbp[512 + ch], l2 = lbp[1024 + ch], mx = fmaxf(l0, fmaxf(l1, l2));
    const float e0 = __expf(l0 - mx), e1 = __expf(l1 - mx), e2 = __expf(l2 - mx), lb = e0 / (e0 + e1 + e2);
    const bf16* p = (const bf16*)(a.ws + WS_P) + (size_t)(m0 + seg * 16) * NIN0 + 2048 + ch;
    float run = 0.f;
#pragma unroll
    for (int i = 0; i < 16; ++i) { const float x = bf2f(p[(size_t)i * NIN0]); const float f = lb + (1.0f - lb) * sigmoidf_(x); run += __logf(f); cum[i] = run; kk[i] = 1.0f - f; }
    LAS float* st = (LAS float*)(lds + HG_SEG);
    st[seg * 128 + k] = run;
    __syncthreads();
    const float s0 = st[k], s1 = st[128 + k], s2 = st[256 + k], s3 = st[384 + k];
    const float off = seg == 0 ? 0.f : (seg == 1 ? s0 : (seg == 2 ? s0 + s1 : s0 + s1 + s2));
    mid = s0 + s1; last = (s0 + s1) + (s2 + s3);
#pragma unroll
    for (int i = 0; i < 16; ++i) cum[i] += off;
}
__device__ __forceinline__ void load_tile128(LAS unsigned char* dst, const bf16* src, size_t src_pitch, int rows, int tid) {
    for (int id = tid; id < rows * 16; id += NT) { const int r = id >> 4, c = id & 15; *(LAS v4u*)(dst + r * HP + c * 16) = *(const v4u*)(src + (size_t)r * src_pitch + c * 8); }
}
__device__ __forceinline__ void hg_pass_a(const Args& a, LAS unsigned char* lds, int tid, int lane, int wave, int G) {
    const bf16* p = (const bf16*)(a.ws + WS_P);
    float* loc = a.out; float* dec = (float*)(a.ws + WS_DEC);
    for (int unit = blockIdx.x; unit < 2048; unit += G) {
        const int b = unit >> 8, h = (unit >> 6) & 3, c = unit & 63, m0 = b * SEQ + c * 64;
        float cum[16], kk[16], mid, last;
        hg_cum(a, lds, tid, m0, h, cum, kk, mid, last);
        const int k = tid & 127, seg = tid >> 7;
#pragma unroll
        for (int i = 0; i < 16; ++i) *(LAS unsigned short*)(lds + HG_KR + (seg * 16 + i) * HP + k * 2) = f2bf(kk[i] * __expf(last - cum[i]));
        if (seg == 0) dec[unit * 128 + k] = __expf(last);
        load_tile128(lds + HG_V, p + (size_t)m0 * NIN0 + 2560 + h * 128, NIN0, 64, tid);
        __syncthreads();
        f32x4 acc[8];
#pragma unroll
        for (int n = 0; n < 8; ++n) acc[n] = (f32x4){0.f, 0.f, 0.f, 0.f};
#pragma unroll
        for (int ks = 0; ks < 2; ++ks) {
            const bf16x8 A = trfrag(lds + HG_KR, HP, 32 * ks, 16 * wave, lane);
#pragma unroll
            for (int n = 0; n < 8; ++n) { const bf16x8 B = trfrag(lds + HG_V, HP, 32 * ks, 16 * n, lane); acc[n] = MFMA16(A, B, acc[n]); }
        }
        const int fr = lane & 15, fq = lane >> 4;
        float* lo = loc + (size_t)unit * 16384 + (16 * wave + 4 * fq) * 128 + fr;
#pragma unroll
        for (int n = 0; n < 8; ++n)
#pragma unroll
            for (int r = 0; r < 4; ++r) lo[r * 128 + 16 * n] = acc[n][r];
        __syncthreads();
    }
}
__device__ __forceinline__ void hg_pass_b(const Args& a, int tid, int G) {
    const float* loc = a.out; const float* dec = (const float*)(a.ws + WS_DEC); bf16* st = (bf16*)(a.ws + WS_S);
    for (int idx = blockIdx.x * NT + tid; idx < 32 * 128 * 32; idx += G * NT) {
        const int bh = idx >> 12, k = (idx >> 5) & 127, v4 = idx & 31;
        f32x4 S = (f32x4){0.f, 0.f, 0.f, 0.f};
        const size_t e0 = (size_t)bh * 64 * 16384 + k * 128 + v4 * 4;
#pragma unroll 8
        for (int c = 0; c < 64; ++c) {
            const f32x4 L = *(const f32x4*)(loc + e0 + (size_t)c * 16384); const float d = dec[(bh * 64 + c) * 128 + k];
            v2u w; w.x = pk2(S.x, S.y); w.y = pk2(S.z, S.w);
            *(v2u*)(st + e0 + (size_t)c * 16384) = w;
            S = S * d + L;
        }
    }
}
__device__ __forceinline__ void hg_pass_c(const Args& a, LAS unsigned char* lds, int tid, int lane, int wave, int G) {
    const bf16* p = (const bf16*)(a.ws + WS_P); const bf16* stg = (const bf16*)(a.ws + WS_S); bf16* y = (bf16*)(a.ws + WS_H);
    const float* gain = a.in[10];
    const int fr = lane & 15, fq = lane >> 4;
    for (int unit = blockIdx.x; unit < 2048; unit += G) {
        const int b = unit >> 8, h = (unit >> 6) & 3, c = unit & 63, m0 = b * SEQ + c * 64;
        {
            float cum[16], kk[16], mid, last;
            hg_cum(a, lds, tid, m0, h, cum, kk, mid, last);
            const int k = tid & 127, seg = tid >> 7;
            const bf16* qp = p + (size_t)(m0 + seg * 16) * NIN0 + 1536 + h * 128 + k;
#pragma unroll
            for (int i = 0; i < 16; ++i) {
                const float q = bf2f(qp[(size_t)i * NIN0]);
                const int o = (seg * 16 + i) * HP + k * 2;
                *(LAS unsigned short*)(lds + HG_QD + o) = f2bf(q * __expf(cum[i]));
                *(LAS unsigned short*)(lds + HG_QR + o) = f2bf(q * __expf(fminf(cum[i] - mid, 80.f)));
                *(LAS unsigned short*)(lds + HG_KR + o) = f2bf(kk[i] * __expf(fminf(mid - cum[i], 80.f)));
            }
        }
        load_tile128(lds + HG_V, p + (size_t)m0 * NIN0 + 2560 + h * 128, NIN0, 64, tid);
        load_tile128(lds + HG_S, stg + (size_t)unit * 16384, 128, 128, tid);
        __syncthreads();
        {
            const int tt = wave >> 1;
#pragma unroll
            for (int j = 0; j < 2; ++j) {
                const int stl = (wave & 1) * 2 + j;
                f32x4 sc = (f32x4){0.f, 0.f, 0.f, 0.f};
                if (stl <= tt) {
#pragma unroll
                    for (int ks = 0; ks < 4; ++ks) sc = MFMA16(rowfrag(lds + HG_QR, HP, 16 * tt, 32 * ks, fr, fq), rowfrag(lds + HG_KR, HP, 16 * stl, 32 * ks, fr, fq), sc);
                }
#pragma unroll
                for (int r = 0; r < 4; ++r) { const int t = 16 * tt + 4 * fq + r, s = 16 * stl + fr;
                    *(LAS unsigned short*)(lds + HG_P + t * PP + s * 2) = f2bf(s <= t ? sc[r] : 0.f); }
            }
        }
        __syncthreads();
        {
            const int tt = wave >> 1, n0 = (wave & 1) * 4;
            f32x4 acc[4];
#pragma unroll
            for (int n = 0; n < 4; ++n) acc[n] = (f32x4){0.f, 0.f, 0.f, 0.f};
#pragma unroll
            for (int ks = 0; ks < 4; ++ks) { const bf16x8 A = rowfrag(lds + HG_QD, HP, 16 * tt, 32 * ks, fr, fq);
#pragma unroll
                for (int n = 0; n < 4; ++n) acc[n] = MFMA16(A, trfrag(lds + HG_S, HP, 32 * ks, 16 * (n0 + n), lane), acc[n]); }
#pragma unroll
            for (int ks = 0; ks < 2; ++ks) { const bf16x8 A = rowfrag(lds + HG_P, PP, 16 * tt, 32 * ks, fr, fq);
#pragma unroll
                for (int n = 0; n < 4; ++n) acc[n] = MFMA16(A, trfrag(lds + HG_V, HP, 32 * ks, 16 * (n0 + n), lane), acc[n]); }
#pragma unroll
            for (int n = 0; n < 4; ++n)
#pragma unroll
                for (int r = 0; r < 4; ++r) *(LAS float*)(lds + HG_O + (16 * tt + 4 * fq + r) * OP + (16 * (n0 + n) + fr) * 4) = acc[n][r];
        }
        __syncthreads();
        {
            const int t = tid >> 3, part = tid & 7, v0 = part * 16;
            f32x4 o[4]; float ss = 0.f;
#pragma unroll
            for (int j = 0; j < 4; ++j) { o[j] = *(LAS const f32x4*)(lds + HG_O + t * OP + (v0 + 4 * j) * 4); ss += (o[j].x * o[j].x + o[j].y * o[j].y) + (o[j].z * o[j].z + o[j].w * o[j].w); }
            ss += __shfl_xor(ss, 1); ss += __shfl_xor(ss, 2); ss += __shfl_xor(ss, 4);
            const float inv = 1.0f / sqrtf(ss * (1.0f / 128.0f) + EPS);
            const bf16* gp = p + (size_t)(m0 + t) * NIN0 + 3072 + h * 128 + v0;
            const v4u g0 = *(const v4u*)gp, g1 = *(const v4u*)(gp + 8);
            const float* gn = gain + h * 128 + v0;
            v4u w0, w1;
#pragma unroll
            for (int i = 0; i < 4; ++i) {
                const float ga = bflo(g0[i]), gb = bfhi(g0[i]), gc = bflo(g1[i]), gd = bfhi(g1[i]);
                const int e = 2 * i;
                const float oa = o[e >> 2][e & 3], ob = o[(e + 1) >> 2][(e + 1) & 3], oc = o[(8 + e) >> 2][(8 + e) & 3], od = o[(9 + e) >> 2][(9 + e) & 3];
                w0[i] = pk2(oa * inv * gn[e] * siluf_(ga), ob * inv * gn[e + 1] * siluf_(gb));
                w1[i] = pk2(oc * inv * gn[8 + e] * siluf_(gc), od * inv * gn[9 + e] * siluf_(gd));
            }
            bf16* yo = y + (size_t)(m0 + t) * 1024 + 512 + h * 128 + v0;
            *(v4u*)yo = w0; *(v4u*)(yo + 8) = w1;
        }
        __syncthreads();
    }
}

constexpr int SG_STAT = 0, SG_W = 1024, SG_V = 35840, SGVP = 528;
__device__ __forceinline__ void phase_sgu(const Args& a, LAS unsigned char* lds, int tid, int lane, int wave, int G) {
    const bf16* z = (const bf16*)(a.ws + WS_P); bf16* y = (bf16*)(a.ws + WS_H);
    const float* lng = a.in[14]; const float* lnb = a.in[15]; const float* ws = a.in[16]; const float* bs = a.in[17];
    const int fr = lane & 15, fq = lane >> 4;
    for (int unit = blockIdx.x; unit < 256; unit += G) {
        const int m0 = unit * 128;
        LAS float* stt = (LAS float*)(lds + SG_STAT);
        for (int r = wave; r < 128; r += 8) {
            const bf16* vr = z + (size_t)(m0 + r) * NIN1 + 1024 + lane * 8;
            const v4u a0 = *(const v4u*)vr, a1 = *(const v4u*)(vr + 512);
            float x[16];
#pragma unroll
            for (int i = 0; i < 4; ++i) { x[2 * i] = bflo(a0[i]); x[2 * i + 1] = bfhi(a0[i]); x[8 + 2 * i] = bflo(a1[i]); x[9 + 2 * i] = bfhi(a1[i]); }
            float s = 0.f;
#pragma unroll
            for (int i = 0; i < 16; ++i) s += x[i];
            const float mean = wave_sum(s) * (1.0f / 1024.0f);
            float q = 0.f;
#pragma unroll
            for (int i = 0; i < 16; ++i) { const float d = x[i] - mean; q += d * d; }
            const float rstd = 1.0f / sqrtf(wave_sum(q) * (1.0f / 1024.0f) + EPS);
            if (lane == 0) { stt[2 * r] = mean; stt[2 * r + 1] = rstd; }
        }
        __syncthreads();
        for (int g = 0; g < 4; ++g) {
            {
                const int t = tid >> 2, s0 = (tid & 3) * 32;
                const float* wr = ws + (size_t)g * 16384 + t * 128 + s0;
#pragma unroll
                for (int j = 0; j < 4; ++j) {
                    const f32x4 w0 = *(const f32x4*)(wr + 8 * j), w1 = *(const f32x4*)(wr + 8 * j + 4);
                    const int s = s0 + 8 * j;
                    v4u o;
                    o.x = pk2(s + 0 <= t ? w0.x : 0.f, s + 1 <= t ? w0.y : 0.f); o.y = pk2(s + 2 <= t ? w0.z : 0.f, s + 3 <= t ? w0.w : 0.f);
                    o.z = pk2(s + 4 <= t ? w1.x : 0.f, s + 5 <= t ? w1.y : 0.f); o.w = pk2(s + 6 <= t ? w1.z : 0.f, s + 7 <= t ? w1.w : 0.f);
                    *(LAS v4u*)(lds + SG_W + t * HP + s * 2) = o;
                }
            }
#pragma unroll 2
            for (int i = 0; i < 8; ++i) {
                const int id = tid + NT * i, s = id >> 5, dc = (id & 31) * 8, col = g * 256 + dc;
                const v4u vv = *(const v4u*)(z + (size_t)(m0 + s) * NIN1 + 1024 + col);
                const float mean = stt[2 * s], rstd = stt[2 * s + 1];
                const f32x4 g0 = *(const f32x4*)(lng + col), g1 = *(const f32x4*)(lng + col + 4), b0 = *(const f32x4*)(lnb + col), b1 = *(const f32x4*)(lnb + col + 4);
                v4u o;
                o.x = pk2((bflo(vv.x) - mean) * rstd * g0.x + b0.x, (bfhi(vv.x) - mean) * rstd * g0.y + b0.y);
                o.y = pk2((bflo(vv.y) - mean) * rstd * g0.z + b0.z, (bfhi(vv.y) - mean) * rstd * g0.w + b0.w);
                o.z = pk2((bflo(vv.z) - mean) * rstd * g1.x + b1.x, (bfhi(vv.z) - mean) * rstd * g1.y + b1.y);
                o.w = pk2((bflo(vv.w) - mean) * rstd * g1.z + b1.z, (bfhi(vv.w) - mean) * rstd * g1.w + b1.w);
                *(LAS v4u*)(lds + SG_V + s * SGVP + dc * 2) = o;
            }
            __syncthreads();
            f32x4 acc[16];
#pragma unroll
            for (int n = 0; n < 16; ++n) acc[n] = (f32x4){0.f, 0.f, 0.f, 0.f};
            for (int ks = 0; ks < 4; ++ks) {
                if (32 * ks > 16 * wave + 15) break;
                const bf16x8 A = rowfrag(lds + SG_W, HP, 16 * wave, 32 * ks, fr, fq);
#pragma unroll
                for (int n = 0; n < 16; ++n) acc[n] = MFMA16(A, trfrag(lds + SG_V, SGVP, 32 * ks, 16 * n, lane), acc[n]);
            }
            __syncthreads();
#pragma unroll
            for (int r = 0; r < 4; ++r) {
                const int t = 16 * wave + 4 * fq + r; const float bsv = bs[g * 128 + t];
#pragma unroll
                for (int n = 0; n < 16; ++n) *(LAS unsigned short*)(lds + SG_V + t * SGVP + (16 * n + fr) * 2) = f2bf(acc[n][r] + bsv);
            }
            __syncthreads();
#pragma unroll 4
            for (int i = 0; i < 8; ++i) {
                const int id = tid + NT * i, t = id >> 5, dc = (id & 31) * 8;
                const v4u mx = *(LAS const v4u*)(lds + SG_V + t * SGVP + dc * 2);
                const v4u uu = *(const v4u*)(z + (size_t)(m0 + t) * NIN1 + g * 256 + dc);
                v4u o;
#pragma unroll
                for (int j = 0; j < 4; ++j) o[j] = pk2(bflo(mx[j]) * bflo(uu[j]), bfhi(mx[j]) * bfhi(uu[j]));
                *(v4u*)(y + (size_t)(m0 + t) * 1024 + g * 256 + dc) = o;
            }
            __syncthreads();
        }
    }
}

#ifndef MK_N_LAUNCHES
#define MK_N_LAUNCHES 1
#endif

__global__ void __launch_bounds__(512, 2) fwd(Args a) {
    extern __shared__ __attribute__((aligned(16))) unsigned char lds_raw[];
    LAS unsigned char* lds = (LAS unsigned char*)lds_raw;
    cg::grid_group grid = cg::this_grid();
    volatile LAS unsigned* MISC = (volatile LAS unsigned*)(lds + MISC_OFF);
    if (threadIdx.x < 16) MISC[threadIdx.x] = 0u;
    __syncthreads();
    const XcdBarrier xbar = xcd_barrier_post((unsigned*)(a.ws + WS_BAR), MISC + 8);
    const int lo = a.ph_lo, hi = a.ph_hi;
#define IN(k) (lo <= (k) && (k) < hi)
#ifndef DBL_MASK
#define DBL_MASK 0
#endif
#define REP(k) _Pragma("unroll 1") for (int rep_ = 0; rep_ <= ((DBL_MASK >> (k)) & 1); ++rep_)
#define SEAM(k) do { if (IN(k) && IN((k) + 1)) { xcd_barrier(xbar); } } while (0)
#define PHASE_VARS int tid = threadIdx.x; asm volatile("" : "+v"(tid)); int G = gridDim.x; asm volatile("" : "+s"(G)); \
    const int lane = tid & 63, wave = __builtin_amdgcn_readfirstlane(tid >> 6); (void)lane; (void)wave; \
    bf16* const H = (bf16*)(a.ws + WS_H); bf16* const P = (bf16*)(a.ws + WS_P); const float* const modf = (const float*)(a.ws + WS_MODF); (void)H; (void)P; (void)modf;
#define GEMM_RES(ph, l, ffn) if (IN(ph)) REP(ph) { PHASE_VARS \
        const bf16* Bt = (ffn) ? (const bf16*)(a.ws + WS_WFF2) + (size_t)(l) * 1024 * 4096 : (const bf16*)(a.ws + ((l) ? WS_WOUT1 : WS_WOUT0)); \
        pg8::Gemm g{(ffn) ? P : H, Bt, M, 1024, (ffn) ? 4096 : 1024}; pg8::StaticOrder S; S.init(M, 1024, G, (int)blockIdx.x); \
        if ((ph) == 6) { pg8::EpiResGateBf<true> E{a.in[0], (bf16*)(a.ws + WS_XR), modf + (size_t)(l) * 8 * 6144 + ((ffn) ? 5 : 2) * 1024}; \
            pg8::gemm_phase<pg8::EpiResGateBf<true>, pg8::StaticOrder, true, true>(lds, g, S, E); } \
        else { pg8::EpiResGateBf<false> E{a.ws + WS_XR, (bf16*)(a.ws + WS_XR), modf + (size_t)(l) * 8 * 6144 + ((ffn) ? 5 : 2) * 1024}; \
            pg8::gemm_phase<pg8::EpiResGateBf<false>, pg8::StaticOrder, true, true>(lds, g, S, E); } } SEAM(ph);
#define GEMM_FF1(ph, l) if (IN(ph)) REP(ph) { PHASE_VARS \
        pg8::Gemm g{H, (const bf16*)(a.ws + WS_WFF1) + (size_t)(l) * 4096 * 1024, M, FF, 1024}; pg8::StaticOrder S; S.init(M, FF, G, (int)blockIdx.x); \
        pg8::EpiBf16<2> E{P, FF, nullptr}; \
        pg8::gemm_phase<pg8::EpiBf16<2>, pg8::StaticOrder, true, true>(lds, g, S, E); } SEAM(ph);
#define NORM(ph, l, ffn) if (IN(ph)) REP(ph) { PHASE_VARS \
        phase_norm_bf(a, ((ffn) ? a.in[5] : a.in[4]) + (l) * 1024, (l), (ffn) ? 3 : 0, (ffn) ? 4 : 1, tid, lane, wave, G); } SEAM(ph);

    if (a.ph_hi > NPH) grid.sync();
    if (IN(0)) REP(0) { PHASE_VARS phase_prologue(a, lds, tid, lane, wave, G); } SEAM(0);
    if (IN(1)) REP(1) { PHASE_VARS phase_norm<true>(a, a.in[0], a.in[4], 0, 0, 1, tid, lane, wave, G); } SEAM(1);
    if (IN(2)) REP(2) { PHASE_VARS
        pg8::Gemm g{H, (const bf16*)(a.ws + WS_WIN0), M, NIN0, 1024}; pg8::StaticOrder S; S.init(M, NIN0, G, (int)blockIdx.x);
        pg8::EpiBf16<0> E{P, NIN0, nullptr};
        pg8::gemm_phase<pg8::EpiBf16<0>, pg8::StaticOrder, true, true>(lds, g, S, E); } SEAM(2);
    if (IN(3)) REP(3) { PHASE_VARS conv_mixer(a, tid, G); hg_pass_a(a, lds, tid, lane, wave, G); } SEAM(3);
    if (IN(4)) REP(4) { PHASE_VARS hg_pass_b(a, tid, G); } SEAM(4);
    if (IN(5)) REP(5) { PHASE_VARS hg_pass_c(a, lds, tid, lane, wave, G); } SEAM(5);
    GEMM_RES(6, 0, false)
    NORM(7, 0, true)
    GEMM_FF1(8, 0)
    GEMM_RES(9, 0, true)
    NORM(10, 1, false)
    if (IN(11)) REP(11) { PHASE_VARS
        pg8::Gemm g{H, (const bf16*)(a.ws + WS_WIN1), M, NIN1, 1024}; pg8::StaticOrder S; S.init(M, NIN1, G, (int)blockIdx.x);
        pg8::EpiBf16<1> E{P, NIN1, a.in[13]};
        pg8::gemm_phase<pg8::EpiBf16<1>, pg8::StaticOrder, true, true>(lds, g, S, E); } SEAM(11);
    if (IN(12)) REP(12) { PHASE_VARS phase_sgu(a, lds, tid, lane, wave, G); } SEAM(12);
    GEMM_RES(13, 1, false)
    NORM(14, 1, true)
    GEMM_FF1(15, 1)
    GEMM_RES(16, 1, true)
    if (IN(17)) REP(17) { PHASE_VARS phase_final_norm(a, lane, wave, G); }
}
}

extern "C" void kernel_launch(void* const* d_in, const int* in_sizes, int n_in, void* d_out, int out_size, void* d_ws, size_t ws_size, hipStream_t stream) {
    using namespace mk;
    static int grid = 0;
    if (grid == 0) {
        if (n_in != 22 || out_size != M * D || ws_size < WS_END) { fprintf(stderr, "kernel_launch: unexpected shapes (n_in %d out %d ws %zu)\n", n_in, out_size, ws_size); grid = -1; return; }
        int dev = 0, cus = 0, per_cu = 0;
        (void)hipGetDevice(&dev); (void)hipDeviceGetAttribute(&cus, hipDeviceAttributeMultiprocessorCount, dev);
        if (hipFuncSetAttribute((const void*)fwd, hipFuncAttributeMaxDynamicSharedMemorySize, LDS_BYTES) != hipSuccess) fprintf(stderr, "kernel_launch: hipFuncSetAttribute failed\n");
        if (hipOccupancyMaxActiveBlocksPerMultiprocessor(&per_cu, (const void*)fwd, NT, LDS_BYTES) != hipSuccess || per_cu < 1) { fprintf(stderr, "kernel_launch: occupancy query says %d\n", per_cu); per_cu = 1; }
        (void)hipGetLastError();
        grid = cus * per_cu;
        if (grid <= 0) grid = 256;
    }
    if (grid < 0) return;
    if (hipMemsetAsync((char*)d_ws + WS_BAR, 0, BAR_ZERO_BYTES, stream) != hipSuccess) fprintf(stderr, "kernel_launch: memset of barrier words failed\n");
    Args a{};
    for (int i = 0; i < 22; ++i) a.in[i] = (const float*)d_in[i];
    a.out = (float*)d_out; a.ws = (unsigned char*)d_ws;
#if MK_N_LAUNCHES == 1
    a.ph_lo = 0; a.ph_hi = NPH;
    void* args[] = {&a};
    hipError_t e = hipLaunchCooperativeKernel((const void*)fwd, dim3(grid), dim3(NT), args, LDS_BYTES, stream);
    if (e != hipSuccess) fprintf(stderr, "cooperative launch failed: %s (grid %d)\n", hipGetErrorString(e), grid);
#else
    for (int ph = 0; ph < NPH; ++ph) {
        a.ph_lo = ph; a.ph_hi = ph + 1;
        hipLaunchKernelGGL(fwd, dim3(grid), dim3(NT), LDS_BYTES, stream, a);
    }
#endif
}
```

```cpp
#include <hip/hip_runtime.h>
#include <hip/hip_cooperative_groups.h>
#include <cstdio>
#include <cstdint>
namespace cg = cooperative_groups;
namespace pg8 {
#define PG8_LAS __attribute__((address_space(3)))
typedef unsigned short bf16_t;
typedef short bf16x8 __attribute__((ext_vector_type(8)));
typedef float f32x4 __attribute__((ext_vector_type(4)));
typedef unsigned u32x4 __attribute__((ext_vector_type(4)));
constexpr int BM = 256, BK = 64, HALF = 128, HTB = HALF * BK * 2  , STAGE_BYTES = 8 * HTB, NXCD = 8, WGM = 8;

__host__ __device__ __forceinline__ int lds_byte(int r, int c) { const int st = (r >> 4) * 2 + (c >> 5), rr = r & 15, cc = c & 31, ob = rr * 64 + cc * 2; return st * 1024 + (ob ^ (((ob >> 9) & 1) << 5)); }
__host__ __device__ __forceinline__ void stage_rc(int b, int& R, int& C) { const int st = b / 1024, sb = b % 1024, swz = sb ^ (((sb >> 9) & 1) << 5); R = (st >> 1) * 16 + swz / 64; C = (st & 1) * 32 + (swz % 64) / 2; }
__host__ __device__ __forceinline__ int perm32(int rho) { const int n = rho >> 4, i = rho & 15; return 8 * (i >> 2) + 4 * n + (i & 3); }

struct Unit { int pm, pn; };
struct Gemm { const bf16_t* A; const bf16_t* Bt; int M, N, K; };

struct StaticOrder {
    int nM, nN, nwg, G, c;
    __host__ __device__ void init(int M, int N, int G_, int c_) { nM = M / BM; nN = N / BM; nwg = nM * nN; G = G_; c = c_; }
    __host__ __device__ bool next(int i, Unit& u) const {
        const long L = (long)i * G + c; if (L >= nwg) return false;
        int wgid = (int)L; { const int q = nwg / NXCD, r = nwg % NXCD, xcd = wgid % NXCD, off = wgid / NXCD; wgid = (xcd < r ? xcd * (q + 1) : r * (q + 1) + (xcd - r) * q) + off; }
        const int nig = WGM * nN, gid = wgid / nig, fm = gid * WGM, gsz = (nM - fm) < WGM ? (nM - fm) : WGM;
        u.pm = fm + ((wgid % nig) % gsz); u.pn = (wgid % nig) / gsz; return true;
    }
    __device__ __forceinline__ void a_ready(const Unit&) const {}
    __device__ __forceinline__ void done(const Unit&) const {}
};

typedef float f32x2c_t __attribute__((ext_vector_type(2)));
typedef __bf16 bf16x2c_t __attribute__((ext_vector_type(2)));
__device__ __forceinline__ unsigned cvt_pk_bf16(float lo, float hi) { const f32x2c_t v = {lo, hi}; const bf16x2c_t b = __builtin_convertvector(v, bf16x2c_t); return __builtin_bit_cast(unsigned, b); }
typedef float f32x2 __attribute__((ext_vector_type(2)));
__device__ __forceinline__ float gelu_tanh(float x) {
    const float u = 0.7978845608f * (x + 0.044715f * x * x * x);
    const float e = __builtin_amdgcn_exp2f(-2.0f * 1.4426950408889634f * u);
    return x * __builtin_amdgcn_rcpf(1.0f + e);
}
template <int ACT> struct EpiBf16 {
    static constexpr bool PERM = true, AFTER_DRAIN = false;
    bf16_t* O; int ldc; const float* bias;
    __device__ __forceinline__ void operator()(const f32x4 (&acc)[2][2][4][2], const Unit& u, int wr, int wc, int fr, int fq) const {
        const int row0 = u.pm * BM + wr * 64 + fr; const int col0 = u.pn * BM + wc * 32 + 8 * fq;
        f32x4 bv[2][2];
#pragma unroll
        for (int bj = 0; bj < 2; ++bj)
#pragma unroll
            for (int n = 0; n < 2; ++n) bv[bj][n] = bias ? *(const f32x4*)(bias + col0 + bj * HALF + 4 * n) : (f32x4){0.f, 0.f, 0.f, 0.f};
#pragma unroll
        for (int ai = 0; ai < 2; ++ai)
#pragma unroll
            for (int m = 0; m < 4; ++m) { bf16_t* rowp = O + (size_t)(row0 + ai * HALF + m * 16) * ldc + col0;
#pragma unroll
                for (int bj = 0; bj < 2; ++bj) { f32x4 v0 = acc[ai][bj][m][0] + bv[bj][0], v1 = acc[ai][bj][m][1] + bv[bj][1];
                    if (ACT == 1) {
#pragma unroll
                        for (int i = 0; i < 4; ++i) { v0[i] = gelu_tanh(v0[i]); v1[i] = gelu_tanh(v1[i]); } }
                    if (ACT == 2) {
#pragma unroll
                        for (int i = 0; i < 4; ++i) { const float a = fmaxf(v0[i], 0.f), b = fmaxf(v1[i], 0.f); v0[i] = a * a; v1[i] = b * b; } }
                    u32x4 w; w.x = cvt_pk_bf16(v0[0], v0[1]); w.y = cvt_pk_bf16(v0[2], v0[3]); w.z = cvt_pk_bf16(v1[0], v1[1]); w.w = cvt_pk_bf16(v1[2], v1[3]);
                    *(u32x4*)(rowp + bj * HALF) = w; } }
    }
};
struct EpiResGate {
    static constexpr bool PERM = false, AFTER_DRAIN = false;
    const float* base; float* out; const float* gate;
    __device__ __forceinline__ void operator()(const f32x4 (&acc)[2][2][4][2], const Unit& u, int wr, int wc, int fr, int fq) const {
        const int row0 = u.pm * BM + wr * 64 + fr; const int col0 = u.pn * BM + wc * 32 + 4 * fq; const int b = u.pm >> 4;
        f32x4 gv[2][2];
#pragma unroll
        for (int bj = 0; bj < 2; ++bj)
#pragma unroll
            for (int n = 0; n < 2; ++n) gv[bj][n] = *(const f32x4*)(gate + (size_t)b * 6144 + col0 + bj * HALF + n * 16);
#pragma unroll
        for (int ai = 0; ai < 2; ++ai) {
            f32x4 bs[4][2][2];
#pragma unroll
            for (int m = 0; m < 4; ++m) { const size_t off = (size_t)(row0 + ai * HALF + m * 16) * 1024 + col0;
#pragma unroll
                for (int bj = 0; bj < 2; ++bj)
#pragma unroll
                    for (int n = 0; n < 2; ++n) bs[m][bj][n] = *(const f32x4*)(base + off + bj * HALF + n * 16); }
#pragma unroll
            for (int m = 0; m < 4; ++m) { const size_t off = (size_t)(row0 + ai * HALF + m * 16) * 1024 + col0;
#pragma unroll
                for (int bj = 0; bj < 2; ++bj)
#pragma unroll
                    for (int n = 0; n < 2; ++n) *(f32x4*)(out + off + bj * HALF + n * 16) = bs[m][bj][n] + gv[bj][n] * acc[ai][bj][m][n]; }
            asm volatile("" ::: "memory"); }
    }
};
template <bool BASE_F32> struct EpiResGateBf {
    static constexpr bool PERM = true, AFTER_DRAIN = false;
    const void* base; bf16_t* out; const float* gate;
    __device__ __forceinline__ void operator()(const f32x4 (&acc)[2][2][4][2], const Unit& u, int wr, int wc, int fr, int fq) const {
        const int row0 = u.pm * BM + wr * 64 + fr; const int col0 = u.pn * BM + wc * 32 + 8 * fq; const int b = u.pm >> 4;
        f32x4 gv[2][2];
#pragma unroll
        for (int bj = 0; bj < 2; ++bj)
#pragma unroll
            for (int n = 0; n < 2; ++n) gv[bj][n] = *(const f32x4*)(gate + (size_t)b * 6144 + col0 + bj * HALF + 4 * n);
#pragma unroll
        for (int ai = 0; ai < 2; ++ai) {
            f32x4 bs[4][2][2];
#pragma unroll
            for (int m = 0; m < 4; ++m) { const size_t off = (size_t)(row0 + ai * HALF + m * 16) * 1024 + col0;
#pragma unroll
                for (int bj = 0; bj < 2; ++bj) {
                    if (BASE_F32) { bs[m][bj][0] = *(const f32x4*)((const float*)base + off + bj * HALF); bs[m][bj][1] = *(const f32x4*)((const float*)base + off + bj * HALF + 4); }
                    else { const u32x4 w = *(const u32x4*)((const bf16_t*)base + off + bj * HALF);
                        bs[m][bj][0] = (f32x4){__builtin_bit_cast(float, w.x << 16), __builtin_bit_cast(float, w.x & 0xffff0000u), __builtin_bit_cast(float, w.y << 16), __builtin_bit_cast(float, w.y & 0xffff0000u)};
                        bs[m][bj][1] = (f32x4){__builtin_bit_cast(float, w.z << 16), __builtin_bit_cast(float, w.z & 0xffff0000u), __builtin_bit_cast(float, w.w << 16), __builtin_bit_cast(float, w.w & 0xffff0000u)}; } } }
#pragma unroll
            for (int m = 0; m < 4; ++m) { const size_t off = (size_t)(row0 + ai * HALF + m * 16) * 1024 + col0;
#pragma unroll
                for (int bj = 0; bj < 2; ++bj) { const f32x4 v0 = bs[m][bj][0] + gv[bj][0] * acc[ai][bj][m][0], v1 = bs[m][bj][1] + gv[bj][1] * acc[ai][bj][m][1];
                    u32x4 w; w.x = cvt_pk_bf16(v0[0], v0[1]); w.y = cvt_pk_bf16(v0[2], v0[3]); w.z = cvt_pk_bf16(v1[0], v1[1]); w.w = cvt_pk_bf16(v1[2], v1[3]);
                    *(u32x4*)(out + off + bj * HALF) = w; } }
            asm volatile("" ::: "memory"); }
    }
};
template <class Epi, class Sched, bool ALIGN_EPI = false, bool SP2 = false>
__device__ __forceinline__ void gemm_phase(PG8_LAS unsigned char* lds, const Gemm g, const Sched& S, const Epi& E) {
    const int tid = threadIdx.x, wid = __builtin_amdgcn_readfirstlane(tid >> 6), lane = tid & 63, wr = wid >> 2, wc = wid & 3, fr = lane & 15, fq = lane >> 4;
    const int K = g.K, nt = K / BK;
    unsigned voffA[2], voffB[2];
#pragma unroll
    for (int i = 0; i < 2; ++i) { int R, C; stage_rc(tid * 16 + i * 8192, R, C); const int Rb = Epi::PERM ? ((R & ~31) + perm32(R & 31)) : R;
        voffA[i] = (unsigned)(R * K + C) * 2u; voffB[i] = (unsigned)(Rb * K + C) * 2u; }
    const size_t kstep = (size_t)(BK * 2);
    const size_t hstep = (size_t)HALF * K * 2;
    const size_t tstep = 2 * hstep;
    const unsigned ldsw = (unsigned)wid * 1024u;
    const int aoff = lds_byte(wr * 64 + fr, fq * 8), boff = lds_byte(wc * 32 + fr, fq * 8);
#define PG8_SA(b, h) (((b) * 2 + (h)) * HTB)
#define PG8_SB(b, h) ((4 + (b) * 2 + (h)) * HTB)
#define PG8_STAGE(bufoff, gbase, voff) do { _Pragma("unroll") for (int _i = 0; _i < 2; ++_i) \
        __builtin_amdgcn_global_load_lds((const unsigned*)((const char*)(gbase) + (voff)[_i]), (PG8_LAS unsigned*)(lds + (bufoff) + ldsw + _i * 8192), 16, 0, 0); } while (0)
#define PG8_LDA(dst, b, h) do { _Pragma("unroll") for (int m = 0; m < 4; ++m) _Pragma("unroll") for (int k = 0; k < 2; ++k) dst[m][k] = *(const PG8_LAS bf16x8*)(lds + PG8_SA(b, h) + aoff + m * 2048 + k * 1024); } while (0)
#define PG8_LDB(dst, b, h) do { _Pragma("unroll") for (int n = 0; n < 2; ++n) _Pragma("unroll") for (int k = 0; k < 2; ++k) dst[n][k] = *(const PG8_LAS bf16x8*)(lds + PG8_SB(b, h) + boff + n * 2048 + k * 1024); } while (0)
#define PG8_MMA(ai, bj, At, Bt) do { __builtin_amdgcn_s_setprio(1); _Pragma("unroll") for (int m = 0; m < 4; ++m) _Pragma("unroll") for (int n = 0; n < 2; ++n) _Pragma("unroll") for (int k = 0; k < 2; ++k) \
        acc[ai][bj][m][n] = __builtin_amdgcn_mfma_f32_16x16x32_bf16(Bt[n][k], At[m][k], acc[ai][bj][m][n], 0, 0, 0); __builtin_amdgcn_s_setprio(0); } while (0)
#define PG8_WAIT_V(n) asm volatile("s_waitcnt vmcnt(" #n ")" ::: "memory")
#define PG8_WAIT_L(n) asm volatile("s_waitcnt lgkmcnt(" #n ")" ::: "memory")
#define PG8_BAR __builtin_amdgcn_s_barrier()
#define PG8_SCHED __builtin_amdgcn_sched_barrier(0)
    Unit cur, nxt; int ui = 0;
    if (!S.next(0, cur)) return;
    f32x4 acc[2][2][4][2];
#pragma unroll
    for (int a = 0; a < 2; ++a)
#pragma unroll
        for (int b = 0; b < 2; ++b)
#pragma unroll
            for (int m = 0; m < 4; ++m)
#pragma unroll
                for (int n = 0; n < 2; ++n) acc[a][b][m][n] = (f32x4){0.f, 0.f, 0.f, 0.f};
    bf16x8 At[4][2], B0[2][2], B1[2][2];
    const char* cA = (const char*)g.A + (size_t)cur.pm * tstep; const char* cB = (const char*)g.Bt + (size_t)cur.pn * tstep;
    S.a_ready(cur);
    if constexpr (SP2) {
        PG8_STAGE(PG8_SB(0, 0), cB, voffB); PG8_STAGE(PG8_SB(0, 1), cB + hstep, voffB); PG8_STAGE(PG8_SA(0, 0), cA, voffA); PG8_STAGE(PG8_SA(0, 1), cA + hstep, voffA);
        if (wr == 1) PG8_BAR;
        PG8_WAIT_V(2); PG8_BAR;
        PG8_STAGE(PG8_SB(1, 0), cB + kstep, voffB); PG8_STAGE(PG8_SA(1, 0), cA + kstep, voffA); PG8_STAGE(PG8_SB(1, 1), cB + hstep + kstep, voffB);
        PG8_WAIT_V(6); PG8_BAR;
    } else {
        PG8_STAGE(PG8_SB(0, 0), cB, voffB); PG8_STAGE(PG8_SA(0, 0), cA, voffA); PG8_STAGE(PG8_SB(0, 1), cB + hstep, voffB); PG8_STAGE(PG8_SA(0, 1), cA + hstep, voffA);
        if (wr == 1) PG8_BAR;
        PG8_WAIT_V(4); PG8_BAR;
        PG8_STAGE(PG8_SB(1, 0), cB + kstep, voffB); PG8_STAGE(PG8_SA(1, 0), cA + kstep, voffA); PG8_STAGE(PG8_SB(1, 1), cB + hstep + kstep, voffB);
        PG8_WAIT_V(6); PG8_BAR;
    }
    for (;;) {
        const bool has_next = S.next(ui + 1, nxt);
        const char* nA = has_next ? (const char*)g.A + (size_t)nxt.pm * tstep : cA; const char* nB = has_next ? (const char*)g.Bt + (size_t)nxt.pn * tstep : cB;
        for (int t = 0; t < nt; t += 2) {
            const bool last = (t == nt - 2);
            const char* a1 = cA + (size_t)(t + 1) * kstep;
            const char* a2 = last ? nA : cA + (size_t)(t + 2) * kstep; const char* b2 = last ? nB : cB + (size_t)(t + 2) * kstep;
            const char* a3 = a2 + kstep; const char* b3 = b2 + kstep;
            if (last && has_next) S.a_ready(nxt);
            if constexpr (SP2) {
            PG8_LDB(B0, 0, 0); PG8_LDB(B1, 0, 1); PG8_SCHED; PG8_LDA(At, 0, 0); PG8_STAGE(PG8_SA(1, 1), a1 + hstep, voffA);
            PG8_WAIT_V(8); PG8_WAIT_L(0); PG8_BAR; PG8_MMA(0, 0, At, B0); PG8_MMA(0, 1, At, B1); PG8_BAR; PG8_SCHED;
            PG8_LDA(At, 0, 1); PG8_STAGE(PG8_SB(0, 0), b2, voffB); PG8_STAGE(PG8_SB(0, 1), b2 + hstep, voffB); PG8_STAGE(PG8_SA(0, 0), a2, voffA);
            PG8_WAIT_V(8); PG8_WAIT_L(0); PG8_BAR; PG8_MMA(1, 0, At, B0); PG8_MMA(1, 1, At, B1); PG8_BAR; PG8_SCHED;
            PG8_LDB(B0, 1, 0); PG8_LDB(B1, 1, 1); PG8_SCHED; PG8_LDA(At, 1, 0); PG8_STAGE(PG8_SA(0, 1), a2 + hstep, voffA);
            PG8_WAIT_V(8); PG8_WAIT_L(0); PG8_BAR; PG8_MMA(0, 0, At, B0); PG8_MMA(0, 1, At, B1); PG8_BAR; PG8_SCHED;
            PG8_LDA(At, 1, 1); PG8_STAGE(PG8_SB(1, 0), b3, voffB); PG8_STAGE(PG8_SB(1, 1), b3 + hstep, voffB); PG8_STAGE(PG8_SA(1, 0), a3, voffA);
            PG8_WAIT_V(8); PG8_WAIT_L(0); PG8_BAR; PG8_MMA(1, 0, At, B0); PG8_MMA(1, 1, At, B1); PG8_BAR; PG8_SCHED;
            } else {
            PG8_LDB(B0, 0, 0); PG8_SCHED; PG8_LDA(At, 0, 0); PG8_STAGE(PG8_SA(1, 1), a1 + hstep, voffA);
            PG8_WAIT_L(8); PG8_BAR; PG8_WAIT_L(0); PG8_MMA(0, 0, At, B0); PG8_BAR; PG8_SCHED;
            PG8_LDB(B1, 0, 1); PG8_STAGE(PG8_SB(0, 0), b2, voffB);
            PG8_BAR; PG8_WAIT_L(0); PG8_MMA(0, 1, At, B1); PG8_BAR;
            PG8_LDA(At, 0, 1); PG8_STAGE(PG8_SA(0, 0), a2, voffA);
            PG8_BAR; PG8_WAIT_L(0); PG8_MMA(1, 0, At, B0); PG8_BAR; PG8_SCHED;
            PG8_STAGE(PG8_SB(0, 1), b2 + hstep, voffB);
            PG8_WAIT_V(6); PG8_BAR; PG8_MMA(1, 1, At, B1); PG8_BAR;
            PG8_LDB(B0, 1, 0); PG8_SCHED; PG8_LDA(At, 1, 0); PG8_STAGE(PG8_SA(0, 1), a2 + hstep, voffA);
            PG8_WAIT_L(8); PG8_BAR; PG8_WAIT_L(0); PG8_MMA(0, 0, At, B0); PG8_BAR; PG8_SCHED;
            PG8_LDB(B1, 1, 1); PG8_STAGE(PG8_SB(1, 0), b3, voffB);
            PG8_BAR; PG8_WAIT_L(0); PG8_MMA(0, 1, At, B1); PG8_BAR;
            PG8_LDA(At, 1, 1); PG8_STAGE(PG8_SA(1, 0), a3, voffA);
            PG8_BAR; PG8_WAIT_L(0); PG8_MMA(1, 0, At, B0); PG8_BAR; PG8_SCHED;
            PG8_STAGE(PG8_SB(1, 1), b3 + hstep, voffB);
            PG8_WAIT_V(6); PG8_BAR; PG8_MMA(1, 1, At, B1); PG8_BAR;
            }
        }
        if constexpr (ALIGN_EPI) { if (wr == 0) PG8_BAR; }
        if constexpr (!Epi::AFTER_DRAIN) { E(acc, cur, wr, wc, fr, fq); S.done(cur); }
        if (!has_next) break;
#pragma unroll
        for (int a = 0; a < 2; ++a)
#pragma unroll
            for (int b = 0; b < 2; ++b)
#pragma unroll
                for (int m = 0; m < 4; ++m)
#pragma unroll
                    for (int n = 0; n < 2; ++n) acc[a][b][m][n] = (f32x4){0.f, 0.f, 0.f, 0.f};
        cur = nxt; cA = nA; cB = nB; ++ui;
        if constexpr (ALIGN_EPI) { if (wr == 1) PG8_BAR; }
    }
    PG8_WAIT_V(0);
    if constexpr (!ALIGN_EPI) { if (wr == 0) PG8_BAR; }
    PG8_BAR;
    if constexpr (Epi::AFTER_DRAIN) { E.fused(acc, cur, wr, wc, fr, fq, lds, wid, lane); S.done(cur); }
#undef PG8_SA
#undef PG8_SB
#undef PG8_STAGE
#undef PG8_LDA
#undef PG8_LDB
#undef PG8_MMA
#undef PG8_WAIT_V
#undef PG8_WAIT_L
#undef PG8_BAR
#undef PG8_SCHED
}
}
namespace mk {
#define LAS __attribute__((address_space(3)))
typedef unsigned short bf16;
typedef short bf16x8 __attribute__((ext_vector_type(8)));
typedef short s16x4 __attribute__((ext_vector_type(4)));
typedef float f32x4 __attribute__((ext_vector_type(4)));
typedef unsigned v4u __attribute__((ext_vector_type(4)));
typedef unsigned v2u __attribute__((ext_vector_type(2)));

constexpr int BATCH = 8, SEQ = 4096, D = 1024, M = BATCH * SEQ, FF = 4096, NIN0 = 3584, NIN1 = 2048;
constexpr int NT = 512;
constexpr float EPS = 1e-6f;
constexpr size_t MiB = 1u << 20;
constexpr size_t WS_MODP = 440 * MiB;
constexpr int NCH = 16;
constexpr size_t WS_MODF = 3 * MiB;
constexpr size_t WS_DEC = 4 * MiB;
constexpr size_t WS_BAR = 5 * MiB, BAR_ZERO_BYTES = 16384;
constexpr int MISC_OFF = 131072;
constexpr size_t WS_WIN0 = 8 * MiB, WS_WOUT0 = 15 * MiB, WS_WIN1 = 17 * MiB, WS_WOUT1 = 21 * MiB, WS_WFF1 = 23 * MiB, WS_WFF2 = 39 * MiB;
constexpr size_t WS_H = 56 * MiB;
constexpr size_t WS_P = 120 * MiB;
constexpr size_t WS_S = 376 * MiB;
constexpr size_t WS_XR = 376 * MiB;
constexpr size_t WS_END = 448 * MiB;
constexpr int LDS_BYTES = 147456;
constexpr int NPH = 18;

struct Args { const float* in[22]; float* out; unsigned char* ws; int ph_lo, ph_hi; };

__device__ __forceinline__ float bf2f(unsigned u) { return __builtin_bit_cast(float, u << 16); }
__device__ __forceinline__ float bflo(unsigned w) { return __builtin_bit_cast(float, w << 16); }
__device__ __forceinline__ float bfhi(unsigned w) { return __builtin_bit_cast(float, w & 0xffff0000u); }
typedef float f32x2_t __attribute__((ext_vector_type(2)));
typedef __bf16 bf16x2_t __attribute__((ext_vector_type(2)));
__device__ __forceinline__ unsigned pk2(float lo, float hi) { const f32x2_t v = {lo, hi}; const bf16x2_t b = __builtin_convertvector(v, bf16x2_t); return __builtin_bit_cast(unsigned, b); }
__device__ __forceinline__ unsigned short f2bf(float f) { return __builtin_bit_cast(unsigned short, (__bf16)f); }
__device__ __forceinline__ float wave_sum(float v) {
#pragma unroll
    for (int o = 1; o < 64; o <<= 1) v += __shfl_xor(v, o);
    return v;
}
__device__ __forceinline__ float sigmoidf_(float x) { return __builtin_amdgcn_rcpf(1.0f + __expf(-x)); }
__device__ __forceinline__ float siluf_(float x) { return x * sigmoidf_(x); }

__device__ __forceinline__ bf16x8 rowfrag(LAS const unsigned char* T, int pitchB, int r0, int k0, int fr, int fq) {
    return *(LAS const bf16x8*)(T + (r0 + fr) * pitchB + (k0 + 8 * fq) * 2);
}
typedef short v4i16_t __attribute__((ext_vector_type(4)));
__device__ __forceinline__ bf16x8 trfrag(LAS const unsigned char* T, int pitchB, int k0, int n0, int lane) {
    const int g = lane >> 4, q = (lane & 15) >> 2, pp = lane & 3;
    LAS const unsigned char* p0 = T + (k0 + 8 * g + q) * pitchB + (n0 + 4 * pp) * 2;
    const v4i16_t a = __builtin_amdgcn_ds_read_tr16_b64_v4i16((LAS v4i16_t*)p0);
    const v4i16_t b = __builtin_amdgcn_ds_read_tr16_b64_v4i16((LAS v4i16_t*)(p0 + 4 * pitchB));
    return (bf16x8){a.x, a.y, a.z, a.w, b.x, b.y, b.z, b.w};
}
#define MFMA16(a, b, c) __builtin_amdgcn_mfma_f32_16x16x32_bf16((a), (b), (c), 0, 0, 0)

#define XB_TMO      128
#define XB_XCNT(j)  (256  + 64 * (j))
#define XB_XSUB(j)  (1280 + 64 * (j))
#define XB_XGEN(j)  (2304 + 64 * (j))
#define XB_TOP      3328
#define XB_TOPGEN   3392
#define XCD_BAR_WORDS 3456
#define XB_SPIN_CAP (1u << 18)

__device__ __forceinline__ unsigned xb_ld(unsigned* p)              { return __hip_atomic_load(p, __ATOMIC_RELAXED, __HIP_MEMORY_SCOPE_AGENT); }
__device__ __forceinline__ unsigned xb_add(unsigned* p, unsigned v) { return __hip_atomic_fetch_add(p, v, __ATOMIC_RELAXED, __HIP_MEMORY_SCOPE_AGENT); }
__device__ __forceinline__ unsigned xb_xcc_id() { return (unsigned)__builtin_amdgcn_s_getreg((3 << 11) | 20) & 0xFu; }
#define XB_SPIN(cond, bar) do { unsigned _sp = 0; while (cond) { __builtin_amdgcn_s_sleep(1); \
    if ((++_sp & 255u) == 0u) { if (xb_ld(&(bar)[XB_TMO])) break; if (_sp > XB_SPIN_CAP) { atomicAdd(&(bar)[XB_TMO], 1u); break; } } } } while (0)

struct XcdBarrier {
    unsigned* bar; unsigned x;
    volatile LAS unsigned* st;
};

__device__ __forceinline__ XcdBarrier xcd_barrier_post(unsigned* bar, volatile LAS unsigned* st) {
    XcdBarrier b; b.bar = bar; b.x = xb_xcc_id(); b.st = st;
    if (threadIdx.x == 0) (void)xb_add(&bar[XB_XCNT(b.x)], 1u);
    return b;
}
__device__ __forceinline__ void xcd_barrier_complete(unsigned* bar, unsigned x, unsigned& nloc, unsigned& nx) {
    const unsigned G = gridDim.x * gridDim.y * gridDim.z;
    unsigned sum, cnt, mine, sp = 0u;
    for (;;) {
        sum = 0u; cnt = 0u; mine = 0u;
#pragma unroll
        for (unsigned j = 0; j < 16; ++j) { const unsigned c = xb_ld(&bar[XB_XCNT(j)]); sum += c; cnt += (c > 0u) ? 1u : 0u; mine = (j == x) ? c : mine; }
        if (sum == G) break;
        __builtin_amdgcn_s_sleep(1);
        if ((++sp & 255u) == 0u) { if (xb_ld(&bar[XB_TMO])) break; if (sp > XB_SPIN_CAP) { atomicAdd(&bar[XB_TMO], 1u); break; } }
    }
    nloc = mine > 0u ? mine : 1u; nx = cnt > 0u ? cnt : 1u;
}

__device__ __forceinline__ void xcd_barrier(const XcdBarrier& b) {
    asm volatile("s_waitcnt vmcnt(0)" ::: "memory");
    __syncthreads();
    if (threadIdx.x == 0) {
        unsigned* bar = b.bar;
        __builtin_amdgcn_s_waitcnt(0);
        unsigned nloc = b.st[0], nx = b.st[1];
        if (nloc == 0u) { xcd_barrier_complete(bar, b.x, nloc, nx); b.st[0] = nloc; b.st[1] = nx; }
        const unsigned old = xb_add(&bar[XB_XSUB(b.x)], 1u);
        const unsigned gen = old / nloc;
        if (old + 1u == (gen + 1u) * nloc) {
            __builtin_amdgcn_fence(__ATOMIC_RELEASE, "agent");
            asm volatile("s_waitcnt vmcnt(0)" ::: "memory");
            const unsigned og = xb_add(&bar[XB_TOP], 1u);
            const unsigned tg = og / nx;
            if (og + 1u == (tg + 1u) * nx) xb_add(&bar[XB_TOPGEN], 1u);
            else XB_SPIN(xb_ld(&bar[XB_TOPGEN]) == tg, bar);
            __builtin_amdgcn_fence(__ATOMIC_ACQUIRE, "agent");
            xb_add(&bar[XB_XGEN(b.x)], 1u);
            asm volatile("s_waitcnt vmcnt(0)" ::: "memory");
        } else {
            XB_SPIN(xb_ld(&bar[XB_XGEN(b.x)]) == gen, bar);
            __builtin_amdgcn_fence(__ATOMIC_ACQUIRE, "agent");
            asm volatile("s_waitcnt vmcnt(0)" ::: "memory");
        }
    }
    __syncthreads();
}

__device__ __forceinline__ void transpose_item(const float* W, int K, int N, bf16* WT, LAS float* scr, int item, int lane) {
    const int nblk = N / 32, kb = item / nblk, nb = item % nblk, k0 = 64 * kb, n0 = 32 * nb;
    float tv[32];
#pragma unroll
    for (int i = 0; i < 32; ++i) tv[i] = W[(size_t)(k0 + 2 * i + (lane >> 5)) * N + n0 + (lane & 31)];
#pragma unroll
    for (int i = 0; i < 32; ++i) scr[(2 * i + (lane >> 5)) * 33 + (lane & 31)] = tv[i];
    asm volatile("s_waitcnt lgkmcnt(0)" ::: "memory");
    const int c = lane & 7;
#pragma unroll
    for (int j = 0; j < 4; ++j) { const int n = (lane >> 3) + 8 * j; const LAS float* s = scr + (8 * c) * 33 + n;
        v4u o; o.x = pk2(s[0 * 33], s[1 * 33]); o.y = pk2(s[2 * 33], s[3 * 33]); o.z = pk2(s[4 * 33], s[5 * 33]); o.w = pk2(s[6 * 33], s[7 * 33]);
        *(v4u*)(WT + (size_t)(n0 + n) * K + k0 + 8 * c) = o; }
    asm volatile("s_waitcnt lgkmcnt(0)" ::: "memory");
}
__device__ __forceinline__ void phase_prologue(const Args& a, LAS unsigned char* lds, int tid, int lane, int wave, int G) {
    LAS float* sc = (LAS float*)lds;
    const float* c = a.in[1];
    for (int i = tid; i < 8192; i += NT) sc[i] = siluf_(c[i]);
    __syncthreads();
    float* modp = (float*)(a.ws + WS_MODP);
    for (int it = blockIdx.x; it < 2 * NCH * 12; it += G) {
        const int l = it / (NCH * 12), r = it % (NCH * 12), ch = r / 12, eb = r % 12, e = eb * 512 + tid;
        const float* w = a.in[2] + ((size_t)l * 1024 + ch * 64) * 6144 + e;
        float acc0 = 0.f, acc1 = 0.f, acc2 = 0.f, acc3 = 0.f, acc4 = 0.f, acc5 = 0.f, acc6 = 0.f, acc7 = 0.f;
        const LAS float* s = sc + ch * 64;
#pragma unroll 16
        for (int d = 0; d < 64; ++d) { const float wv = w[(size_t)d * 6144];
            acc0 += s[d] * wv; acc1 += s[1024 + d] * wv; acc2 += s[2048 + d] * wv; acc3 += s[3072 + d] * wv;
            acc4 += s[4096 + d] * wv; acc5 += s[5120 + d] * wv; acc6 += s[6144 + d] * wv; acc7 += s[7168 + d] * wv; }
        float* o = modp + (size_t)((ch * 2 + l) * 8) * 6144 + e;
        o[0] = acc0; o[6144] = acc1; o[2 * 6144] = acc2; o[3 * 6144] = acc3; o[4 * 6144] = acc4; o[5 * 6144] = acc5; o[6 * 6144] = acc6; o[7 * 6144] = acc7;
    }
    __syncthreads();
    LAS float* scr = (LAS float*)(lds + 32768 + wave * 8704);
    const int gw = blockIdx.x * 8 + wave, NGW = G * 8;
    constexpr int I0 = 1792, I1 = 512, I2 = 1024, I3 = 512, I4 = 2048, I5 = 2048;
    constexpr int NITEMS = I0 + I1 + I2 + I3 + 2 * I4 + 2 * I5;
    for (int it = gw; it < NITEMS; it += NGW) {
        int r = it;
        if (r < I0) { transpose_item(a.in[6], 1024, NIN0, (bf16*)(a.ws + WS_WIN0), scr, r, lane); continue; } r -= I0;
        if (r < I1) { transpose_item(a.in[11], 1024, 1024, (bf16*)(a.ws + WS_WOUT0), scr, r, lane); continue; } r -= I1;
        if (r < I2) { transpose_item(a.in[12], 1024, NIN1, (bf16*)(a.ws + WS_WIN1), scr, r, lane); continue; } r -= I2;
        if (r < I3) { transpose_item(a.in[18], 1024, 1024, (bf16*)(a.ws + WS_WOUT1), scr, r, lane); continue; } r -= I3;
        if (r < 2 * I4) { const int l = r / I4; transpose_item(a.in[19] + (size_t)l * 1024 * 4096, 1024, 4096, (bf16*)(a.ws + WS_WFF1) + (size_t)l * 4096 * 1024, scr, r % I4, lane); continue; } r -= 2 * I4;
        { const int l = r / I5; transpose_item(a.in[20] + (size_t)l * 4096 * 1024, 4096, 1024, (bf16*)(a.ws + WS_WFF2) + (size_t)l * 1024 * 4096, scr, r % I5, lane); }
    }
}

template <bool PARTIAL>
__device__ __forceinline__ float modval(const Args& a, int l, int b, int idx) {
    if (PARTIAL) {
        const float* modp = (const float*)(a.ws + WS_MODP);
        float s = a.in[3][l * 6144 + idx];
#pragma unroll
        for (int ch = 0; ch < NCH; ++ch) s += modp[(size_t)((ch * 2 + l) * 8 + b) * 6144 + idx];
        return s;
    } else {
        return ((const float*)(a.ws + WS_MODF))[(size_t)(l * 8 + b) * 6144 + idx];
    }
}
template <bool PARTIAL>
__device__ __forceinline__ void phase_norm(const Args& a, const float* xsrc, const float* gvec, int l, int jshift, int jscale, int tid, int lane, int wave, int G) {
    bf16* h = (bf16*)(a.ws + WS_H);
    if (PARTIAL) {
        float* modf = (float*)(a.ws + WS_MODF);
        for (int i = blockIdx.x * NT + tid; i < 2 * 8 * 6144; i += G * NT) { const int ll = i / 49152, bb = (i / 6144) % 8, idx = i % 6144; modf[i] = modval<true>(a, ll, bb, idx); }
    }
    for (int blk = blockIdx.x; blk < 256; blk += G) {
        const int b = blk >> 5;
        f32x4 gs[4], sh[4];
#pragma unroll
        for (int j = 0; j < 4; ++j) { const int col = lane * 4 + 256 * j;
#pragma unroll
            for (int i = 0; i < 4; ++i) { gs[j][i] = gvec[col + i] * (1.0f + modval<PARTIAL>(a, l, b, jscale * 1024 + col + i)); sh[j][i] = modval<PARTIAL>(a, l, b, jshift * 1024 + col + i); } }
        const float* xb = xsrc + (size_t)blk * 128 * 1024;
        f32x4 nx[4];
#pragma unroll
        for (int j = 0; j < 4; ++j) nx[j] = ((const f32x4*)(xb + (size_t)wave * 1024) + lane)[64 * j];
        for (int r = wave; r < 128; r += 8) {
            const size_t m = (size_t)blk * 128 + r;
            f32x4 v[4]; float ss = 0.f;
#pragma unroll
            for (int j = 0; j < 4; ++j) { v[j] = nx[j]; ss += (v[j].x * v[j].x + v[j].y * v[j].y) + (v[j].z * v[j].z + v[j].w * v[j].w); }
            if (r + 8 < 128) {
#pragma unroll
                for (int j = 0; j < 4; ++j) nx[j] = ((const f32x4*)(xb + (size_t)(r + 8) * 1024) + lane)[64 * j];
            }
            const float inv = 1.0f / sqrtf(wave_sum(ss) * (1.0f / 1024.0f) + EPS);
            v2u* o8 = (v2u*)(h + m * 1024) + lane;
#pragma unroll
            for (int j = 0; j < 4; ++j) { const f32x4 o = v[j] * inv * gs[j] + sh[j]; v2u w; w.x = pk2(o.x, o.y); w.y = pk2(o.z, o.w); o8[64 * j] = w; }
        }
    }
}
__device__ __forceinline__ void unpack8(const v4u w, float (&x)[16], int o) {
#pragma unroll
    for (int i = 0; i < 4; ++i) { x[o + 2 * i] = bflo(w[i]); x[o + 2 * i + 1] = bfhi(w[i]); }
}
__device__ __forceinline__ void phase_norm_bf(const Args& a, const float* gvec, int l, int jshift, int jscale, int tid, int lane, int wave, int G) {
    bf16* h = (bf16*)(a.ws + WS_H); const bf16* xr = (const bf16*)(a.ws + WS_XR);
    for (int blk = blockIdx.x; blk < 256; blk += G) {
        const int b = blk >> 5;
        float gs[16], sh[16];
#pragma unroll
        for (int j = 0; j < 2; ++j)
#pragma unroll
            for (int i = 0; i < 8; ++i) { const int col = lane * 8 + 512 * j + i; gs[8 * j + i] = gvec[col] * (1.0f + modval<false>(a, l, b, jscale * 1024 + col)); sh[8 * j + i] = modval<false>(a, l, b, jshift * 1024 + col); }
        const bf16* xb = xr + (size_t)blk * 128 * 1024 + lane * 8;
        v4u n0 = *(const v4u*)(xb + (size_t)wave * 1024), n1 = *(const v4u*)(xb + (size_t)wave * 1024 + 512);
        for (int r = wave; r < 128; r += 8) {
            float x[16]; unpack8(n0, x, 0); unpack8(n1, x, 8);
            if (r + 8 < 128) { n0 = *(const v4u*)(xb + (size_t)(r + 8) * 1024); n1 = *(const v4u*)(xb + (size_t)(r + 8) * 1024 + 512); }
            float ss = 0.f;
#pragma unroll
            for (int i = 0; i < 16; ++i) ss += x[i] * x[i];
            const float inv = 1.0f / sqrtf(wave_sum(ss) * (1.0f / 1024.0f) + EPS);
            bf16* ho = h + ((size_t)blk * 128 + r) * 1024 + lane * 8;
#pragma unroll
            for (int j = 0; j < 2; ++j) { v4u w;
#pragma unroll
                for (int i = 0; i < 4; ++i) w[i] = pk2(x[8 * j + 2 * i] * inv * gs[8 * j + 2 * i] + sh[8 * j + 2 * i], x[8 * j + 2 * i + 1] * inv * gs[8 * j + 2 * i + 1] + sh[8 * j + 2 * i + 1]);
                *(v4u*)(ho + 512 * j) = w; }
        }
    }
}
__device__ __forceinline__ void phase_final_norm(const Args& a, int lane, int wave, int G) {
    const float* g = a.in[21]; const bf16* xr = (const bf16*)(a.ws + WS_XR);
    float gs[16];
#pragma unroll
    for (int j = 0; j < 2; ++j)
#pragma unroll
        for (int i = 0; i < 8; ++i) gs[8 * j + i] = g[lane * 8 + 512 * j + i];
    int m = blockIdx.x * 8 + wave;
    v4u n0 = (v4u){0u, 0u, 0u, 0u}, n1 = n0;
    if (m < M) { n0 = *(const v4u*)(xr + (size_t)m * 1024 + lane * 8); n1 = *(const v4u*)(xr + (size_t)m * 1024 + lane * 8 + 512); }
    for (; m < M; m += G * 8) {
        float x[16]; unpack8(n0, x, 0); unpack8(n1, x, 8);
        if (m + G * 8 < M) { n0 = *(const v4u*)(xr + (size_t)(m + G * 8) * 1024 + lane * 8); n1 = *(const v4u*)(xr + (size_t)(m + G * 8) * 1024 + lane * 8 + 512); }
        float ss = 0.f;
#pragma unroll
        for (int i = 0; i < 16; ++i) ss += x[i] * x[i];
        const float inv = 1.0f / sqrtf(wave_sum(ss) * (1.0f / 1024.0f) + EPS);
        float* o = a.out + (size_t)m * 1024 + lane * 8;
#pragma unroll
        for (int j = 0; j < 2; ++j) {
            *(f32x4*)(o + 512 * j) = (f32x4){x[8 * j] * inv * gs[8 * j], x[8 * j + 1] * inv * gs[8 * j + 1], x[8 * j + 2] * inv * gs[8 * j + 2], x[8 * j + 3] * inv * gs[8 * j + 3]};
            *(f32x4*)(o + 512 * j + 4) = (f32x4){x[8 * j + 4] * inv * gs[8 * j + 4], x[8 * j + 5] * inv * gs[8 * j + 5], x[8 * j + 6] * inv * gs[8 * j + 6], x[8 * j + 7] * inv * gs[8 * j + 7]};
        }
    }
}

__device__ __forceinline__ void conv_mixer(const Args& a, int tid, int G) {
    const bf16* p = (const bf16*)(a.ws + WS_P); bf16* y = (bf16*)(a.ws + WS_H);
    const float* cw = a.in[7]; const float* cb = a.in[8];
    for (int it = blockIdx.x * NT + tid; it < M * 64; it += G * NT) {
        const int m = it >> 6, c0 = (it & 63) * 8, t = m & (SEQ - 1);
        const bf16* pr = p + (size_t)m * NIN0 + c0;
        float conv[8];
#pragma unroll
        for (int i = 0; i < 8; ++i) conv[i] = cb[c0 + i];
#pragma unroll
        for (int tap = 0; tap < 3; ++tap) {
            const int dt = 2 - tap;
            if (t - dt >= 0) {
                const v4u cc = *(const v4u*)(pr - (size_t)dt * NIN0 + 512), hh = *(const v4u*)(pr - (size_t)dt * NIN0 + 1024);
#pragma unroll
                for (int i = 0; i < 4; ++i) {
                    conv[2 * i] += cw[tap * 512 + c0 + 2 * i] * (bflo(cc[i]) * bflo(hh[i]));
                    conv[2 * i + 1] += cw[tap * 512 + c0 + 2 * i + 1] * (bfhi(cc[i]) * bfhi(hh[i]));
                }
            }
        }
        const v4u bb = *(const v4u*)pr;
        v4u o;
#pragma unroll
        for (int i = 0; i < 4; ++i) o[i] = pk2(bflo(bb[i]) * conv[2 * i], bfhi(bb[i]) * conv[2 * i + 1]);
        *(v4u*)(y + (size_t)m * 1024 + c0) = o;
    }
}
constexpr int HP = 272;
constexpr int HG_SEG = 0, HG_QD = 2048, HG_QR = 19456, HG_KR = 36864, HG_V = 54272, HG_S = 71680, HG_P = 106496, HG_O = 19456;
constexpr int PP = 144;
constexpr int OP = 528;
__device__ __forceinline__ void hg_cum(const Args& a, LAS unsigned char* lds, int tid, int m0, int h, float (&cum)[16], float (&kk)[16], float& mid, float& last) {
    const int k = tid & 127, seg = tid >> 7, ch = h * 128 + k;
    const float* lbp = a.in[9];
    const float l0 = lbp[ch], l1 = lbp[512 + ch], l2 = lbp[1024 + ch], mx = fmaxf(l0, fmaxf(l1, l2));
    const float e0 = __expf(l0 - mx), e1 = __expf(l1 - mx), e2 = __expf(l2 - mx), lb = e0 / (e0 + e1 + e2);
    const bf16* p = (const bf16*)(a.ws + WS_P) + (size_t)(m0 + seg * 16) * NIN0 + 2048 + ch;
    float run = 0.f;
#pragma unroll
    for (int i = 0; i < 16; ++i) { const float x = bf2f(p[(size_t)i * NIN0]); const float f = lb + (1.0f - lb) * sigmoidf_(x); run += __logf(f); cum[i] = run; kk[i] = 1.0f - f; }
    LAS float* st = (LAS float*)(lds + HG_SEG);
    st[seg * 128 + k] = run;
    __syncthreads();
    const float s0 = st[k], s1 = st[128 + k], s2 = st[256 + k], s3 = st[384 + k];
    const float off = seg == 0 ? 0.f : (seg == 1 ? s0 : (seg == 2 ? s0 + s1 : s0 + s1 + s2));
    mid = s0 + s1; last = (s0 + s1) + (s2 + s3);
#pragma unroll
    for (int i = 0; i < 16; ++i) cum[i] += off;
}
__device__ __forceinline__ void load_tile128(LAS unsigned char* dst, const bf16* src, size_t src_pitch, int rows, int tid) {
    for (int id = tid; id < rows * 16; id += NT) { const int r = id >> 4, c = id & 15; *(LAS v4u*)(dst + r * HP + c * 16) = *(const v4u*)(src + (size_t)r * src_pitch + c * 8); }
}
__device__ __forceinline__ void hg_pass_a(const Args& a, LAS unsigned char* lds, int tid, int lane, int wave, int G) {
    const bf16* p = (const bf16*)(a.ws + WS_P);
    bf16* loc = (bf16*)a.out; float* dec = (float*)(a.ws + WS_DEC);
    for (int unit = blockIdx.x; unit < 2048; unit += G) {
        const int b = unit >> 8, h = (unit >> 6) & 3, c = unit & 63, m0 = b * SEQ + c * 64;
        float cum[16], kk[16], mid, last;
        hg_cum(a, lds, tid, m0, h, cum, kk, mid, last);
        const int k = tid & 127, seg = tid >> 7;
#pragma unroll
        for (int i = 0; i < 16; ++i) *(LAS unsigned short*)(lds + HG_KR + (seg * 16 + i) * HP + k * 2) = f2bf(kk[i] * __expf(last - cum[i]));
        if (seg == 0) dec[unit * 128 + k] = __expf(last);
        load_tile128(lds + HG_V, p + (size_t)m0 * NIN0 + 2560 + h * 128, NIN0, 64, tid);
        __syncthreads();
        f32x4 acc[8];
#pragma unroll
        for (int n = 0; n < 8; ++n) acc[n] = (f32x4){0.f, 0.f, 0.f, 0.f};
#pragma unroll
        for (int ks = 0; ks < 2; ++ks) {
            const bf16x8 B = trfrag(lds + HG_KR, HP, 32 * ks, 16 * wave, lane);
#pragma unroll
            for (int n = 0; n < 8; ++n) { const bf16x8 A = trfrag(lds + HG_V, HP, 32 * ks, 16 * n, lane); acc[n] = MFMA16(A, B, acc[n]); }
        }
        const int fr = lane & 15, fq = lane >> 4;
        bf16* lo = loc + (size_t)unit * 16384 + (16 * wave + fr) * 128 + 4 * fq;
#pragma unroll
        for (int n = 0; n < 8; ++n) { v2u w; w.x = pk2(acc[n][0], acc[n][1]); w.y = pk2(acc[n][2], acc[n][3]); *(v2u*)(lo + 16 * n) = w; }
        __syncthreads();
    }
}
__device__ __forceinline__ void hg_pass_b(const Args& a, int tid, int G) {
    const bf16* loc = (const bf16*)a.out; const float* dec = (const float*)(a.ws + WS_DEC); bf16* st = (bf16*)(a.ws + WS_S);
    for (int idx = blockIdx.x * NT + tid; idx < 32 * 128 * 32; idx += G * NT) {
        const int bh = idx >> 12, k = (idx >> 5) & 127, v4 = idx & 31;
        f32x4 S = (f32x4){0.f, 0.f, 0.f, 0.f};
        const size_t e0 = (size_t)bh * 64 * 16384 + k * 128 + v4 * 4;
#pragma unroll 8
        for (int c = 0; c < 64; ++c) {
            const v2u Lw = *(const v2u*)(loc + e0 + (size_t)c * 16384); const float d = dec[(bh * 64 + c) * 128 + k];
            const f32x4 L = (f32x4){bflo(Lw.x), bfhi(Lw.x), bflo(Lw.y), bfhi(Lw.y)};
            v2u w; w.x = pk2(S.x, S.y); w.y = pk2(S.z, S.w);
            *(v2u*)(st + e0 + (size_t)c * 16384) = w;
            S = S * d + L;
        }
    }
}
__device__ __forceinline__ void hg_pass_c(const Args& a, LAS unsigned char* lds, int tid, int lane, int wave, int G) {
    const bf16* p = (const bf16*)(a.ws + WS_P); const bf16* stg = (const bf16*)(a.ws + WS_S); bf16* y = (bf16*)(a.ws + WS_H);
    const float* gain = a.in[10];
    const int fr = lane & 15, fq = lane >> 4;
    for (int unit = blockIdx.x; unit < 2048; unit += G) {
        const int b = unit >> 8, h = (unit >> 6) & 3, c = unit & 63, m0 = b * SEQ + c * 64;
        {
            float cum[16], kk[16], mid, last;
            hg_cum(a, lds, tid, m0, h, cum, kk, mid, last);
            const int k = tid & 127, seg = tid >> 7;
            const bf16* qp = p + (size_t)(m0 + seg * 16) * NIN0 + 1536 + h * 128 + k;
#pragma unroll
            for (int i = 0; i < 16; ++i) {
                const float q = bf2f(qp[(size_t)i * NIN0]);
                const int o = (seg * 16 + i) * HP + k * 2;
                *(LAS unsigned short*)(lds + HG_QD + o) = f2bf(q * __expf(cum[i]));
                *(LAS unsigned short*)(lds + HG_QR + o) = f2bf(q * __expf(fminf(cum[i] - mid, 80.f)));
                *(LAS unsigned short*)(lds + HG_KR + o) = f2bf(kk[i] * __expf(fminf(mid - cum[i], 80.f)));
            }
        }
        load_tile128(lds + HG_V, p + (size_t)m0 * NIN0 + 2560 + h * 128, NIN0, 64, tid);
        load_tile128(lds + HG_S, stg + (size_t)unit * 16384, 128, 128, tid);
        __syncthreads();
        {
            const int tt = wave >> 1;
#pragma unroll
            for (int j = 0; j < 2; ++j) {
                const int stl = (wave & 1) * 2 + j;
                f32x4 sc = (f32x4){0.f, 0.f, 0.f, 0.f};
                if (stl <= tt) {
#pragma unroll
                    for (int ks = 0; ks < 4; ++ks) sc = MFMA16(rowfrag(lds + HG_QR, HP, 16 * tt, 32 * ks, fr, fq), rowfrag(lds + HG_KR, HP, 16 * stl, 32 * ks, fr, fq), sc);
                }
#pragma unroll
                for (int r = 0; r < 4; ++r) { const int t = 16 * tt + 4 * fq + r, s = 16 * stl + fr;
                    *(LAS unsigned short*)(lds + HG_P + t * PP + s * 2) = f2bf(s <= t ? sc[r] : 0.f); }
            }
        }
        __syncthreads();
        {
            const int tt = wave >> 1, n0 = (wave & 1) * 4;
            f32x4 acc[4];
#pragma unroll
            for (int n = 0; n < 4; ++n) acc[n] = (f32x4){0.f, 0.f, 0.f, 0.f};
#pragma unroll
            for (int ks = 0; ks < 4; ++ks) { const bf16x8 A = rowfrag(lds + HG_QD, HP, 16 * tt, 32 * ks, fr, fq);
#pragma unroll
                for (int n = 0; n < 4; ++n) acc[n] = MFMA16(A, trfrag(lds + HG_S, HP, 32 * ks, 16 * (n0 + n), lane), acc[n]); }
#pragma unroll
            for (int ks = 0; ks < 2; ++ks) { const bf16x8 A = rowfrag(lds + HG_P, PP, 16 * tt, 32 * ks, fr, fq);
#pragma unroll
                for (int n = 0; n < 4; ++n) acc[n] = MFMA16(A, trfrag(lds + HG_V, HP, 32 * ks, 16 * (n0 + n), lane), acc[n]); }
#pragma unroll
            for (int n = 0; n < 4; ++n)
#pragma unroll
                for (int r = 0; r < 4; ++r) *(LAS float*)(lds + HG_O + (16 * tt + 4 * fq + r) * OP + (16 * (n0 + n) + fr) * 4) = acc[n][r];
        }
        __syncthreads();
        {
            const int t = tid >> 3, part = tid & 7, v0 = part * 16;
            f32x4 o[4]; float ss = 0.f;
#pragma unroll
            for (int j = 0; j < 4; ++j) { o[j] = *(LAS const f32x4*)(lds + HG_O + t * OP + (v0 + 4 * j) * 4); ss += (o[j].x * o[j].x + o[j].y * o[j].y) + (o[j].z * o[j].z + o[j].w * o[j].w); }
            ss += __shfl_xor(ss, 1); ss += __shfl_xor(ss, 2); ss += __shfl_xor(ss, 4);
            const float inv = 1.0f / sqrtf(ss * (1.0f / 128.0f) + EPS);
            const bf16* gp = p + (size_t)(m0 + t) * NIN0 + 3072 + h * 128 + v0;
            const v4u g0 = *(const v4u*)gp, g1 = *(const v4u*)(gp + 8);
            const float* gn = gain + h * 128 + v0;
            v4u w0, w1;
#pragma unroll
            for (int i = 0; i < 4; ++i) {
                const float ga = bflo(g0[i]), gb = bfhi(g0[i]), gc = bflo(g1[i]), gd = bfhi(g1[i]);
                const int e = 2 * i;
                const float oa = o[e >> 2][e & 3], ob = o[(e + 1) >> 2][(e + 1) & 3], oc = o[(8 + e) >> 2][(8 + e) & 3], od = o[(9 + e) >> 2][(9 + e) & 3];
                w0[i] = pk2(oa * inv * gn[e] * siluf_(ga), ob * inv * gn[e + 1] * siluf_(gb));
                w1[i] = pk2(oc * inv * gn[8 + e] * siluf_(gc), od * inv * gn[9 + e] * siluf_(gd));
            }
            bf16* yo = y + (size_t)(m0 + t) * 1024 + 512 + h * 128 + v0;
            *(v4u*)yo = w0; *(v4u*)(yo + 8) = w1;
        }
        __syncthreads();
    }
}

constexpr int SG_STAT = 0, SG_W = 1024, SG_V = 35840, SGVP = 528;
__device__ __forceinline__ void phase_sgu(const Args& a, LAS unsigned char* lds, int tid, int lane, int wave, int G) {
    const bf16* z = (const bf16*)(a.ws + WS_P); bf16* y = (bf16*)(a.ws + WS_H);
    const float* lng = a.in[14]; const float* lnb = a.in[15]; const float* ws = a.in[16]; const float* bs = a.in[17];
    const int fr = lane & 15, fq = lane >> 4;
    for (int unit = blockIdx.x; unit < 256; unit += G) {
        const int m0 = unit * 128;
        LAS float* stt = (LAS float*)(lds + SG_STAT);
        for (int r = wave; r < 128; r += 8) {
            const bf16* vr = z + (size_t)(m0 + r) * NIN1 + 1024 + lane * 8;
            const v4u a0 = *(const v4u*)vr, a1 = *(const v4u*)(vr + 512);
            float x[16];
#pragma unroll
            for (int i = 0; i < 4; ++i) { x[2 * i] = bflo(a0[i]); x[2 * i + 1] = bfhi(a0[i]); x[8 + 2 * i] = bflo(a1[i]); x[9 + 2 * i] = bfhi(a1[i]); }
            float s = 0.f;
#pragma unroll
            for (int i = 0; i < 16; ++i) s += x[i];
            const float mean = wave_sum(s) * (1.0f / 1024.0f);
            float q = 0.f;
#pragma unroll
            for (int i = 0; i < 16; ++i) { const float d = x[i] - mean; q += d * d; }
            const float rstd = 1.0f / sqrtf(wave_sum(q) * (1.0f / 1024.0f) + EPS);
            if (lane == 0) { stt[2 * r] = mean; stt[2 * r + 1] = rstd; }
        }
        __syncthreads();
        for (int g = 0; g < 4; ++g) {
            {
                const int t = tid >> 2, s0 = (tid & 3) * 32;
                const float* wr = ws + (size_t)g * 16384 + t * 128 + s0;
#pragma unroll
                for (int j = 0; j < 4; ++j) {
                    const f32x4 w0 = *(const f32x4*)(wr + 8 * j), w1 = *(const f32x4*)(wr + 8 * j + 4);
                    const int s = s0 + 8 * j;
                    v4u o;
                    o.x = pk2(s + 0 <= t ? w0.x : 0.f, s + 1 <= t ? w0.y : 0.f); o.y = pk2(s + 2 <= t ? w0.z : 0.f, s + 3 <= t ? w0.w : 0.f);
                    o.z = pk2(s + 4 <= t ? w1.x : 0.f, s + 5 <= t ? w1.y : 0.f); o.w = pk2(s + 6 <= t ? w1.z : 0.f, s + 7 <= t ? w1.w : 0.f);
                    *(LAS v4u*)(lds + SG_W + t * HP + s * 2) = o;
                }
            }
#pragma unroll 2
            for (int i = 0; i < 8; ++i) {
                const int id = tid + NT * i, s = id >> 5, dc = (id & 31) * 8, col = g * 256 + dc;
                const v4u vv = *(const v4u*)(z + (size_t)(m0 + s) * NIN1 + 1024 + col);
                const float mean = stt[2 * s], rstd = stt[2 * s + 1];
                const f32x4 g0 = *(const f32x4*)(lng + col), g1 = *(const f32x4*)(lng + col + 4), b0 = *(const f32x4*)(lnb + col), b1 = *(const f32x4*)(lnb + col + 4);
                v4u o;
                o.x = pk2((bflo(vv.x) - mean) * rstd * g0.x + b0.x, (bfhi(vv.x) - mean) * rstd * g0.y + b0.y);
                o.y = pk2((bflo(vv.y) - mean) * rstd * g0.z + b0.z, (bfhi(vv.y) - mean) * rstd * g0.w + b0.w);
                o.z = pk2((bflo(vv.z) - mean) * rstd * g1.x + b1.x, (bfhi(vv.z) - mean) * rstd * g1.y + b1.y);
                o.w = pk2((bflo(vv.w) - mean) * rstd * g1.z + b1.z, (bfhi(vv.w) - mean) * rstd * g1.w + b1.w);
                *(LAS v4u*)(lds + SG_V + s * SGVP + dc * 2) = o;
            }
            __syncthreads();
            f32x4 acc[16];
#pragma unroll
            for (int n = 0; n < 16; ++n) acc[n] = (f32x4){0.f, 0.f, 0.f, 0.f};
            for (int ks = 0; ks < 4; ++ks) {
                if (32 * ks > 16 * wave + 15) break;
                const bf16x8 A = rowfrag(lds + SG_W, HP, 16 * wave, 32 * ks, fr, fq);
#pragma unroll
                for (int n = 0; n < 16; ++n) acc[n] = MFMA16(A, trfrag(lds + SG_V, SGVP, 32 * ks, 16 * n, lane), acc[n]);
            }
            __syncthreads();
#pragma unroll
            for (int r = 0; r < 4; ++r) {
                const int t = 16 * wave + 4 * fq + r; const float bsv = bs[g * 128 + t];
#pragma unroll
                for (int n = 0; n < 16; ++n) *(LAS unsigned short*)(lds + SG_V + t * SGVP + (16 * n + fr) * 2) = f2bf(acc[n][r] + bsv);
            }
            __syncthreads();
#pragma unroll 4
            for (int i = 0; i < 8; ++i) {
                const int id = tid + NT * i, t = id >> 5, dc = (id & 31) * 8;
                const v4u mx = *(LAS const v4u*)(lds + SG_V + t * SGVP + dc * 2);
                const v4u uu = *(const v4u*)(z + (size_t)(m0 + t) * NIN1 + g * 256 + dc);
                v4u o;
#pragma unroll
                for (int j = 0; j < 4; ++j) o[j] = pk2(bflo(mx[j]) * bflo(uu[j]), bfhi(mx[j]) * bfhi(uu[j]));
                *(v4u*)(y + (size_t)(m0 + t) * 1024 + g * 256 + dc) = o;
            }
            __syncthreads();
        }
    }
}

#ifndef MK_N_LAUNCHES
#define MK_N_LAUNCHES 1
#endif

__global__ void __launch_bounds__(512, 2) fwd(Args a) {
    extern __shared__ __attribute__((aligned(16))) unsigned char lds_raw[];
    LAS unsigned char* lds = (LAS unsigned char*)lds_raw;
    cg::grid_group grid = cg::this_grid();
    volatile LAS unsigned* MISC = (volatile LAS unsigned*)(lds + MISC_OFF);
    if (threadIdx.x < 16) MISC[threadIdx.x] = 0u;
    __syncthreads();
    const XcdBarrier xbar = xcd_barrier_post((unsigned*)(a.ws + WS_BAR), MISC + 8);
    const int lo = a.ph_lo, hi = a.ph_hi;
#define IN(k) (lo <= (k) && (k) < hi)
#ifndef DBL_MASK
#define DBL_MASK 0
#endif
#define REP(k) _Pragma("unroll 1") for (int rep_ = 0; rep_ <= ((DBL_MASK >> (k)) & 1); ++rep_)
#define SEAM(k) do { if (IN(k) && IN((k) + 1)) { xcd_barrier(xbar); } } while (0)
#define PHASE_VARS int tid = threadIdx.x; asm volatile("" : "+v"(tid)); int G = gridDim.x; asm volatile("" : "+s"(G)); \
    const int lane = tid & 63, wave = __builtin_amdgcn_readfirstlane(tid >> 6); (void)lane; (void)wave; \
    bf16* const H = (bf16*)(a.ws + WS_H); bf16* const P = (bf16*)(a.ws + WS_P); const float* const modf = (const float*)(a.ws + WS_MODF); (void)H; (void)P; (void)modf;
#define GEMM_RES(ph, l, ffn) if (IN(ph)) REP(ph) { PHASE_VARS \
        const bf16* Bt = (ffn) ? (const bf16*)(a.ws + WS_WFF2) + (size_t)(l) * 1024 * 4096 : (const bf16*)(a.ws + ((l) ? WS_WOUT1 : WS_WOUT0)); \
        pg8::Gemm g{(ffn) ? P : H, Bt, M, 1024, (ffn) ? 4096 : 1024}; pg8::StaticOrder S; S.init(M, 1024, G, (int)blockIdx.x); \
        if ((ph) == 6) { pg8::EpiResGateBf<true> E{a.in[0], (bf16*)(a.ws + WS_XR), modf + (size_t)(l) * 8 * 6144 + ((ffn) ? 5 : 2) * 1024}; \
            pg8::gemm_phase<pg8::EpiResGateBf<true>, pg8::StaticOrder, false, true>(lds, g, S, E); } \
        else { pg8::EpiResGateBf<false> E{a.ws + WS_XR, (bf16*)(a.ws + WS_XR), modf + (size_t)(l) * 8 * 6144 + ((ffn) ? 5 : 2) * 1024}; \
            pg8::gemm_phase<pg8::EpiResGateBf<false>, pg8::StaticOrder, false, true>(lds, g, S, E); } } SEAM(ph);
#define GEMM_FF1(ph, l) if (IN(ph)) REP(ph) { PHASE_VARS \
        pg8::Gemm g{H, (const bf16*)(a.ws + WS_WFF1) + (size_t)(l) * 4096 * 1024, M, FF, 1024}; pg8::StaticOrder S; S.init(M, FF, G, (int)blockIdx.x); \
        pg8::EpiBf16<2> E{P, FF, nullptr}; \
        pg8::gemm_phase<pg8::EpiBf16<2>, pg8::StaticOrder, true, true>(lds, g, S, E); } SEAM(ph);
#define NORM(ph, l, ffn) if (IN(ph)) REP(ph) { PHASE_VARS \
        phase_norm_bf(a, ((ffn) ? a.in[5] : a.in[4]) + (l) * 1024, (l), (ffn) ? 3 : 0, (ffn) ? 4 : 1, tid, lane, wave, G); } SEAM(ph);

    if (a.ph_hi > NPH) grid.sync();
    if (IN(0)) REP(0) { PHASE_VARS phase_prologue(a, lds, tid, lane, wave, G); } SEAM(0);
    if (IN(1)) REP(1) { PHASE_VARS phase_norm<true>(a, a.in[0], a.in[4], 0, 0, 1, tid, lane, wave, G); } SEAM(1);
    if (IN(2)) REP(2) { PHASE_VARS
        pg8::Gemm g{H, (const bf16*)(a.ws + WS_WIN0), M, NIN0, 1024}; pg8::StaticOrder S; S.init(M, NIN0, G, (int)blockIdx.x);
        pg8::EpiBf16<0> E{P, NIN0, nullptr};
        pg8::gemm_phase<pg8::EpiBf16<0>, pg8::StaticOrder, true, true>(lds, g, S, E); } SEAM(2);
    if (IN(3)) REP(3) { PHASE_VARS conv_mixer(a, tid, G); hg_pass_a(a, lds, tid, lane, wave, G); } SEAM(3);
    if (IN(4)) REP(4) { PHASE_VARS hg_pass_b(a, tid, G); } SEAM(4);
    if (IN(5)) REP(5) { PHASE_VARS hg_pass_c(a, lds, tid, lane, wave, G); } SEAM(5);
    GEMM_RES(6, 0, false)
    NORM(7, 0, true)
    GEMM_FF1(8, 0)
    GEMM_RES(9, 0, true)
    NORM(10, 1, false)
    if (IN(11)) REP(11) { PHASE_VARS
        pg8::Gemm g{H, (const bf16*)(a.ws + WS_WIN1), M, NIN1, 1024}; pg8::StaticOrder S; S.init(M, NIN1, G, (int)blockIdx.x);
        pg8::EpiBf16<1> E{P, NIN1, a.in[13]};
        pg8::gemm_phase<pg8::EpiBf16<1>, pg8::StaticOrder, true, true>(lds, g, S, E); } SEAM(11);
    if (IN(12)) REP(12) { PHASE_VARS phase_sgu(a, lds, tid, lane, wave, G); } SEAM(12);
    GEMM_RES(13, 1, false)
    NORM(14, 1, true)
    GEMM_FF1(15, 1)
    GEMM_RES(16, 1, true)
    if (IN(17)) REP(17) { PHASE_VARS phase_final_norm(a, lane, wave, G); }
}
}

extern "C" void kernel_launch(void* const* d_in, const int* in_sizes, int n_in, void* d_out, int out_size, void* d_ws, size_t ws_size, hipStream_t stream) {
    using namespace mk;
    static int grid = 0;
    if (grid == 0) {
        if (n_in != 22 || out_size != M * D || ws_size < WS_END) { fprintf(stderr, "kernel_launch: unexpected shapes (n_in %d out %d ws %zu)\n", n_in, out_size, ws_size); grid = -1; return; }
        int dev = 0, cus = 0, per_cu = 0;
        (void)hipGetDevice(&dev); (void)hipDeviceGetAttribute(&cus, hipDeviceAttributeMultiprocessorCount, dev);
        if (hipFuncSetAttribute((const void*)fwd, hipFuncAttributeMaxDynamicSharedMemorySize, LDS_BYTES) != hipSuccess) fprintf(stderr, "kernel_launch: hipFuncSetAttribute failed\n");
        if (hipOccupancyMaxActiveBlocksPerMultiprocessor(&per_cu, (const void*)fwd, NT, LDS_BYTES) != hipSuccess || per_cu < 1) { fprintf(stderr, "kernel_launch: occupancy query says %d\n", per_cu); per_cu = 1; }
        (void)hipGetLastError();
        grid = cus * per_cu;
        if (grid <= 0) grid = 256;
    }
    if (grid < 0) return;
    if (hipMemsetAsync((char*)d_ws + WS_BAR, 0, BAR_ZERO_BYTES, stream) != hipSuccess) fprintf(stderr, "kernel_launch: memset of barrier words failed\n");
    Args a{};
    for (int i = 0; i < 22; ++i) a.in[i] = (const float*)d_in[i];
    a.out = (float*)d_out; a.ws = (unsigned char*)d_ws;
#if MK_N_LAUNCHES == 1
    a.ph_lo = 0; a.ph_hi = NPH;
    void* args[] = {&a};
    hipError_t e = hipLaunchCooperativeKernel((const void*)fwd, dim3(grid), dim3(NT), args, LDS_BYTES, stream);
    if (e != hipSuccess) fprintf(stderr, "cooperative launch failed: %s (grid %d)\n", hipGetErrorString(e), grid);
#else
    for (int ph = 0; ph < NPH; ++ph) {
        a.ph_lo = ph; a.ph_hi = ph + 1;
        hipLaunchKernelGGL(fwd, dim3(grid), dim3(NT), LDS_BYTES, stream, a);
    }
#endif
}
```

```cpp
#include <hip/hip_runtime.h>
#include <hip/hip_cooperative_groups.h>
#include <cstdio>
#include <cstdint>
namespace cg = cooperative_groups;
namespace pg8 {
#define PG8_LAS __attribute__((address_space(3)))
typedef unsigned short bf16_t;
typedef short bf16x8 __attribute__((ext_vector_type(8)));
typedef float f32x4 __attribute__((ext_vector_type(4)));
typedef unsigned u32x4 __attribute__((ext_vector_type(4)));
constexpr int BM = 256, BK = 64, HALF = 128, HTB = HALF * BK * 2  , STAGE_BYTES = 8 * HTB, NXCD = 8, WGM = 8;

__host__ __device__ __forceinline__ int lds_byte(int r, int c) { const int st = (r >> 4) * 2 + (c >> 5), rr = r & 15, cc = c & 31, ob = rr * 64 + cc * 2; return st * 1024 + (ob ^ (((ob >> 9) & 1) << 5)); }
__host__ __device__ __forceinline__ void stage_rc(int b, int& R, int& C) { const int st = b / 1024, sb = b % 1024, swz = sb ^ (((sb >> 9) & 1) << 5); R = (st >> 1) * 16 + swz / 64; C = (st & 1) * 32 + (swz % 64) / 2; }
__host__ __device__ __forceinline__ int perm32(int rho) { const int n = rho >> 4, i = rho & 15; return 8 * (i >> 2) + 4 * n + (i & 3); }

struct Unit { int pm, pn; };
struct Gemm { const bf16_t* A; const bf16_t* Bt; int M, N, K; };

struct StaticOrder {
    int nM, nN, nwg, G, c;
    __host__ __device__ void init(int M, int N, int G_, int c_) { nM = M / BM; nN = N / BM; nwg = nM * nN; G = G_; c = c_; }
    __host__ __device__ bool next(int i, Unit& u) const {
        const long L = (long)i * G + c; if (L >= nwg) return false;
        int wgid = (int)L; { const int q = nwg / NXCD, r = nwg % NXCD, xcd = wgid % NXCD, off = wgid / NXCD; wgid = (xcd < r ? xcd * (q + 1) : r * (q + 1) + (xcd - r) * q) + off; }
        const int nig = WGM * nN, gid = wgid / nig, fm = gid * WGM, gsz = (nM - fm) < WGM ? (nM - fm) : WGM;
        u.pm = fm + ((wgid % nig) % gsz); u.pn = (wgid % nig) / gsz; return true;
    }
    __device__ __forceinline__ void a_ready(const Unit&) const {}
    __device__ __forceinline__ void done(const Unit&) const {}
};

typedef float f32x2c_t __attribute__((ext_vector_type(2)));
typedef __bf16 bf16x2c_t __attribute__((ext_vector_type(2)));
__device__ __forceinline__ unsigned cvt_pk_bf16(float lo, float hi) { const f32x2c_t v = {lo, hi}; const bf16x2c_t b = __builtin_convertvector(v, bf16x2c_t); return __builtin_bit_cast(unsigned, b); }
typedef float f32x2 __attribute__((ext_vector_type(2)));
__device__ __forceinline__ float gelu_tanh(float x) {
    const float u = 0.7978845608f * (x + 0.044715f * x * x * x);
    const float e = __builtin_amdgcn_exp2f(-2.0f * 1.4426950408889634f * u);
    return x * __builtin_amdgcn_rcpf(1.0f + e);
}
template <int ACT> struct EpiBf16 {
    static constexpr bool PERM = true, AFTER_DRAIN = false;
    bf16_t* O; int ldc; const float* bias;
    __device__ __forceinline__ void operator()(const f32x4 (&acc)[2][2][4][2], const Unit& u, int wr, int wc, int fr, int fq) const {
        const int row0 = u.pm * BM + wr * 64 + fr; const int col0 = u.pn * BM + wc * 32 + 8 * fq;
        f32x4 bv[2][2];
#pragma unroll
        for (int bj = 0; bj < 2; ++bj)
#pragma unroll
            for (int n = 0; n < 2; ++n) bv[bj][n] = bias ? *(const f32x4*)(bias + col0 + bj * HALF + 4 * n) : (f32x4){0.f, 0.f, 0.f, 0.f};
#pragma unroll
        for (int ai = 0; ai < 2; ++ai)
#pragma unroll
            for (int m = 0; m < 4; ++m) { bf16_t* rowp = O + (size_t)(row0 + ai * HALF + m * 16) * ldc + col0;
#pragma unroll
                for (int bj = 0; bj < 2; ++bj) { f32x4 v0 = acc[ai][bj][m][0] + bv[bj][0], v1 = acc[ai][bj][m][1] + bv[bj][1];
                    if (ACT == 1) {
#pragma unroll
                        for (int i = 0; i < 4; ++i) { v0[i] = gelu_tanh(v0[i]); v1[i] = gelu_tanh(v1[i]); } }
                    if (ACT == 2) {
#pragma unroll
                        for (int i = 0; i < 4; ++i) { const float a = fmaxf(v0[i], 0.f), b = fmaxf(v1[i], 0.f); v0[i] = a * a; v1[i] = b * b; } }
                    u32x4 w; w.x = cvt_pk_bf16(v0[0], v0[1]); w.y = cvt_pk_bf16(v0[2], v0[3]); w.z = cvt_pk_bf16(v1[0], v1[1]); w.w = cvt_pk_bf16(v1[2], v1[3]);
                    *(u32x4*)(rowp + bj * HALF) = w; } }
    }
};
struct EpiResGate {
    static constexpr bool PERM = false, AFTER_DRAIN = false;
    const float* base; float* out; const float* gate;
    __device__ __forceinline__ void operator()(const f32x4 (&acc)[2][2][4][2], const Unit& u, int wr, int wc, int fr, int fq) const {
        const int row0 = u.pm * BM + wr * 64 + fr; const int col0 = u.pn * BM + wc * 32 + 4 * fq; const int b = u.pm >> 4;
        f32x4 gv[2][2];
#pragma unroll
        for (int bj = 0; bj < 2; ++bj)
#pragma unroll
            for (int n = 0; n < 2; ++n) gv[bj][n] = *(const f32x4*)(gate + (size_t)b * 6144 + col0 + bj * HALF + n * 16);
#pragma unroll
        for (int ai = 0; ai < 2; ++ai) {
            f32x4 bs[4][2][2];
#pragma unroll
            for (int m = 0; m < 4; ++m) { const size_t off = (size_t)(row0 + ai * HALF + m * 16) * 1024 + col0;
#pragma unroll
                for (int bj = 0; bj < 2; ++bj)
#pragma unroll
                    for (int n = 0; n < 2; ++n) bs[m][bj][n] = *(const f32x4*)(base + off + bj * HALF + n * 16); }
#pragma unroll
            for (int m = 0; m < 4; ++m) { const size_t off = (size_t)(row0 + ai * HALF + m * 16) * 1024 + col0;
#pragma unroll
                for (int bj = 0; bj < 2; ++bj)
#pragma unroll
                    for (int n = 0; n < 2; ++n) *(f32x4*)(out + off + bj * HALF + n * 16) = bs[m][bj][n] + gv[bj][n] * acc[ai][bj][m][n]; }
            asm volatile("" ::: "memory"); }
    }
};
template <bool BASE_F32> struct EpiResGateBf {
    static constexpr bool PERM = true, AFTER_DRAIN = false;
    const void* base; bf16_t* out; const float* gate;
    __device__ __forceinline__ void operator()(const f32x4 (&acc)[2][2][4][2], const Unit& u, int wr, int wc, int fr, int fq) const {
        const int row0 = u.pm * BM + wr * 64 + fr; const int col0 = u.pn * BM + wc * 32 + 8 * fq; const int b = u.pm >> 4;
        f32x4 gv[2][2];
#pragma unroll
        for (int bj = 0; bj < 2; ++bj)
#pragma unroll
            for (int n = 0; n < 2; ++n) gv[bj][n] = *(const f32x4*)(gate + (size_t)b * 6144 + col0 + bj * HALF + 4 * n);
#pragma unroll
        for (int ai = 0; ai < 2; ++ai) {
            f32x4 bs[4][2][2];
#pragma unroll
            for (int m = 0; m < 4; ++m) { const size_t off = (size_t)(row0 + ai * HALF + m * 16) * 1024 + col0;
#pragma unroll
                for (int bj = 0; bj < 2; ++bj) {
                    if (BASE_F32) { bs[m][bj][0] = *(const f32x4*)((const float*)base + off + bj * HALF); bs[m][bj][1] = *(const f32x4*)((const float*)base + off + bj * HALF + 4); }
                    else { const u32x4 w = *(const u32x4*)((const bf16_t*)base + off + bj * HALF);
                        bs[m][bj][0] = (f32x4){__builtin_bit_cast(float, w.x << 16), __builtin_bit_cast(float, w.x & 0xffff0000u), __builtin_bit_cast(float, w.y << 16), __builtin_bit_cast(float, w.y & 0xffff0000u)};
                        bs[m][bj][1] = (f32x4){__builtin_bit_cast(float, w.z << 16), __builtin_bit_cast(float, w.z & 0xffff0000u), __builtin_bit_cast(float, w.w << 16), __builtin_bit_cast(float, w.w & 0xffff0000u)}; } } }
#pragma unroll
            for (int m = 0; m < 4; ++m) { const size_t off = (size_t)(row0 + ai * HALF + m * 16) * 1024 + col0;
#pragma unroll
                for (int bj = 0; bj < 2; ++bj) { const f32x4 v0 = bs[m][bj][0] + gv[bj][0] * acc[ai][bj][m][0], v1 = bs[m][bj][1] + gv[bj][1] * acc[ai][bj][m][1];
                    u32x4 w; w.x = cvt_pk_bf16(v0[0], v0[1]); w.y = cvt_pk_bf16(v0[2], v0[3]); w.z = cvt_pk_bf16(v1[0], v1[1]); w.w = cvt_pk_bf16(v1[2], v1[3]);
                    *(u32x4*)(out + off + bj * HALF) = w; } }
            asm volatile("" ::: "memory"); }
    }
};
template <class Epi, class Sched, bool ALIGN_EPI = false, bool SP2 = false>
__device__ __forceinline__ void gemm_phase(PG8_LAS unsigned char* lds, const Gemm g, const Sched& S, const Epi& E) {
    const int tid = threadIdx.x, wid = __builtin_amdgcn_readfirstlane(tid >> 6), lane = tid & 63, wr = wid >> 2, wc = wid & 3, fr = lane & 15, fq = lane >> 4;
    const int K = g.K, nt = K / BK;
    unsigned voffA[2], voffB[2];
#pragma unroll
    for (int i = 0; i < 2; ++i) { int R, C; stage_rc(tid * 16 + i * 8192, R, C); const int Rb = Epi::PERM ? ((R & ~31) + perm32(R & 31)) : R;
        voffA[i] = (unsigned)(R * K + C) * 2u; voffB[i] = (unsigned)(Rb * K + C) * 2u; }
    const size_t kstep = (size_t)(BK * 2);
    const size_t hstep = (size_t)HALF * K * 2;
    const size_t tstep = 2 * hstep;
    const unsigned ldsw = (unsigned)wid * 1024u;
    const int aoff = lds_byte(wr * 64 + fr, fq * 8), boff = lds_byte(wc * 32 + fr, fq * 8);
#define PG8_SA(b, h) (((b) * 2 + (h)) * HTB)
#define PG8_SB(b, h) ((4 + (b) * 2 + (h)) * HTB)
#define PG8_STAGE(bufoff, gbase, voff) do { _Pragma("unroll") for (int _i = 0; _i < 2; ++_i) \
        __builtin_amdgcn_global_load_lds((const unsigned*)((const char*)(gbase) + (voff)[_i]), (PG8_LAS unsigned*)(lds + (bufoff) + ldsw + _i * 8192), 16, 0, 0); } while (0)
#define PG8_LDA(dst, b, h) do { _Pragma("unroll") for (int m = 0; m < 4; ++m) _Pragma("unroll") for (int k = 0; k < 2; ++k) dst[m][k] = *(const PG8_LAS bf16x8*)(lds + PG8_SA(b, h) + aoff + m * 2048 + k * 1024); } while (0)
#define PG8_LDB(dst, b, h) do { _Pragma("unroll") for (int n = 0; n < 2; ++n) _Pragma("unroll") for (int k = 0; k < 2; ++k) dst[n][k] = *(const PG8_LAS bf16x8*)(lds + PG8_SB(b, h) + boff + n * 2048 + k * 1024); } while (0)
#define PG8_MMA(ai, bj, At, Bt) do { __builtin_amdgcn_s_setprio(1); _Pragma("unroll") for (int m = 0; m < 4; ++m) _Pragma("unroll") for (int n = 0; n < 2; ++n) _Pragma("unroll") for (int k = 0; k < 2; ++k) \
        acc[ai][bj][m][n] = __builtin_amdgcn_mfma_f32_16x16x32_bf16(Bt[n][k], At[m][k], acc[ai][bj][m][n], 0, 0, 0); __builtin_amdgcn_s_setprio(0); } while (0)
#define PG8_WAIT_V(n) asm volatile("s_waitcnt vmcnt(" #n ")" ::: "memory")
#define PG8_WAIT_L(n) asm volatile("s_waitcnt lgkmcnt(" #n ")" ::: "memory")
#define PG8_BAR __builtin_amdgcn_s_barrier()
#define PG8_SCHED __builtin_amdgcn_sched_barrier(0)
    Unit cur, nxt; int ui = 0;
    if (!S.next(0, cur)) return;
    f32x4 acc[2][2][4][2];
#pragma unroll
    for (int a = 0; a < 2; ++a)
#pragma unroll
        for (int b = 0; b < 2; ++b)
#pragma unroll
            for (int m = 0; m < 4; ++m)
#pragma unroll
                for (int n = 0; n < 2; ++n) acc[a][b][m][n] = (f32x4){0.f, 0.f, 0.f, 0.f};
    bf16x8 At[4][2], B0[2][2], B1[2][2];
    const char* cA = (const char*)g.A + (size_t)cur.pm * tstep; const char* cB = (const char*)g.Bt + (size_t)cur.pn * tstep;
    S.a_ready(cur);
    if constexpr (SP2) {
        PG8_STAGE(PG8_SB(0, 0), cB, voffB); PG8_STAGE(PG8_SB(0, 1), cB + hstep, voffB); PG8_STAGE(PG8_SA(0, 0), cA, voffA); PG8_STAGE(PG8_SA(0, 1), cA + hstep, voffA);
        if (wr == 1) PG8_BAR;
        PG8_WAIT_V(2); PG8_BAR;
        PG8_STAGE(PG8_SB(1, 0), cB + kstep, voffB); PG8_STAGE(PG8_SA(1, 0), cA + kstep, voffA); PG8_STAGE(PG8_SB(1, 1), cB + hstep + kstep, voffB);
        PG8_WAIT_V(6); PG8_BAR;
    } else {
        PG8_STAGE(PG8_SB(0, 0), cB, voffB); PG8_STAGE(PG8_SA(0, 0), cA, voffA); PG8_STAGE(PG8_SB(0, 1), cB + hstep, voffB); PG8_STAGE(PG8_SA(0, 1), cA + hstep, voffA);
        if (wr == 1) PG8_BAR;
        PG8_WAIT_V(4); PG8_BAR;
        PG8_STAGE(PG8_SB(1, 0), cB + kstep, voffB); PG8_STAGE(PG8_SA(1, 0), cA + kstep, voffA); PG8_STAGE(PG8_SB(1, 1), cB + hstep + kstep, voffB);
        PG8_WAIT_V(6); PG8_BAR;
    }
    for (;;) {
        const bool has_next = S.next(ui + 1, nxt);
        const char* nA = has_next ? (const char*)g.A + (size_t)nxt.pm * tstep : cA; const char* nB = has_next ? (const char*)g.Bt + (size_t)nxt.pn * tstep : cB;
        for (int t = 0; t < nt; t += 2) {
            const bool last = (t == nt - 2);
            const char* a1 = cA + (size_t)(t + 1) * kstep;
            const char* a2 = last ? nA : cA + (size_t)(t + 2) * kstep; const char* b2 = last ? nB : cB + (size_t)(t + 2) * kstep;
            const char* a3 = a2 + kstep; const char* b3 = b2 + kstep;
            if (last && has_next) S.a_ready(nxt);
            if constexpr (SP2) {
            PG8_LDB(B0, 0, 0); PG8_LDB(B1, 0, 1); PG8_SCHED; PG8_LDA(At, 0, 0); PG8_STAGE(PG8_SA(1, 1), a1 + hstep, voffA);
            PG8_WAIT_V(8); PG8_WAIT_L(0); PG8_BAR; PG8_MMA(0, 0, At, B0); PG8_MMA(0, 1, At, B1); PG8_BAR; PG8_SCHED;
            PG8_LDA(At, 0, 1); PG8_STAGE(PG8_SB(0, 0), b2, voffB); PG8_STAGE(PG8_SB(0, 1), b2 + hstep, voffB); PG8_STAGE(PG8_SA(0, 0), a2, voffA);
            PG8_WAIT_V(8); PG8_WAIT_L(0); PG8_BAR; PG8_MMA(1, 0, At, B0); PG8_MMA(1, 1, At, B1); PG8_BAR; PG8_SCHED;
            PG8_LDB(B0, 1, 0); PG8_LDB(B1, 1, 1); PG8_SCHED; PG8_LDA(At, 1, 0); PG8_STAGE(PG8_SA(0, 1), a2 + hstep, voffA);
            PG8_WAIT_V(8); PG8_WAIT_L(0); PG8_BAR; PG8_MMA(0, 0, At, B0); PG8_MMA(0, 1, At, B1); PG8_BAR; PG8_SCHED;
            PG8_LDA(At, 1, 1); PG8_STAGE(PG8_SB(1, 0), b3, voffB); PG8_STAGE(PG8_SB(1, 1), b3 + hstep, voffB); PG8_STAGE(PG8_SA(1, 0), a3, voffA);
            PG8_WAIT_V(8); PG8_WAIT_L(0); PG8_BAR; PG8_MMA(1, 0, At, B0); PG8_MMA(1, 1, At, B1); PG8_BAR; PG8_SCHED;
            } else {
            PG8_LDB(B0, 0, 0); PG8_SCHED; PG8_LDA(At, 0, 0); PG8_STAGE(PG8_SA(1, 1), a1 + hstep, voffA);
            PG8_WAIT_L(8); PG8_BAR; PG8_WAIT_L(0); PG8_MMA(0, 0, At, B0); PG8_BAR; PG8_SCHED;
            PG8_LDB(B1, 0, 1); PG8_STAGE(PG8_SB(0, 0), b2, voffB);
            PG8_BAR; PG8_WAIT_L(0); PG8_MMA(0, 1, At, B1); PG8_BAR;
            PG8_LDA(At, 0, 1); PG8_STAGE(PG8_SA(0, 0), a2, voffA);
            PG8_BAR; PG8_WAIT_L(0); PG8_MMA(1, 0, At, B0); PG8_BAR; PG8_SCHED;
            PG8_STAGE(PG8_SB(0, 1), b2 + hstep, voffB);
            PG8_WAIT_V(6); PG8_BAR; PG8_MMA(1, 1, At, B1); PG8_BAR;
            PG8_LDB(B0, 1, 0); PG8_SCHED; PG8_LDA(At, 1, 0); PG8_STAGE(PG8_SA(0, 1), a2 + hstep, voffA);
            PG8_WAIT_L(8); PG8_BAR; PG8_WAIT_L(0); PG8_MMA(0, 0, At, B0); PG8_BAR; PG8_SCHED;
            PG8_LDB(B1, 1, 1); PG8_STAGE(PG8_SB(1, 0), b3, voffB);
            PG8_BAR; PG8_WAIT_L(0); PG8_MMA(0, 1, At, B1); PG8_BAR;
            PG8_LDA(At, 1, 1); PG8_STAGE(PG8_SA(1, 0), a3, voffA);
            PG8_BAR; PG8_WAIT_L(0); PG8_MMA(1, 0, At, B0); PG8_BAR; PG8_SCHED;
            PG8_STAGE(PG8_SB(1, 1), b3 + hstep, voffB);
            PG8_WAIT_V(6); PG8_BAR; PG8_MMA(1, 1, At, B1); PG8_BAR;
            }
        }
        if constexpr (ALIGN_EPI) { if (wr == 0) PG8_BAR; }
        if constexpr (!Epi::AFTER_DRAIN) { E(acc, cur, wr, wc, fr, fq); S.done(cur); }
        if (!has_next) break;
#pragma unroll
        for (int a = 0; a < 2; ++a)
#pragma unroll
            for (int b = 0; b < 2; ++b)
#pragma unroll
                for (int m = 0; m < 4; ++m)
#pragma unroll
                    for (int n = 0; n < 2; ++n) acc[a][b][m][n] = (f32x4){0.f, 0.f, 0.f, 0.f};
        cur = nxt; cA = nA; cB = nB; ++ui;
        if constexpr (ALIGN_EPI) { if (wr == 1) PG8_BAR; }
    }
    PG8_WAIT_V(0);
    if constexpr (!ALIGN_EPI) { if (wr == 0) PG8_BAR; }
    PG8_BAR;
    if constexpr (Epi::AFTER_DRAIN) { E.fused(acc, cur, wr, wc, fr, fq, lds, wid, lane); S.done(cur); }
#undef PG8_SA
#undef PG8_SB
#undef PG8_STAGE
#undef PG8_LDA
#undef PG8_LDB
#undef PG8_MMA
#undef PG8_WAIT_V
#undef PG8_WAIT_L
#undef PG8_BAR
#undef PG8_SCHED
}
}
namespace mk {
#define LAS __attribute__((address_space(3)))
typedef unsigned short bf16;
typedef short bf16x8 __attribute__((ext_vector_type(8)));
typedef short s16x4 __attribute__((ext_vector_type(4)));
typedef float f32x4 __attribute__((ext_vector_type(4)));
typedef unsigned v4u __attribute__((ext_vector_type(4)));
typedef unsigned v2u __attribute__((ext_vector_type(2)));

constexpr int BATCH = 8, SEQ = 4096, D = 1024, M = BATCH * SEQ, FF = 4096, NIN0 = 3584, NIN1 = 2048;
constexpr int NT = 512;
constexpr float EPS = 1e-6f;
constexpr size_t MiB = 1u << 20;
constexpr size_t WS_MODP = 440 * MiB;
constexpr int NCH = 16;
constexpr size_t WS_MODF = 3 * MiB;
constexpr size_t WS_DEC = 4 * MiB;
constexpr size_t WS_BAR = 5 * MiB, BAR_ZERO_BYTES = 16384;
constexpr int MISC_OFF = 131072;
constexpr size_t WS_WIN0 = 8 * MiB, WS_WOUT0 = 15 * MiB, WS_WIN1 = 17 * MiB, WS_WOUT1 = 21 * MiB, WS_WFF1 = 23 * MiB, WS_WFF2 = 39 * MiB;
constexpr size_t WS_H = 56 * MiB;
constexpr size_t WS_P = 120 * MiB;
constexpr size_t WS_S = 376 * MiB;
constexpr size_t WS_XR = 376 * MiB;
constexpr size_t WS_END = 448 * MiB;
constexpr int LDS_BYTES = 147456;
constexpr int NPH = 18;

struct Args { const float* in[22]; float* out; unsigned char* ws; int ph_lo, ph_hi; };

__device__ __forceinline__ float bf2f(unsigned u) { return __builtin_bit_cast(float, u << 16); }
__device__ __forceinline__ float bflo(unsigned w) { return __builtin_bit_cast(float, w << 16); }
__device__ __forceinline__ float bfhi(unsigned w) { return __builtin_bit_cast(float, w & 0xffff0000u); }
typedef float f32x2_t __attribute__((ext_vector_type(2)));
typedef __bf16 bf16x2_t __attribute__((ext_vector_type(2)));
__device__ __forceinline__ unsigned pk2(float lo, float hi) { const f32x2_t v = {lo, hi}; const bf16x2_t b = __builtin_convertvector(v, bf16x2_t); return __builtin_bit_cast(unsigned, b); }
__device__ __forceinline__ unsigned short f2bf(float f) { return __builtin_bit_cast(unsigned short, (__bf16)f); }
__device__ __forceinline__ float wave_sum(float v) {
#pragma unroll
    for (int o = 1; o < 64; o <<= 1) v += __shfl_xor(v, o);
    return v;
}
__device__ __forceinline__ float sigmoidf_(float x) { return __builtin_amdgcn_rcpf(1.0f + __expf(-x)); }
__device__ __forceinline__ float siluf_(float x) { return x * sigmoidf_(x); }

__device__ __forceinline__ bf16x8 rowfrag(LAS const unsigned char* T, int pitchB, int r0, int k0, int fr, int fq) {
    return *(LAS const bf16x8*)(T + (r0 + fr) * pitchB + (k0 + 8 * fq) * 2);
}
typedef short v4i16_t __attribute__((ext_vector_type(4)));
__device__ __forceinline__ bf16x8 trfrag(LAS const unsigned char* T, int pitchB, int k0, int n0, int lane) {
    const int g = lane >> 4, q = (lane & 15) >> 2, pp = lane & 3;
    LAS const unsigned char* p0 = T + (k0 + 8 * g + q) * pitchB + (n0 + 4 * pp) * 2;
    const v4i16_t a = __builtin_amdgcn_ds_read_tr16_b64_v4i16((LAS v4i16_t*)p0);
    const v4i16_t b = __builtin_amdgcn_ds_read_tr16_b64_v4i16((LAS v4i16_t*)(p0 + 4 * pitchB));
    return (bf16x8){a.x, a.y, a.z, a.w, b.x, b.y, b.z, b.w};
}
#define MFMA16(a, b, c) __builtin_amdgcn_mfma_f32_16x16x32_bf16((a), (b), (c), 0, 0, 0)

#define XB_TMO      128
#define XB_XCNT(j)  (256  + 64 * (j))
#define XB_XSUB(j)  (1280 + 64 * (j))
#define XB_XGEN(j)  (2304 + 64 * (j))
#define XB_TOP      3328
#define XB_TOPGEN   3392
#define XCD_BAR_WORDS 3456
#define XB_SPIN_CAP (1u << 18)

__device__ __forceinline__ unsigned xb_ld(unsigned* p)              { return __hip_atomic_load(p, __ATOMIC_RELAXED, __HIP_MEMORY_SCOPE_AGENT); }
__device__ __forceinline__ unsigned xb_add(unsigned* p, unsigned v) { return __hip_atomic_fetch_add(p, v, __ATOMIC_RELAXED, __HIP_MEMORY_SCOPE_AGENT); }
__device__ __forceinline__ unsigned xb_xcc_id() { return (unsigned)__builtin_amdgcn_s_getreg((3 << 11) | 20) & 0xFu; }
#define XB_SPIN(cond, bar) do { unsigned _sp = 0; while (cond) { __builtin_amdgcn_s_sleep(1); \
    if ((++_sp & 255u) == 0u) { if (xb_ld(&(bar)[XB_TMO])) break; if (_sp > XB_SPIN_CAP) { atomicAdd(&(bar)[XB_TMO], 1u); break; } } } } while (0)

struct XcdBarrier {
    unsigned* bar; unsigned x;
    volatile LAS unsigned* st;
};

__device__ __forceinline__ XcdBarrier xcd_barrier_post(unsigned* bar, volatile LAS unsigned* st) {
    XcdBarrier b; b.bar = bar; b.x = xb_xcc_id(); b.st = st;
    if (threadIdx.x == 0) (void)xb_add(&bar[XB_XCNT(b.x)], 1u);
    return b;
}
__device__ __forceinline__ void xcd_barrier_complete(unsigned* bar, unsigned x, unsigned& nloc, unsigned& nx) {
    const unsigned G = gridDim.x * gridDim.y * gridDim.z;
    unsigned sum, cnt, mine, sp = 0u;
    for (;;) {
        sum = 0u; cnt = 0u; mine = 0u;
#pragma unroll
        for (unsigned j = 0; j < 16; ++j) { const unsigned c = xb_ld(&bar[XB_XCNT(j)]); sum += c; cnt += (c > 0u) ? 1u : 0u; mine = (j == x) ? c : mine; }
        if (sum == G) break;
        __builtin_amdgcn_s_sleep(1);
        if ((++sp & 255u) == 0u) { if (xb_ld(&bar[XB_TMO])) break; if (sp > XB_SPIN_CAP) { atomicAdd(&bar[XB_TMO], 1u); break; } }
    }
    nloc = mine > 0u ? mine : 1u; nx = cnt > 0u ? cnt : 1u;
}

__device__ __forceinline__ void xcd_barrier(const XcdBarrier& b) {
    asm volatile("s_waitcnt vmcnt(0)" ::: "memory");
    __syncthreads();
    if (threadIdx.x == 0) {
        unsigned* bar = b.bar;
        __builtin_amdgcn_s_waitcnt(0);
        unsigned nloc = b.st[0], nx = b.st[1];
        if (nloc == 0u) { xcd_barrier_complete(bar, b.x, nloc, nx); b.st[0] = nloc; b.st[1] = nx; }
        const unsigned old = xb_add(&bar[XB_XSUB(b.x)], 1u);
        const unsigned gen = old / nloc;
        if (old + 1u == (gen + 1u) * nloc) {
            __builtin_amdgcn_fence(__ATOMIC_RELEASE, "agent");
            asm volatile("s_waitcnt vmcnt(0)" ::: "memory");
            const unsigned og = xb_add(&bar[XB_TOP], 1u);
            const unsigned tg = og / nx;
            if (og + 1u == (tg + 1u) * nx) xb_add(&bar[XB_TOPGEN], 1u);
            else XB_SPIN(xb_ld(&bar[XB_TOPGEN]) == tg, bar);
            __builtin_amdgcn_fence(__ATOMIC_ACQUIRE, "agent");
            xb_add(&bar[XB_XGEN(b.x)], 1u);
            asm volatile("s_waitcnt vmcnt(0)" ::: "memory");
        } else {
            XB_SPIN(xb_ld(&bar[XB_XGEN(b.x)]) == gen, bar);
            __builtin_amdgcn_fence(__ATOMIC_ACQUIRE, "agent");
            asm volatile("s_waitcnt vmcnt(0)" ::: "memory");
        }
    }
    __syncthreads();
}

__device__ __forceinline__ void transpose_item(const float* W, int K, int N, bf16* WT, LAS float* scr, int item, int lane) {
    const int nblk = N / 32, kb = item / nblk, nb = item % nblk, k0 = 64 * kb, n0 = 32 * nb;
    float tv[32];
#pragma unroll
    for (int i = 0; i < 32; ++i) tv[i] = W[(size_t)(k0 + 2 * i + (lane >> 5)) * N + n0 + (lane & 31)];
#pragma unroll
    for (int i = 0; i < 32; ++i) scr[(2 * i + (lane >> 5)) * 33 + (lane & 31)] = tv[i];
    asm volatile("s_waitcnt lgkmcnt(0)" ::: "memory");
    const int c = lane & 7;
#pragma unroll
    for (int j = 0; j < 4; ++j) { const int n = (lane >> 3) + 8 * j; const LAS float* s = scr + (8 * c) * 33 + n;
        v4u o; o.x = pk2(s[0 * 33], s[1 * 33]); o.y = pk2(s[2 * 33], s[3 * 33]); o.z = pk2(s[4 * 33], s[5 * 33]); o.w = pk2(s[6 * 33], s[7 * 33]);
        *(v4u*)(WT + (size_t)(n0 + n) * K + k0 + 8 * c) = o; }
    asm volatile("s_waitcnt lgkmcnt(0)" ::: "memory");
}
__device__ __forceinline__ void phase_prologue(const Args& a, LAS unsigned char* lds, int tid, int lane, int wave, int G) {
    LAS float* sc = (LAS float*)lds;
    const float* c = a.in[1];
    for (int i = tid; i < 8192; i += NT) sc[i] = siluf_(c[i]);
    __syncthreads();
    float* modp = (float*)(a.ws + WS_MODP);
    for (int it = blockIdx.x; it < 2 * NCH * 12; it += G) {
        const int l = it / (NCH * 12), r = it % (NCH * 12), ch = r / 12, eb = r % 12, e = eb * 512 + tid;
        const float* w = a.in[2] + ((size_t)l * 1024 + ch * 64) * 6144 + e;
        float acc0 = 0.f, acc1 = 0.f, acc2 = 0.f, acc3 = 0.f, acc4 = 0.f, acc5 = 0.f, acc6 = 0.f, acc7 = 0.f;
        const LAS float* s = sc + ch * 64;
#pragma unroll 16
        for (int d = 0; d < 64; ++d) { const float wv = w[(size_t)d * 6144];
            acc0 += s[d] * wv; acc1 += s[1024 + d] * wv; acc2 += s[2048 + d] * wv; acc3 += s[3072 + d] * wv;
            acc4 += s[4096 + d] * wv; acc5 += s[5120 + d] * wv; acc6 += s[6144 + d] * wv; acc7 += s[7168 + d] * wv; }
        float* o = modp + (size_t)((ch * 2 + l) * 8) * 6144 + e;
        o[0] = acc0; o[6144] = acc1; o[2 * 6144] = acc2; o[3 * 6144] = acc3; o[4 * 6144] = acc4; o[5 * 6144] = acc5; o[6 * 6144] = acc6; o[7 * 6144] = acc7;
    }
    __syncthreads();
    LAS float* scr = (LAS float*)(lds + 32768 + wave * 8704);
    const int gw = blockIdx.x * 8 + wave, NGW = G * 8;
    constexpr int I0 = 1792, I1 = 512, I2 = 1024, I3 = 512, I4 = 2048, I5 = 2048;
    constexpr int NITEMS = I0 + I1 + I2 + I3 + 2 * I4 + 2 * I5;
    for (int it = gw; it < NITEMS; it += NGW) {
        int r = it;
        if (r < I0) { transpose_item(a.in[6], 1024, NIN0, (bf16*)(a.ws + WS_WIN0), scr, r, lane); continue; } r -= I0;
        if (r < I1) { transpose_item(a.in[11], 1024, 1024, (bf16*)(a.ws + WS_WOUT0), scr, r, lane); continue; } r -= I1;
        if (r < I2) { transpose_item(a.in[12], 1024, NIN1, (bf16*)(a.ws + WS_WIN1), scr, r, lane); continue; } r -= I2;
        if (r < I3) { transpose_item(a.in[18], 1024, 1024, (bf16*)(a.ws + WS_WOUT1), scr, r, lane); continue; } r -= I3;
        if (r < 2 * I4) { const int l = r / I4; transpose_item(a.in[19] + (size_t)l * 1024 * 4096, 1024, 4096, (bf16*)(a.ws + WS_WFF1) + (size_t)l * 4096 * 1024, scr, r % I4, lane); continue; } r -= 2 * I4;
        { const int l = r / I5; transpose_item(a.in[20] + (size_t)l * 4096 * 1024, 4096, 1024, (bf16*)(a.ws + WS_WFF2) + (size_t)l * 1024 * 4096, scr, r % I5, lane); }
    }
}

template <bool PARTIAL>
__device__ __forceinline__ float modval(const Args& a, int l, int b, int idx) {
    if (PARTIAL) {
        const float* modp = (const float*)(a.ws + WS_MODP);
        float s = a.in[3][l * 6144 + idx];
#pragma unroll
        for (int ch = 0; ch < NCH; ++ch) s += modp[(size_t)((ch * 2 + l) * 8 + b) * 6144 + idx];
        return s;
    } else {
        return ((const float*)(a.ws + WS_MODF))[(size_t)(l * 8 + b) * 6144 + idx];
    }
}
template <bool PARTIAL>
__device__ __forceinline__ void phase_norm(const Args& a, LAS unsigned char* lds, const float* xsrc, const float* gvec, int l, int jshift, int jscale, int tid, int lane, int wave, int G) {
    bf16* h = (bf16*)(a.ws + WS_H);
    if (PARTIAL) {
        float* modf = (float*)(a.ws + WS_MODF);
        for (int i = blockIdx.x * NT + tid; i < 2 * 8 * 6144; i += G * NT) { const int ll = i / 49152, bb = (i / 6144) % 8, idx = i % 6144; modf[i] = modval<true>(a, ll, bb, idx); }
    }
    for (int blk = blockIdx.x; blk < 256; blk += G) {
        const int b = blk >> 5;
        f32x4 gs[4], sh[4];
        if (PARTIAL) {
            LAS float* mv = (LAS float*)lds;
            __syncthreads();
#pragma unroll
            for (int i = 0; i < 4; ++i) { const int e = tid + NT * i; mv[e] = modval<true>(a, l, b, (e < 1024 ? jscale * 1024 + e : jshift * 1024 + e - 1024)); }
            __syncthreads();
#pragma unroll
            for (int j = 0; j < 4; ++j) { const int col = lane * 4 + 256 * j;
#pragma unroll
                for (int i = 0; i < 4; ++i) { gs[j][i] = gvec[col + i] * (1.0f + mv[col + i]); sh[j][i] = mv[1024 + col + i]; } }
        } else {
#pragma unroll
        for (int j = 0; j < 4; ++j) { const int col = lane * 4 + 256 * j;
#pragma unroll
            for (int i = 0; i < 4; ++i) { gs[j][i] = gvec[col + i] * (1.0f + modval<PARTIAL>(a, l, b, jscale * 1024 + col + i)); sh[j][i] = modval<PARTIAL>(a, l, b, jshift * 1024 + col + i); } }
        }
        const float* xb = xsrc + (size_t)blk * 128 * 1024;
        f32x4 nx[4];
#pragma unroll
        for (int j = 0; j < 4; ++j) nx[j] = ((const f32x4*)(xb + (size_t)wave * 1024) + lane)[64 * j];
        for (int r = wave; r < 128; r += 8) {
            const size_t m = (size_t)blk * 128 + r;
            f32x4 v[4]; float ss = 0.f;
#pragma unroll
            for (int j = 0; j < 4; ++j) { v[j] = nx[j]; ss += (v[j].x * v[j].x + v[j].y * v[j].y) + (v[j].z * v[j].z + v[j].w * v[j].w); }
            if (r + 8 < 128) {
#pragma unroll
                for (int j = 0; j < 4; ++j) nx[j] = ((const f32x4*)(xb + (size_t)(r + 8) * 1024) + lane)[64 * j];
            }
            const float inv = 1.0f / sqrtf(wave_sum(ss) * (1.0f / 1024.0f) + EPS);
            v2u* o8 = (v2u*)(h + m * 1024) + lane;
#pragma unroll
            for (int j = 0; j < 4; ++j) { const f32x4 o = v[j] * inv * gs[j] + sh[j]; v2u w; w.x = pk2(o.x, o.y); w.y = pk2(o.z, o.w); o8[64 * j] = w; }
        }
    }
}
__device__ __forceinline__ void unpack8(const v4u w, float (&x)[16], int o) {
#pragma unroll
    for (int i = 0; i < 4; ++i) { x[o + 2 * i] = bflo(w[i]); x[o + 2 * i + 1] = bfhi(w[i]); }
}
__device__ __forceinline__ void phase_norm_bf(const Args& a, const float* gvec, int l, int jshift, int jscale, int tid, int lane, int wave, int G) {
    bf16* h = (bf16*)(a.ws + WS_H); const bf16* xr = (const bf16*)(a.ws + WS_XR);
    for (int blk = blockIdx.x; blk < 256; blk += G) {
        const int b = blk >> 5;
        float gs[16], sh[16];
#pragma unroll
        for (int j = 0; j < 2; ++j)
#pragma unroll
            for (int i = 0; i < 8; ++i) { const int col = lane * 8 + 512 * j + i; gs[8 * j + i] = gvec[col] * (1.0f + modval<false>(a, l, b, jscale * 1024 + col)); sh[8 * j + i] = modval<false>(a, l, b, jshift * 1024 + col); }
        const bf16* xb = xr + (size_t)blk * 128 * 1024 + lane * 8;
        v4u n0 = *(const v4u*)(xb + (size_t)wave * 1024), n1 = *(const v4u*)(xb + (size_t)wave * 1024 + 512);
        for (int r = wave; r < 128; r += 8) {
            float x[16]; unpack8(n0, x, 0); unpack8(n1, x, 8);
            if (r + 8 < 128) { n0 = *(const v4u*)(xb + (size_t)(r + 8) * 1024); n1 = *(const v4u*)(xb + (size_t)(r + 8) * 1024 + 512); }
            float ss = 0.f;
#pragma unroll
            for (int i = 0; i < 16; ++i) ss += x[i] * x[i];
            const float inv = 1.0f / sqrtf(wave_sum(ss) * (1.0f / 1024.0f) + EPS);
            bf16* ho = h + ((size_t)blk * 128 + r) * 1024 + lane * 8;
#pragma unroll
            for (int j = 0; j < 2; ++j) { v4u w;
#pragma unroll
                for (int i = 0; i < 4; ++i) w[i] = pk2(x[8 * j + 2 * i] * inv * gs[8 * j + 2 * i] + sh[8 * j + 2 * i], x[8 * j + 2 * i + 1] * inv * gs[8 * j + 2 * i + 1] + sh[8 * j + 2 * i + 1]);
                *(v4u*)(ho + 512 * j) = w; }
        }
    }
}
__device__ __forceinline__ void phase_final_norm(const Args& a, int lane, int wave, int G) {
    const float* g = a.in[21]; const bf16* xr = (const bf16*)(a.ws + WS_XR);
    float gs[16];
#pragma unroll
    for (int j = 0; j < 2; ++j)
#pragma unroll
        for (int i = 0; i < 8; ++i) gs[8 * j + i] = g[lane * 8 + 512 * j + i];
    int m = blockIdx.x * 8 + wave;
    v4u n0 = (v4u){0u, 0u, 0u, 0u}, n1 = n0;
    if (m < M) { n0 = *(const v4u*)(xr + (size_t)m * 1024 + lane * 8); n1 = *(const v4u*)(xr + (size_t)m * 1024 + lane * 8 + 512); }
    for (; m < M; m += G * 8) {
        float x[16]; unpack8(n0, x, 0); unpack8(n1, x, 8);
        if (m + G * 8 < M) { n0 = *(const v4u*)(xr + (size_t)(m + G * 8) * 1024 + lane * 8); n1 = *(const v4u*)(xr + (size_t)(m + G * 8) * 1024 + lane * 8 + 512); }
        float ss = 0.f;
#pragma unroll
        for (int i = 0; i < 16; ++i) ss += x[i] * x[i];
        const float inv = 1.0f / sqrtf(wave_sum(ss) * (1.0f / 1024.0f) + EPS);
        float* o = a.out + (size_t)m * 1024 + lane * 8;
#pragma unroll
        for (int j = 0; j < 2; ++j) {
            *(f32x4*)(o + 512 * j) = (f32x4){x[8 * j] * inv * gs[8 * j], x[8 * j + 1] * inv * gs[8 * j + 1], x[8 * j + 2] * inv * gs[8 * j + 2], x[8 * j + 3] * inv * gs[8 * j + 3]};
            *(f32x4*)(o + 512 * j + 4) = (f32x4){x[8 * j + 4] * inv * gs[8 * j + 4], x[8 * j + 5] * inv * gs[8 * j + 5], x[8 * j + 6] * inv * gs[8 * j + 6], x[8 * j + 7] * inv * gs[8 * j + 7]};
        }
    }
}

__device__ __forceinline__ void conv_mixer(const Args& a, int tid, int G) {
    const bf16* p = (const bf16*)(a.ws + WS_P); bf16* y = (bf16*)(a.ws + WS_H);
    const float* cw = a.in[7]; const float* cb = a.in[8];
    for (int it = blockIdx.x * NT + tid; it < M * 64; it += G * NT) {
        const int m = it >> 6, c0 = (it & 63) * 8, t = m & (SEQ - 1);
        const bf16* pr = p + (size_t)m * NIN0 + c0;
        float conv[8];
#pragma unroll
        for (int i = 0; i < 8; ++i) conv[i] = cb[c0 + i];
#pragma unroll
        for (int tap = 0; tap < 3; ++tap) {
            const int dt = 2 - tap;
            if (t - dt >= 0) {
                const v4u cc = *(const v4u*)(pr - (size_t)dt * NIN0 + 512), hh = *(const v4u*)(pr - (size_t)dt * NIN0 + 1024);
#pragma unroll
                for (int i = 0; i < 4; ++i) {
                    conv[2 * i] += cw[tap * 512 + c0 + 2 * i] * (bflo(cc[i]) * bflo(hh[i]));
                    conv[2 * i + 1] += cw[tap * 512 + c0 + 2 * i + 1] * (bfhi(cc[i]) * bfhi(hh[i]));
                }
            }
        }
        const v4u bb = *(const v4u*)pr;
        v4u o;
#pragma unroll
        for (int i = 0; i < 4; ++i) o[i] = pk2(bflo(bb[i]) * conv[2 * i], bfhi(bb[i]) * conv[2 * i + 1]);
        *(v4u*)(y + (size_t)m * 1024 + c0) = o;
    }
}
constexpr int HP = 272;
constexpr int HG_SEG = 0, HG_QD = 2048, HG_QR = 19456, HG_KR = 36864, HG_V = 54272, HG_S = 71680, HG_P = 106496, HG_O = 19456;
constexpr int PP = 144;
constexpr int OP = 528;
__device__ __forceinline__ void hg_cum(const Args& a, LAS unsigned char* lds, int tid, int m0, int h, float (&cum)[16], float (&kk)[16], float& mid, float& last) {
    const int k = tid & 127, seg = tid >> 7, ch = h * 128 + k;
    const float* lbp = a.in[9];
    const float l0 = lbp[ch], l1 = lbp[512 + ch], l2 = lbp[1024 + ch], mx = fmaxf(l0, fmaxf(l1, l2));
    const float e0 = __expf(l0 - mx), e1 = __expf(l1 - mx), e2 = __expf(l2 - mx), lb = e0 / (e0 + e1 + e2);
    const bf16* p = (const bf16*)(a.ws + WS_P) + (size_t)(m0 + seg * 16) * NIN0 + 2048 + ch;
    float run = 0.f;
#pragma unroll
    for (int i = 0; i < 16; ++i) { const float x = bf2f(p[(size_t)i * NIN0]); const float f = lb + (1.0f - lb) * sigmoidf_(x); run += __logf(f); cum[i] = run; kk[i] = 1.0f - f; }
    LAS float* st = (LAS float*)(lds + HG_SEG);
    st[seg * 128 + k] = run;
    __syncthreads();
    const float s0 = st[k], s1 = st[128 + k], s2 = st[256 + k], s3 = st[384 + k];
    const float off = seg == 0 ? 0.f : (seg == 1 ? s0 : (seg == 2 ? s0 + s1 : s0 + s1 + s2));
    mid = s0 + s1; last = (s0 + s1) + (s2 + s3);
#pragma unroll
    for (int i = 0; i < 16; ++i) cum[i] += off;
}
__device__ __forceinline__ void load_tile128(LAS unsigned char* dst, const bf16* src, size_t src_pitch, int rows, int tid) {
    for (int id = tid; id < rows * 16; id += NT) { const int r = id >> 4, c = id & 15; *(LAS v4u*)(dst + r * HP + c * 16) = *(const v4u*)(src + (size_t)r * src_pitch + c * 8); }
}
template <int N16> __device__ __forceinline__ void tile_ld(v4u (&t)[N16], const bf16* src, size_t src_pitch, int tid) {
#pragma unroll
    for (int i = 0; i < N16; ++i) { const int id = tid + NT * i, r = id >> 4, c = id & 15; t[i] = *(const v4u*)(src + (size_t)r * src_pitch + c * 8); }
}
template <int N16> __device__ __forceinline__ void tile_st(const v4u (&t)[N16], LAS unsigned char* dst, int tid) {
#pragma unroll
    for (int i = 0; i < N16; ++i) { const int id = tid + NT * i, r = id >> 4, c = id & 15; *(LAS v4u*)(dst + r * HP + c * 16) = t[i]; }
}
__device__ __forceinline__ void hg_pass_a(const Args& a, LAS unsigned char* lds, int tid, int lane, int wave, int G) {
    const bf16* p = (const bf16*)(a.ws + WS_P);
    bf16* loc = (bf16*)a.out; float* dec = (float*)(a.ws + WS_DEC);
    for (int unit = blockIdx.x; unit < 2048; unit += G) {
        const int b = unit >> 8, h = (unit >> 6) & 3, c = unit & 63, m0 = b * SEQ + c * 64;
        v4u vt[2]; tile_ld<2>(vt, p + (size_t)m0 * NIN0 + 2560 + h * 128, NIN0, tid);
        float cum[16], kk[16], mid, last;
        hg_cum(a, lds, tid, m0, h, cum, kk, mid, last);
        const int k = tid & 127, seg = tid >> 7;
#pragma unroll
        for (int i = 0; i < 16; ++i) *(LAS unsigned short*)(lds + HG_KR + (seg * 16 + i) * HP + k * 2) = f2bf(kk[i] * __expf(last - cum[i]));
        if (seg == 0) dec[unit * 128 + k] = __expf(last);
        tile_st<2>(vt, lds + HG_V, tid);
        __syncthreads();
        f32x4 acc[8];
#pragma unroll
        for (int n = 0; n < 8; ++n) acc[n] = (f32x4){0.f, 0.f, 0.f, 0.f};
#pragma unroll
        for (int ks = 0; ks < 2; ++ks) {
            const bf16x8 B = trfrag(lds + HG_KR, HP, 32 * ks, 16 * wave, lane);
#pragma unroll
            for (int n = 0; n < 8; ++n) { const bf16x8 A = trfrag(lds + HG_V, HP, 32 * ks, 16 * n, lane); acc[n] = MFMA16(A, B, acc[n]); }
        }
        const int fr = lane & 15, fq = lane >> 4;
        bf16* lo = loc + (size_t)unit * 16384 + (16 * wave + fr) * 128 + 4 * fq;
#pragma unroll
        for (int n = 0; n < 8; ++n) { v2u w; w.x = pk2(acc[n][0], acc[n][1]); w.y = pk2(acc[n][2], acc[n][3]); *(v2u*)(lo + 16 * n) = w; }
        __syncthreads();
    }
}
__device__ __forceinline__ void hg_pass_b(const Args& a, int tid, int G) {
    const bf16* loc = (const bf16*)a.out; const float* dec = (const float*)(a.ws + WS_DEC); bf16* st = (bf16*)(a.ws + WS_S);
    for (int idx = blockIdx.x * NT + tid; idx < 32 * 128 * 32; idx += G * NT) {
        const int bh = idx >> 12, k = (idx >> 5) & 127, v4 = idx & 31;
        f32x4 S = (f32x4){0.f, 0.f, 0.f, 0.f};
        const size_t e0 = (size_t)bh * 64 * 16384 + k * 128 + v4 * 4;
#pragma unroll 16
        for (int c = 0; c < 64; ++c) {
            const v2u Lw = *(const v2u*)(loc + e0 + (size_t)c * 16384); const float d = dec[(bh * 64 + c) * 128 + k];
            const f32x4 L = (f32x4){bflo(Lw.x), bfhi(Lw.x), bflo(Lw.y), bfhi(Lw.y)};
            v2u w; w.x = pk2(S.x, S.y); w.y = pk2(S.z, S.w);
            *(v2u*)(st + e0 + (size_t)c * 16384) = w;
            S = S * d + L;
        }
    }
}
__device__ __forceinline__ void hg_pass_c(const Args& a, LAS unsigned char* lds, int tid, int lane, int wave, int G) {
    const bf16* p = (const bf16*)(a.ws + WS_P); const bf16* stg = (const bf16*)(a.ws + WS_S); bf16* y = (bf16*)(a.ws + WS_H);
    const float* gain = a.in[10];
    const int fr = lane & 15, fq = lane >> 4;
    for (int unit = blockIdx.x; unit < 2048; unit += G) {
        const int b = unit >> 8, h = (unit >> 6) & 3, c = unit & 63, m0 = b * SEQ + c * 64;
        v4u vt[2], stt4[4];
        tile_ld<2>(vt, p + (size_t)m0 * NIN0 + 2560 + h * 128, NIN0, tid);
        tile_ld<4>(stt4, stg + (size_t)unit * 16384, 128, tid);
        {
            const int k = tid & 127, seg = tid >> 7;
            const bf16* qp = p + (size_t)(m0 + seg * 16) * NIN0 + 1536 + h * 128 + k;
            unsigned short qraw[16];
#pragma unroll
            for (int i = 0; i < 16; ++i) qraw[i] = qp[(size_t)i * NIN0];
            float cum[16], kk[16], mid, last;
            hg_cum(a, lds, tid, m0, h, cum, kk, mid, last);
#pragma unroll
            for (int i = 0; i < 16; ++i) {
                const float q = bf2f(qraw[i]);
                const int o = (seg * 16 + i) * HP + k * 2;
                *(LAS unsigned short*)(lds + HG_QD + o) = f2bf(q * __expf(cum[i]));
                *(LAS unsigned short*)(lds + HG_QR + o) = f2bf(q * __expf(fminf(cum[i] - mid, 80.f)));
                *(LAS unsigned short*)(lds + HG_KR + o) = f2bf(kk[i] * __expf(fminf(mid - cum[i], 80.f)));
            }
        }
        tile_st<2>(vt, lds + HG_V, tid);
        tile_st<4>(stt4, lds + HG_S, tid);
        __syncthreads();
        {
            const int tt = wave >> 1;
#pragma unroll
            for (int j = 0; j < 2; ++j) {
                const int stl = (wave & 1) * 2 + j;
                f32x4 sc = (f32x4){0.f, 0.f, 0.f, 0.f};
                if (stl <= tt) {
#pragma unroll
                    for (int ks = 0; ks < 4; ++ks) sc = MFMA16(rowfrag(lds + HG_QR, HP, 16 * tt, 32 * ks, fr, fq), rowfrag(lds + HG_KR, HP, 16 * stl, 32 * ks, fr, fq), sc);
                }
#pragma unroll
                for (int r = 0; r < 4; ++r) { const int t = 16 * tt + 4 * fq + r, s = 16 * stl + fr;
                    *(LAS unsigned short*)(lds + HG_P + t * PP + s * 2) = f2bf(s <= t ? sc[r] : 0.f); }
            }
        }
        __syncthreads();
        {
            const int tt = wave >> 1, n0 = (wave & 1) * 4;
            f32x4 acc[4];
#pragma unroll
            for (int n = 0; n < 4; ++n) acc[n] = (f32x4){0.f, 0.f, 0.f, 0.f};
#pragma unroll
            for (int ks = 0; ks < 4; ++ks) { const bf16x8 A = rowfrag(lds + HG_QD, HP, 16 * tt, 32 * ks, fr, fq);
#pragma unroll
                for (int n = 0; n < 4; ++n) acc[n] = MFMA16(A, trfrag(lds + HG_S, HP, 32 * ks, 16 * (n0 + n), lane), acc[n]); }
#pragma unroll
            for (int ks = 0; ks < 2; ++ks) { const bf16x8 A = rowfrag(lds + HG_P, PP, 16 * tt, 32 * ks, fr, fq);
#pragma unroll
                for (int n = 0; n < 4; ++n) acc[n] = MFMA16(A, trfrag(lds + HG_V, HP, 32 * ks, 16 * (n0 + n), lane), acc[n]); }
#pragma unroll
            for (int n = 0; n < 4; ++n)
#pragma unroll
                for (int r = 0; r < 4; ++r) *(LAS float*)(lds + HG_O + (16 * tt + 4 * fq + r) * OP + (16 * (n0 + n) + fr) * 4) = acc[n][r];
        }
        __syncthreads();
        {
            const int t = tid >> 3, part = tid & 7, v0 = part * 16;
            f32x4 o[4]; float ss = 0.f;
#pragma unroll
            for (int j = 0; j < 4; ++j) { o[j] = *(LAS const f32x4*)(lds + HG_O + t * OP + (v0 + 4 * j) * 4); ss += (o[j].x * o[j].x + o[j].y * o[j].y) + (o[j].z * o[j].z + o[j].w * o[j].w); }
            ss += __shfl_xor(ss, 1); ss += __shfl_xor(ss, 2); ss += __shfl_xor(ss, 4);
            const float inv = 1.0f / sqrtf(ss * (1.0f / 128.0f) + EPS);
            const bf16* gp = p + (size_t)(m0 + t) * NIN0 + 3072 + h * 128 + v0;
            const v4u g0 = *(const v4u*)gp, g1 = *(const v4u*)(gp + 8);
            const float* gn = gain + h * 128 + v0;
            v4u w0, w1;
#pragma unroll
            for (int i = 0; i < 4; ++i) {
                const float ga = bflo(g0[i]), gb = bfhi(g0[i]), gc = bflo(g1[i]), gd = bfhi(g1[i]);
                const int e = 2 * i;
                const float oa = o[e >> 2][e & 3], ob = o[(e + 1) >> 2][(e + 1) & 3], oc = o[(8 + e) >> 2][(8 + e) & 3], od = o[(9 + e) >> 2][(9 + e) & 3];
                w0[i] = pk2(oa * inv * gn[e] * siluf_(ga), ob * inv * gn[e + 1] * siluf_(gb));
                w1[i] = pk2(oc * inv * gn[8 + e] * siluf_(gc), od * inv * gn[9 + e] * siluf_(gd));
            }
            bf16* yo = y + (size_t)(m0 + t) * 1024 + 512 + h * 128 + v0;
            *(v4u*)yo = w0; *(v4u*)(yo + 8) = w1;
        }
        __syncthreads();
    }
}

constexpr int SG_STAT = 0, SG_W = 1024, SG_V = 35840, SGVP = 528;
__device__ __forceinline__ void phase_sgu(const Args& a, LAS unsigned char* lds, int tid, int lane, int wave, int G) {
    const bf16* z = (const bf16*)(a.ws + WS_P); bf16* y = (bf16*)(a.ws + WS_H);
    const float* lng = a.in[14]; const float* lnb = a.in[15]; const float* ws = a.in[16]; const float* bs = a.in[17];
    const int fr = lane & 15, fq = lane >> 4;
    for (int unit = blockIdx.x; unit < 256; unit += G) {
        const int m0 = unit * 128;
        LAS float* stt = (LAS float*)(lds + SG_STAT);
        {
            const bf16* vb = z + (size_t)m0 * NIN1 + 1024 + lane * 8;
            v4u a0 = *(const v4u*)(vb + (size_t)wave * NIN1), a1 = *(const v4u*)(vb + (size_t)wave * NIN1 + 512);
            for (int r = wave; r < 128; r += 8) {
                float x[16]; unpack8(a0, x, 0); unpack8(a1, x, 8);
                if (r + 8 < 128) { a0 = *(const v4u*)(vb + (size_t)(r + 8) * NIN1); a1 = *(const v4u*)(vb + (size_t)(r + 8) * NIN1 + 512); }
                float s = 0.f, q = 0.f;
#pragma unroll
                for (int i = 0; i < 16; ++i) { s += x[i]; q += x[i] * x[i]; }
#pragma unroll
                for (int o = 1; o < 64; o <<= 1) { s += __shfl_xor(s, o); q += __shfl_xor(q, o); }
                const float mean = s * (1.0f / 1024.0f);
                const float var = fmaxf(q * (1.0f / 1024.0f) - mean * mean, 0.f);
                if (lane == 0) { stt[2 * r] = mean; stt[2 * r + 1] = 1.0f / sqrtf(var + EPS); }
            }
        }
        __syncthreads();
        for (int g = 0; g < 4; ++g) {
            {
                const int t = tid >> 2, s0 = (tid & 3) * 32;
                const float* wr = ws + (size_t)g * 16384 + t * 128 + s0;
#pragma unroll
                for (int j = 0; j < 4; ++j) {
                    const f32x4 w0 = *(const f32x4*)(wr + 8 * j), w1 = *(const f32x4*)(wr + 8 * j + 4);
                    const int s = s0 + 8 * j;
                    v4u o;
                    o.x = pk2(s + 0 <= t ? w0.x : 0.f, s + 1 <= t ? w0.y : 0.f); o.y = pk2(s + 2 <= t ? w0.z : 0.f, s + 3 <= t ? w0.w : 0.f);
                    o.z = pk2(s + 4 <= t ? w1.x : 0.f, s + 5 <= t ? w1.y : 0.f); o.w = pk2(s + 6 <= t ? w1.z : 0.f, s + 7 <= t ? w1.w : 0.f);
                    *(LAS v4u*)(lds + SG_W + t * HP + s * 2) = o;
                }
            }
#pragma unroll 2
            for (int i = 0; i < 8; ++i) {
                const int id = tid + NT * i, s = id >> 5, dc = (id & 31) * 8, col = g * 256 + dc;
                const v4u vv = *(const v4u*)(z + (size_t)(m0 + s) * NIN1 + 1024 + col);
                const float mean = stt[2 * s], rstd = stt[2 * s + 1];
                const f32x4 g0 = *(const f32x4*)(lng + col), g1 = *(const f32x4*)(lng + col + 4), b0 = *(const f32x4*)(lnb + col), b1 = *(const f32x4*)(lnb + col + 4);
                v4u o;
                o.x = pk2((bflo(vv.x) - mean) * rstd * g0.x + b0.x, (bfhi(vv.x) - mean) * rstd * g0.y + b0.y);
                o.y = pk2((bflo(vv.y) - mean) * rstd * g0.z + b0.z, (bfhi(vv.y) - mean) * rstd * g0.w + b0.w);
                o.z = pk2((bflo(vv.z) - mean) * rstd * g1.x + b1.x, (bfhi(vv.z) - mean) * rstd * g1.y + b1.y);
                o.w = pk2((bflo(vv.w) - mean) * rstd * g1.z + b1.z, (bfhi(vv.w) - mean) * rstd * g1.w + b1.w);
                *(LAS v4u*)(lds + SG_V + s * SGVP + dc * 2) = o;
            }
            __syncthreads();
            f32x4 acc[16];
#pragma unroll
            for (int n = 0; n < 16; ++n) acc[n] = (f32x4){0.f, 0.f, 0.f, 0.f};
            for (int ks = 0; ks < 4; ++ks) {
                if (32 * ks > 16 * wave + 15) break;
                const bf16x8 A = rowfrag(lds + SG_W, HP, 16 * wave, 32 * ks, fr, fq);
#pragma unroll
                for (int n = 0; n < 16; ++n) acc[n] = MFMA16(A, trfrag(lds + SG_V, SGVP, 32 * ks, 16 * n, lane), acc[n]);
            }
            __syncthreads();
#pragma unroll
            for (int r = 0; r < 4; ++r) {
                const int t = 16 * wave + 4 * fq + r; const float bsv = bs[g * 128 + t];
#pragma unroll
                for (int n = 0; n < 16; ++n) *(LAS unsigned short*)(lds + SG_V + t * SGVP + (16 * n + fr) * 2) = f2bf(acc[n][r] + bsv);
            }
            __syncthreads();
#pragma unroll 4
            for (int i = 0; i < 8; ++i) {
                const int id = tid + NT * i, t = id >> 5, dc = (id & 31) * 8;
                const v4u mx = *(LAS const v4u*)(lds + SG_V + t * SGVP + dc * 2);
                const v4u uu = *(const v4u*)(z + (size_t)(m0 + t) * NIN1 + g * 256 + dc);
                v4u o;
#pragma unroll
                for (int j = 0; j < 4; ++j) o[j] = pk2(bflo(mx[j]) * bflo(uu[j]), bfhi(mx[j]) * bfhi(uu[j]));
                *(v4u*)(y + (size_t)(m0 + t) * 1024 + g * 256 + dc) = o;
            }
            __syncthreads();
        }
    }
}

#ifndef MK_N_LAUNCHES
#define MK_N_LAUNCHES 1
#endif

__global__ void __launch_bounds__(512, 2) fwd(Args a) {
    extern __shared__ __attribute__((aligned(16))) unsigned char lds_raw[];
    LAS unsigned char* lds = (LAS unsigned char*)lds_raw;
    cg::grid_group grid = cg::this_grid();
    volatile LAS unsigned* MISC = (volatile LAS unsigned*)(lds + MISC_OFF);
    if (threadIdx.x < 16) MISC[threadIdx.x] = 0u;
    __syncthreads();
    const XcdBarrier xbar = xcd_barrier_post((unsigned*)(a.ws + WS_BAR), MISC + 8);
    const int lo = a.ph_lo, hi = a.ph_hi;
#define IN(k) (lo <= (k) && (k) < hi)
#ifndef DBL_MASK
#define DBL_MASK 0
#endif
#define REP(k) _Pragma("unroll 1") for (int rep_ = 0; rep_ <= ((DBL_MASK >> (k)) & 1); ++rep_)
#define SEAM(k) do { if (IN(k) && IN((k) + 1)) { xcd_barrier(xbar); } } while (0)
#define PHASE_VARS int tid = threadIdx.x; asm volatile("" : "+v"(tid)); int G = gridDim.x; asm volatile("" : "+s"(G)); \
    const int lane = tid & 63, wave = __builtin_amdgcn_readfirstlane(tid >> 6); (void)lane; (void)wave; \
    bf16* const H = (bf16*)(a.ws + WS_H); bf16* const P = (bf16*)(a.ws + WS_P); const float* const modf = (const float*)(a.ws + WS_MODF); (void)H; (void)P; (void)modf;
#define GEMM_RES(ph, l, ffn) if (IN(ph)) REP(ph) { PHASE_VARS \
        const bf16* Bt = (ffn) ? (const bf16*)(a.ws + WS_WFF2) + (size_t)(l) * 1024 * 4096 : (const bf16*)(a.ws + ((l) ? WS_WOUT1 : WS_WOUT0)); \
        pg8::Gemm g{(ffn) ? P : H, Bt, M, 1024, (ffn) ? 4096 : 1024}; pg8::StaticOrder S; S.init(M, 1024, G, (int)blockIdx.x); \
        if ((ph) == 6) { pg8::EpiResGateBf<true> E{a.in[0], (bf16*)(a.ws + WS_XR), modf + (size_t)(l) * 8 * 6144 + ((ffn) ? 5 : 2) * 1024}; \
            pg8::gemm_phase<pg8::EpiResGateBf<true>, pg8::StaticOrder, false, true>(lds, g, S, E); } \
        else { pg8::EpiResGateBf<false> E{a.ws + WS_XR, (bf16*)(a.ws + WS_XR), modf + (size_t)(l) * 8 * 6144 + ((ffn) ? 5 : 2) * 1024}; \
            pg8::gemm_phase<pg8::EpiResGateBf<false>, pg8::StaticOrder, false, true>(lds, g, S, E); } } SEAM(ph);
#define GEMM_FF1(ph, l) if (IN(ph)) REP(ph) { PHASE_VARS \
        pg8::Gemm g{H, (const bf16*)(a.ws + WS_WFF1) + (size_t)(l) * 4096 * 1024, M, FF, 1024}; pg8::StaticOrder S; S.init(M, FF, G, (int)blockIdx.x); \
        pg8::EpiBf16<2> E{P, FF, nullptr}; \
        pg8::gemm_phase<pg8::EpiBf16<2>, pg8::StaticOrder, true, true>(lds, g, S, E); } SEAM(ph);
#define NORM(ph, l, ffn) if (IN(ph)) REP(ph) { PHASE_VARS \
        phase_norm_bf(a, ((ffn) ? a.in[5] : a.in[4]) + (l) * 1024, (l), (ffn) ? 3 : 0, (ffn) ? 4 : 1, tid, lane, wave, G); } SEAM(ph);

    if (a.ph_hi > NPH) grid.sync();
    if (IN(0)) REP(0) { PHASE_VARS phase_prologue(a, lds, tid, lane, wave, G); } SEAM(0);
    if (IN(1)) REP(1) { PHASE_VARS phase_norm<true>(a, lds, a.in[0], a.in[4], 0, 0, 1, tid, lane, wave, G); } SEAM(1);
    if (IN(2)) REP(2) { PHASE_VARS
        pg8::Gemm g{H, (const bf16*)(a.ws + WS_WIN0), M, NIN0, 1024}; pg8::StaticOrder S; S.init(M, NIN0, G, (int)blockIdx.x);
        pg8::EpiBf16<0> E{P, NIN0, nullptr};
        pg8::gemm_phase<pg8::EpiBf16<0>, pg8::StaticOrder, true, true>(lds, g, S, E); } SEAM(2);
    if (IN(3)) REP(3) { PHASE_VARS conv_mixer(a, tid, G); hg_pass_a(a, lds, tid, lane, wave, G); } SEAM(3);
    if (IN(4)) REP(4) { PHASE_VARS hg_pass_b(a, tid, G); } SEAM(4);
    if (IN(5)) REP(5) { PHASE_VARS hg_pass_c(a, lds, tid, lane, wave, G); } SEAM(5);
    GEMM_RES(6, 0, false)
    NORM(7, 0, true)
    GEMM_FF1(8, 0)
    GEMM_RES(9, 0, true)
    NORM(10, 1, false)
    if (IN(11)) REP(11) { PHASE_VARS
        pg8::Gemm g{H, (const bf16*)(a.ws + WS_WIN1), M, NIN1, 1024}; pg8::StaticOrder S; S.init(M, NIN1, G, (int)blockIdx.x);
        pg8::EpiBf16<1> E{P, NIN1, a.in[13]};
        pg8::gemm_phase<pg8::EpiBf16<1>, pg8::StaticOrder, true, true>(lds, g, S, E); } SEAM(11);
    if (IN(12)) REP(12) { PHASE_VARS phase_sgu(a, lds, tid, lane, wave, G); } SEAM(12);
    GEMM_RES(13, 1, false)
    NORM(14, 1, true)
    GEMM_FF1(15, 1)
    GEMM_RES(16, 1, true)
    if (IN(17)) REP(17) { PHASE_VARS phase_final_norm(a, lane, wave, G); }
}
}

extern "C" void kernel_launch(void* const* d_in, const int* in_sizes, int n_in, void* d_out, int out_size, void* d_ws, size_t ws_size, hipStream_t stream) {
    using namespace mk;
    static int grid = 0;
    if (grid == 0) {
        if (n_in != 22 || out_size != M * D || ws_size < WS_END) { fprintf(stderr, "kernel_launch: unexpected shapes (n_in %d out %d ws %zu)\n", n_in, out_size, ws_size); grid = -1; return; }
        int dev = 0, cus = 0, per_cu = 0;
        (void)hipGetDevice(&dev); (void)hipDeviceGetAttribute(&cus, hipDeviceAttributeMultiprocessorCount, dev);
        if (hipFuncSetAttribute((const void*)fwd, hipFuncAttributeMaxDynamicSharedMemorySize, LDS_BYTES) != hipSuccess) fprintf(stderr, "kernel_launch: hipFuncSetAttribute failed\n");
        if (hipOccupancyMaxActiveBlocksPerMultiprocessor(&per_cu, (const void*)fwd, NT, LDS_BYTES) != hipSuccess || per_cu < 1) { fprintf(stderr, "kernel_launch: occupancy query says %d\n", per_cu); per_cu = 1; }
        (void)hipGetLastError();
        grid = cus * per_cu;
        if (grid <= 0) grid = 256;
    }
    if (grid < 0) return;
    if (hipMemsetAsync((char*)d_ws + WS_BAR, 0, BAR_ZERO_BYTES, stream) != hipSuccess) fprintf(stderr, "kernel_launch: memset of barrier words failed\n");
    Args a{};
    for (int i = 0; i < 22; ++i) a.in[i] = (const float*)d_in[i];
    a.out = (float*)d_out; a.ws = (unsigned char*)d_ws;
#if MK_N_LAUNCHES == 1
    a.ph_lo = 0; a.ph_hi = NPH;
    void* args[] = {&a};
    hipError_t e = hipLaunchCooperativeKernel((const void*)fwd, dim3(grid), dim3(NT), args, LDS_BYTES, stream);
    if (e != hipSuccess) fprintf(stderr, "cooperative launch failed: %s (grid %d)\n", hipGetErrorString(e), grid);
#else
    for (int ph = 0; ph < NPH; ++ph) {
        a.ph_lo = ph; a.ph_hi = ph + 1;
        hipLaunchKernelGGL(fwd, dim3(grid), dim3(NT), LDS_BYTES, stream, a);
    }
#endif
}
```

```cpp
#include <hip/hip_runtime.h>
#include <hip/hip_cooperative_groups.h>
#include <cstdio>
#include <cstdint>
namespace cg = cooperative_groups;
namespace pg8 {
#define PG8_LAS __attribute__((address_space(3)))
typedef unsigned short bf16_t;
typedef short bf16x8 __attribute__((ext_vector_type(8)));
typedef float f32x4 __attribute__((ext_vector_type(4)));
typedef unsigned u32x4 __attribute__((ext_vector_type(4)));
constexpr int BM = 256, BK = 64, HALF = 128, HTB = HALF * BK * 2  , STAGE_BYTES = 8 * HTB, NXCD = 8, WGM = 8;

__host__ __device__ __forceinline__ int lds_byte(int r, int c) { const int st = (r >> 4) * 2 + (c >> 5), rr = r & 15, cc = c & 31, ob = rr * 64 + cc * 2; return st * 1024 + (ob ^ (((ob >> 9) & 1) << 5)); }
__host__ __device__ __forceinline__ void stage_rc(int b, int& R, int& C) { const int st = b / 1024, sb = b % 1024, swz = sb ^ (((sb >> 9) & 1) << 5); R = (st >> 1) * 16 + swz / 64; C = (st & 1) * 32 + (swz % 64) / 2; }
__host__ __device__ __forceinline__ int perm32(int rho) { const int n = rho >> 4, i = rho & 15; return 8 * (i >> 2) + 4 * n + (i & 3); }

struct Unit { int pm, pn; };
struct Gemm { const bf16_t* A; const bf16_t* Bt; int M, N, K; };

struct StaticOrder {
    int nM, nN, nwg, G, c;
    __host__ __device__ void init(int M, int N, int G_, int c_) { nM = M / BM; nN = N / BM; nwg = nM * nN; G = G_; c = c_; }
    __host__ __device__ bool next(int i, Unit& u) const {
        const long L = (long)i * G + c; if (L >= nwg) return false;
        int wgid = (int)L; { const int q = nwg / NXCD, r = nwg % NXCD, xcd = wgid % NXCD, off = wgid / NXCD; wgid = (xcd < r ? xcd * (q + 1) : r * (q + 1) + (xcd - r) * q) + off; }
        const int nig = WGM * nN, gid = wgid / nig, fm = gid * WGM, gsz = (nM - fm) < WGM ? (nM - fm) : WGM;
        u.pm = fm + ((wgid % nig) % gsz); u.pn = (wgid % nig) / gsz; return true;
    }
    __device__ __forceinline__ void a_ready(const Unit&) const {}
    __device__ __forceinline__ void done(const Unit&) const {}
};

typedef float f32x2c_t __attribute__((ext_vector_type(2)));
typedef __bf16 bf16x2c_t __attribute__((ext_vector_type(2)));
__device__ __forceinline__ unsigned cvt_pk_bf16(float lo, float hi) { const f32x2c_t v = {lo, hi}; const bf16x2c_t b = __builtin_convertvector(v, bf16x2c_t); return __builtin_bit_cast(unsigned, b); }
typedef float f32x2 __attribute__((ext_vector_type(2)));
__device__ __forceinline__ float gelu_tanh(float x) {
    const float u = 0.7978845608f * (x + 0.044715f * x * x * x);
    const float e = __builtin_amdgcn_exp2f(-2.0f * 1.4426950408889634f * u);
    return x * __builtin_amdgcn_rcpf(1.0f + e);
}
template <int ACT> struct EpiBf16 {
    static constexpr bool PERM = true, AFTER_DRAIN = false;
    bf16_t* O; int ldc; const float* bias;
    __device__ __forceinline__ void operator()(const f32x4 (&acc)[2][2][4][2], const Unit& u, int wr, int wc, int fr, int fq) const {
        const int row0 = u.pm * BM + wr * 64 + fr; const int col0 = u.pn * BM + wc * 32 + 8 * fq;
        f32x4 bv[2][2];
#pragma unroll
        for (int bj = 0; bj < 2; ++bj)
#pragma unroll
            for (int n = 0; n < 2; ++n) bv[bj][n] = bias ? *(const f32x4*)(bias + col0 + bj * HALF + 4 * n) : (f32x4){0.f, 0.f, 0.f, 0.f};
#pragma unroll
        for (int ai = 0; ai < 2; ++ai)
#pragma unroll
            for (int m = 0; m < 4; ++m) { bf16_t* rowp = O + (size_t)(row0 + ai * HALF + m * 16) * ldc + col0;
#pragma unroll
                for (int bj = 0; bj < 2; ++bj) { f32x4 v0 = acc[ai][bj][m][0] + bv[bj][0], v1 = acc[ai][bj][m][1] + bv[bj][1];
                    if (ACT == 1) {
#pragma unroll
                        for (int i = 0; i < 4; ++i) { v0[i] = gelu_tanh(v0[i]); v1[i] = gelu_tanh(v1[i]); } }
                    if (ACT == 2) {
#pragma unroll
                        for (int i = 0; i < 4; ++i) { const float a = fmaxf(v0[i], 0.f), b = fmaxf(v1[i], 0.f); v0[i] = a * a; v1[i] = b * b; } }
                    u32x4 w; w.x = cvt_pk_bf16(v0[0], v0[1]); w.y = cvt_pk_bf16(v0[2], v0[3]); w.z = cvt_pk_bf16(v1[0], v1[1]); w.w = cvt_pk_bf16(v1[2], v1[3]);
                    *(u32x4*)(rowp + bj * HALF) = w; } }
    }
};
struct EpiResGate {
    static constexpr bool PERM = false, AFTER_DRAIN = false;
    const float* base; float* out; const float* gate;
    __device__ __forceinline__ void operator()(const f32x4 (&acc)[2][2][4][2], const Unit& u, int wr, int wc, int fr, int fq) const {
        const int row0 = u.pm * BM + wr * 64 + fr; const int col0 = u.pn * BM + wc * 32 + 4 * fq; const int b = u.pm >> 4;
        f32x4 gv[2][2];
#pragma unroll
        for (int bj = 0; bj < 2; ++bj)
#pragma unroll
            for (int n = 0; n < 2; ++n) gv[bj][n] = *(const f32x4*)(gate + (size_t)b * 6144 + col0 + bj * HALF + n * 16);
#pragma unroll
        for (int ai = 0; ai < 2; ++ai) {
            f32x4 bs[4][2][2];
#pragma unroll
            for (int m = 0; m < 4; ++m) { const size_t off = (size_t)(row0 + ai * HALF + m * 16) * 1024 + col0;
#pragma unroll
                for (int bj = 0; bj < 2; ++bj)
#pragma unroll
                    for (int n = 0; n < 2; ++n) bs[m][bj][n] = *(const f32x4*)(base + off + bj * HALF + n * 16); }
#pragma unroll
            for (int m = 0; m < 4; ++m) { const size_t off = (size_t)(row0 + ai * HALF + m * 16) * 1024 + col0;
#pragma unroll
                for (int bj = 0; bj < 2; ++bj)
#pragma unroll
                    for (int n = 0; n < 2; ++n) *(f32x4*)(out + off + bj * HALF + n * 16) = bs[m][bj][n] + gv[bj][n] * acc[ai][bj][m][n]; }
            asm volatile("" ::: "memory"); }
    }
};
template <bool BASE_F32> struct EpiResGateBf {
    static constexpr bool PERM = true, AFTER_DRAIN = false;
    const void* base; bf16_t* out; const float* gate;
    __device__ __forceinline__ void operator()(const f32x4 (&acc)[2][2][4][2], const Unit& u, int wr, int wc, int fr, int fq) const {
        const int row0 = u.pm * BM + wr * 64 + fr; const int col0 = u.pn * BM + wc * 32 + 8 * fq; const int b = u.pm >> 4;
        f32x4 gv[2][2];
#pragma unroll
        for (int bj = 0; bj < 2; ++bj)
#pragma unroll
            for (int n = 0; n < 2; ++n) gv[bj][n] = *(const f32x4*)(gate + (size_t)b * 6144 + col0 + bj * HALF + 4 * n);
#pragma unroll
        for (int ai = 0; ai < 2; ++ai) {
            f32x4 bs[4][2][2];
#pragma unroll
            for (int m = 0; m < 4; ++m) { const size_t off = (size_t)(row0 + ai * HALF + m * 16) * 1024 + col0;
#pragma unroll
                for (int bj = 0; bj < 2; ++bj) {
                    if (BASE_F32) { bs[m][bj][0] = *(const f32x4*)((const float*)base + off + bj * HALF); bs[m][bj][1] = *(const f32x4*)((const float*)base + off + bj * HALF + 4); }
                    else { const u32x4 w = *(const u32x4*)((const bf16_t*)base + off + bj * HALF);
                        bs[m][bj][0] = (f32x4){__builtin_bit_cast(float, w.x << 16), __builtin_bit_cast(float, w.x & 0xffff0000u), __builtin_bit_cast(float, w.y << 16), __builtin_bit_cast(float, w.y & 0xffff0000u)};
                        bs[m][bj][1] = (f32x4){__builtin_bit_cast(float, w.z << 16), __builtin_bit_cast(float, w.z & 0xffff0000u), __builtin_bit_cast(float, w.w << 16), __builtin_bit_cast(float, w.w & 0xffff0000u)}; } } }
#pragma unroll
            for (int m = 0; m < 4; ++m) { const size_t off = (size_t)(row0 + ai * HALF + m * 16) * 1024 + col0;
#pragma unroll
                for (int bj = 0; bj < 2; ++bj) { const f32x4 v0 = bs[m][bj][0] + gv[bj][0] * acc[ai][bj][m][0], v1 = bs[m][bj][1] + gv[bj][1] * acc[ai][bj][m][1];
                    u32x4 w; w.x = cvt_pk_bf16(v0[0], v0[1]); w.y = cvt_pk_bf16(v0[2], v0[3]); w.z = cvt_pk_bf16(v1[0], v1[1]); w.w = cvt_pk_bf16(v1[2], v1[3]);
                    *(u32x4*)(out + off + bj * HALF) = w; } }
            asm volatile("" ::: "memory"); }
    }
};
template <class Epi, class Sched, bool ALIGN_EPI = false, bool SP2 = false>
__device__ __forceinline__ void gemm_phase(PG8_LAS unsigned char* lds, const Gemm g, const Sched& S, const Epi& E) {
    const int tid = threadIdx.x, wid = __builtin_amdgcn_readfirstlane(tid >> 6), lane = tid & 63, wr = wid >> 2, wc = wid & 3, fr = lane & 15, fq = lane >> 4;
    const int K = g.K, nt = K / BK;
    unsigned voffA[2], voffB[2];
#pragma unroll
    for (int i = 0; i < 2; ++i) { int R, C; stage_rc(tid * 16 + i * 8192, R, C); const int Rb = Epi::PERM ? ((R & ~31) + perm32(R & 31)) : R;
        voffA[i] = (unsigned)(R * K + C) * 2u; voffB[i] = (unsigned)(Rb * K + C) * 2u; }
    const size_t kstep = (size_t)(BK * 2);
    const size_t hstep = (size_t)HALF * K * 2;
    const size_t tstep = 2 * hstep;
    const unsigned ldsw = (unsigned)wid * 1024u;
    const int aoff = lds_byte(wr * 64 + fr, fq * 8), boff = lds_byte(wc * 32 + fr, fq * 8);
#define PG8_SA(b, h) (((b) * 2 + (h)) * HTB)
#define PG8_SB(b, h) ((4 + (b) * 2 + (h)) * HTB)
#define PG8_STAGE(bufoff, gbase, voff) do { _Pragma("unroll") for (int _i = 0; _i < 2; ++_i) \
        __builtin_amdgcn_global_load_lds((const unsigned*)((const char*)(gbase) + (voff)[_i]), (PG8_LAS unsigned*)(lds + (bufoff) + ldsw + _i * 8192), 16, 0, 0); } while (0)
#define PG8_LDA(dst, b, h) do { _Pragma("unroll") for (int m = 0; m < 4; ++m) _Pragma("unroll") for (int k = 0; k < 2; ++k) dst[m][k] = *(const PG8_LAS bf16x8*)(lds + PG8_SA(b, h) + aoff + m * 2048 + k * 1024); } while (0)
#define PG8_LDB(dst, b, h) do { _Pragma("unroll") for (int n = 0; n < 2; ++n) _Pragma("unroll") for (int k = 0; k < 2; ++k) dst[n][k] = *(const PG8_LAS bf16x8*)(lds + PG8_SB(b, h) + boff + n * 2048 + k * 1024); } while (0)
#define PG8_MMA(ai, bj, At, Bt) do { __builtin_amdgcn_s_setprio(1); _Pragma("unroll") for (int m = 0; m < 4; ++m) _Pragma("unroll") for (int n = 0; n < 2; ++n) _Pragma("unroll") for (int k = 0; k < 2; ++k) \
        acc[ai][bj][m][n] = __builtin_amdgcn_mfma_f32_16x16x32_bf16(Bt[n][k], At[m][k], acc[ai][bj][m][n], 0, 0, 0); __builtin_amdgcn_s_setprio(0); } while (0)
#define PG8_WAIT_V(n) asm volatile("s_waitcnt vmcnt(" #n ")" ::: "memory")
#define PG8_WAIT_L(n) asm volatile("s_waitcnt lgkmcnt(" #n ")" ::: "memory")
#define PG8_BAR __builtin_amdgcn_s_barrier()
#define PG8_SCHED __builtin_amdgcn_sched_barrier(0)
    Unit cur, nxt; int ui = 0;
    if (!S.next(0, cur)) return;
    f32x4 acc[2][2][4][2];
#pragma unroll
    for (int a = 0; a < 2; ++a)
#pragma unroll
        for (int b = 0; b < 2; ++b)
#pragma unroll
            for (int m = 0; m < 4; ++m)
#pragma unroll
                for (int n = 0; n < 2; ++n) acc[a][b][m][n] = (f32x4){0.f, 0.f, 0.f, 0.f};
    bf16x8 At[4][2], B0[2][2], B1[2][2];
    const char* cA = (const char*)g.A + (size_t)cur.pm * tstep; const char* cB = (const char*)g.Bt + (size_t)cur.pn * tstep;
    S.a_ready(cur);
    if constexpr (SP2) {
        PG8_STAGE(PG8_SB(0, 0), cB, voffB); PG8_STAGE(PG8_SB(0, 1), cB + hstep, voffB); PG8_STAGE(PG8_SA(0, 0), cA, voffA); PG8_STAGE(PG8_SA(0, 1), cA + hstep, voffA);
        if (wr == 1) PG8_BAR;
        PG8_WAIT_V(2); PG8_BAR;
        PG8_STAGE(PG8_SB(1, 0), cB + kstep, voffB); PG8_STAGE(PG8_SA(1, 0), cA + kstep, voffA); PG8_STAGE(PG8_SB(1, 1), cB + hstep + kstep, voffB);
        PG8_WAIT_V(6); PG8_BAR;
    } else {
        PG8_STAGE(PG8_SB(0, 0), cB, voffB); PG8_STAGE(PG8_SA(0, 0), cA, voffA); PG8_STAGE(PG8_SB(0, 1), cB + hstep, voffB); PG8_STAGE(PG8_SA(0, 1), cA + hstep, voffA);
        if (wr == 1) PG8_BAR;
        PG8_WAIT_V(4); PG8_BAR;
        PG8_STAGE(PG8_SB(1, 0), cB + kstep, voffB); PG8_STAGE(PG8_SA(1, 0), cA + kstep, voffA); PG8_STAGE(PG8_SB(1, 1), cB + hstep + kstep, voffB);
        PG8_WAIT_V(6); PG8_BAR;
    }
    for (;;) {
        const bool has_next = S.next(ui + 1, nxt);
        const char* nA = has_next ? (const char*)g.A + (size_t)nxt.pm * tstep : cA; const char* nB = has_next ? (const char*)g.Bt + (size_t)nxt.pn * tstep : cB;
        for (int t = 0; t < nt; t += 2) {
            const bool last = (t == nt - 2);
            const char* a1 = cA + (size_t)(t + 1) * kstep;
            const char* a2 = last ? nA : cA + (size_t)(t + 2) * kstep; const char* b2 = last ? nB : cB + (size_t)(t + 2) * kstep;
            const char* a3 = a2 + kstep; const char* b3 = b2 + kstep;
            if (last && has_next) S.a_ready(nxt);
            if constexpr (SP2) {
            PG8_LDB(B0, 0, 0); PG8_LDB(B1, 0, 1); PG8_SCHED; PG8_LDA(At, 0, 0); PG8_STAGE(PG8_SA(1, 1), a1 + hstep, voffA);
            PG8_WAIT_V(8); PG8_WAIT_L(0); PG8_BAR; PG8_MMA(0, 0, At, B0); PG8_MMA(0, 1, At, B1); PG8_BAR; PG8_SCHED;
            PG8_LDA(At, 0, 1); PG8_STAGE(PG8_SB(0, 0), b2, voffB); PG8_STAGE(PG8_SB(0, 1), b2 + hstep, voffB); PG8_STAGE(PG8_SA(0, 0), a2, voffA);
            PG8_WAIT_V(8); PG8_WAIT_L(0); PG8_BAR; PG8_MMA(1, 0, At, B0); PG8_MMA(1, 1, At, B1); PG8_BAR; PG8_SCHED;
            PG8_LDB(B0, 1, 0); PG8_LDB(B1, 1, 1); PG8_SCHED; PG8_LDA(At, 1, 0); PG8_STAGE(PG8_SA(0, 1), a2 + hstep, voffA);
            PG8_WAIT_V(8); PG8_WAIT_L(0); PG8_BAR; PG8_MMA(0, 0, At, B0); PG8_MMA(0, 1, At, B1); PG8_BAR; PG8_SCHED;
            PG8_LDA(At, 1, 1); PG8_STAGE(PG8_SB(1, 0), b3, voffB); PG8_STAGE(PG8_SB(1, 1), b3 + hstep, voffB); PG8_STAGE(PG8_SA(1, 0), a3, voffA);
            PG8_WAIT_V(8); PG8_WAIT_L(0); PG8_BAR; PG8_MMA(1, 0, At, B0); PG8_MMA(1, 1, At, B1); PG8_BAR; PG8_SCHED;
            } else {
            PG8_LDB(B0, 0, 0); PG8_SCHED; PG8_LDA(At, 0, 0); PG8_STAGE(PG8_SA(1, 1), a1 + hstep, voffA);
            PG8_WAIT_L(8); PG8_BAR; PG8_WAIT_L(0); PG8_MMA(0, 0, At, B0); PG8_BAR; PG8_SCHED;
            PG8_LDB(B1, 0, 1); PG8_STAGE(PG8_SB(0, 0), b2, voffB);
            PG8_BAR; PG8_WAIT_L(0); PG8_MMA(0, 1, At, B1); PG8_BAR;
            PG8_LDA(At, 0, 1); PG8_STAGE(PG8_SA(0, 0), a2, voffA);
            PG8_BAR; PG8_WAIT_L(0); PG8_MMA(1, 0, At, B0); PG8_BAR; PG8_SCHED;
            PG8_STAGE(PG8_SB(0, 1), b2 + hstep, voffB);
            PG8_WAIT_V(6); PG8_BAR; PG8_MMA(1, 1, At, B1); PG8_BAR;
            PG8_LDB(B0, 1, 0); PG8_SCHED; PG8_LDA(At, 1, 0); PG8_STAGE(PG8_SA(0, 1), a2 + hstep, voffA);
            PG8_WAIT_L(8); PG8_BAR; PG8_WAIT_L(0); PG8_MMA(0, 0, At, B0); PG8_BAR; PG8_SCHED;
            PG8_LDB(B1, 1, 1); PG8_STAGE(PG8_SB(1, 0), b3, voffB);
            PG8_BAR; PG8_WAIT_L(0); PG8_MMA(0, 1, At, B1); PG8_BAR;
            PG8_LDA(At, 1, 1); PG8_STAGE(PG8_SA(1, 0), a3, voffA);
            PG8_BAR; PG8_WAIT_L(0); PG8_MMA(1, 0, At, B0); PG8_BAR; PG8_SCHED;
            PG8_STAGE(PG8_SB(1, 1), b3 + hstep, voffB);
            PG8_WAIT_V(6); PG8_BAR; PG8_MMA(1, 1, At, B1); PG8_BAR;
            }
        }
        if constexpr (ALIGN_EPI) { if (wr == 0) PG8_BAR; }
        if constexpr (!Epi::AFTER_DRAIN) { E(acc, cur, wr, wc, fr, fq); S.done(cur); }
        if (!has_next) break;
#pragma unroll
        for (int a = 0; a < 2; ++a)
#pragma unroll
            for (int b = 0; b < 2; ++b)
#pragma unroll
                for (int m = 0; m < 4; ++m)
#pragma unroll
                    for (int n = 0; n < 2; ++n) acc[a][b][m][n] = (f32x4){0.f, 0.f, 0.f, 0.f};
        cur = nxt; cA = nA; cB = nB; ++ui;
        if constexpr (ALIGN_EPI) { if (wr == 1) PG8_BAR; }
    }
    PG8_WAIT_V(0);
    if constexpr (!ALIGN_EPI) { if (wr == 0) PG8_BAR; }
    PG8_BAR;
    if constexpr (Epi::AFTER_DRAIN) { E.fused(acc, cur, wr, wc, fr, fq, lds, wid, lane); S.done(cur); }
#undef PG8_SA
#undef PG8_SB
#undef PG8_STAGE
#undef PG8_LDA
#undef PG8_LDB
#undef PG8_MMA
#undef PG8_WAIT_V
#undef PG8_WAIT_L
#undef PG8_BAR
#undef PG8_SCHED
}
}
namespace mk {
#define LAS __attribute__((address_space(3)))
typedef unsigned short bf16;
typedef short bf16x8 __attribute__((ext_vector_type(8)));
typedef short s16x4 __attribute__((ext_vector_type(4)));
typedef float f32x4 __attribute__((ext_vector_type(4)));
typedef unsigned v4u __attribute__((ext_vector_type(4)));
typedef unsigned v2u __attribute__((ext_vector_type(2)));

constexpr int BATCH = 8, SEQ = 4096, D = 1024, M = BATCH * SEQ, FF = 4096, NIN0 = 3584, NIN1 = 2048;
constexpr int NT = 512;
constexpr float EPS = 1e-6f;
constexpr size_t MiB = 1u << 20;
constexpr size_t WS_MODP = 440 * MiB;
constexpr int NCH = 16;
constexpr size_t WS_MODF = 3 * MiB;
constexpr size_t WS_DEC = 4 * MiB;
constexpr size_t WS_BAR = 5 * MiB, BAR_ZERO_BYTES = 16384;
constexpr int MISC_OFF = 131072;
constexpr size_t WS_WIN0 = 8 * MiB, WS_WOUT0 = 15 * MiB, WS_WIN1 = 17 * MiB, WS_WOUT1 = 21 * MiB, WS_WFF1 = 23 * MiB, WS_WFF2 = 39 * MiB;
constexpr size_t WS_H = 56 * MiB;
constexpr size_t WS_P = 120 * MiB;
constexpr size_t WS_S = 376 * MiB;
constexpr size_t WS_XR = 376 * MiB;
constexpr size_t WS_END = 448 * MiB;
constexpr int LDS_BYTES = 147456;
constexpr int NPH = 18;

struct Args { const float* in[22]; float* out; unsigned char* ws; int ph_lo, ph_hi; };

__device__ __forceinline__ float bf2f(unsigned u) { return __builtin_bit_cast(float, u << 16); }
__device__ __forceinline__ float bflo(unsigned w) { return __builtin_bit_cast(float, w << 16); }
__device__ __forceinline__ float bfhi(unsigned w) { return __builtin_bit_cast(float, w & 0xffff0000u); }
typedef float f32x2_t __attribute__((ext_vector_type(2)));
typedef __bf16 bf16x2_t __attribute__((ext_vector_type(2)));
__device__ __forceinline__ unsigned pk2(float lo, float hi) { const f32x2_t v = {lo, hi}; const bf16x2_t b = __builtin_convertvector(v, bf16x2_t); return __builtin_bit_cast(unsigned, b); }
__device__ __forceinline__ unsigned short f2bf(float f) { return __builtin_bit_cast(unsigned short, (__bf16)f); }
__device__ __forceinline__ float wave_sum(float v) {
#pragma unroll
    for (int o = 1; o < 64; o <<= 1) v += __shfl_xor(v, o);
    return v;
}
__device__ __forceinline__ float sigmoidf_(float x) { return __builtin_amdgcn_rcpf(1.0f + __expf(-x)); }
__device__ __forceinline__ float siluf_(float x) { return x * sigmoidf_(x); }

__device__ __forceinline__ bf16x8 rowfrag(LAS const unsigned char* T, int pitchB, int r0, int k0, int fr, int fq) {
    return *(LAS const bf16x8*)(T + (r0 + fr) * pitchB + (k0 + 8 * fq) * 2);
}
typedef short v4i16_t __attribute__((ext_vector_type(4)));
__device__ __forceinline__ bf16x8 trfrag(LAS const unsigned char* T, int pitchB, int k0, int n0, int lane) {
    const int g = lane >> 4, q = (lane & 15) >> 2, pp = lane & 3;
    LAS const unsigned char* p0 = T + (k0 + 8 * g + q) * pitchB + (n0 + 4 * pp) * 2;
    const v4i16_t a = __builtin_amdgcn_ds_read_tr16_b64_v4i16((LAS v4i16_t*)p0);
    const v4i16_t b = __builtin_amdgcn_ds_read_tr16_b64_v4i16((LAS v4i16_t*)(p0 + 4 * pitchB));
    return (bf16x8){a.x, a.y, a.z, a.w, b.x, b.y, b.z, b.w};
}
#define MFMA16(a, b, c) __builtin_amdgcn_mfma_f32_16x16x32_bf16((a), (b), (c), 0, 0, 0)

#define XB_TMO      128
#define XB_XCNT(j)  (256  + 64 * (j))
#define XB_XSUB(j)  (1280 + 64 * (j))
#define XB_XGEN(j)  (2304 + 64 * (j))
#define XB_TOP      3328
#define XB_TOPGEN   3392
#define XCD_BAR_WORDS 3456
#define XB_SPIN_CAP (1u << 18)

__device__ __forceinline__ unsigned xb_ld(unsigned* p)              { return __hip_atomic_load(p, __ATOMIC_RELAXED, __HIP_MEMORY_SCOPE_AGENT); }
__device__ __forceinline__ unsigned xb_add(unsigned* p, unsigned v) { return __hip_atomic_fetch_add(p, v, __ATOMIC_RELAXED, __HIP_MEMORY_SCOPE_AGENT); }
__device__ __forceinline__ unsigned xb_xcc_id() { return (unsigned)__builtin_amdgcn_s_getreg((3 << 11) | 20) & 0xFu; }
#define XB_SPIN(cond, bar) do { unsigned _sp = 0; while (cond) { __builtin_amdgcn_s_sleep(1); \
    if ((++_sp & 255u) == 0u) { if (xb_ld(&(bar)[XB_TMO])) break; if (_sp > XB_SPIN_CAP) { atomicAdd(&(bar)[XB_TMO], 1u); break; } } } } while (0)

struct XcdBarrier {
    unsigned* bar; unsigned x;
    volatile LAS unsigned* st;
};

__device__ __forceinline__ XcdBarrier xcd_barrier_post(unsigned* bar, volatile LAS unsigned* st) {
    XcdBarrier b; b.bar = bar; b.x = xb_xcc_id(); b.st = st;
    if (threadIdx.x == 0) (void)xb_add(&bar[XB_XCNT(b.x)], 1u);
    return b;
}
__device__ __forceinline__ void xcd_barrier_complete(unsigned* bar, unsigned x, unsigned& nloc, unsigned& nx) {
    const unsigned G = gridDim.x * gridDim.y * gridDim.z;
    unsigned sum, cnt, mine, sp = 0u;
    for (;;) {
        sum = 0u; cnt = 0u; mine = 0u;
#pragma unroll
        for (unsigned j = 0; j < 16; ++j) { const unsigned c = xb_ld(&bar[XB_XCNT(j)]); sum += c; cnt += (c > 0u) ? 1u : 0u; mine = (j == x) ? c : mine; }
        if (sum == G) break;
        __builtin_amdgcn_s_sleep(1);
        if ((++sp & 255u) == 0u) { if (xb_ld(&bar[XB_TMO])) break; if (sp > XB_SPIN_CAP) { atomicAdd(&bar[XB_TMO], 1u); break; } }
    }
    nloc = mine > 0u ? mine : 1u; nx = cnt > 0u ? cnt : 1u;
}

__device__ __forceinline__ void xcd_barrier(const XcdBarrier& b) {
    asm volatile("s_waitcnt vmcnt(0)" ::: "memory");
    __syncthreads();
    if (threadIdx.x == 0) {
        unsigned* bar = b.bar;
        __builtin_amdgcn_s_waitcnt(0);
        unsigned nloc = b.st[0], nx = b.st[1];
        if (nloc == 0u) { xcd_barrier_complete(bar, b.x, nloc, nx); b.st[0] = nloc; b.st[1] = nx; }
        const unsigned old = xb_add(&bar[XB_XSUB(b.x)], 1u);
        const unsigned gen = old / nloc;
        if (old + 1u == (gen + 1u) * nloc) {
            __builtin_amdgcn_fence(__ATOMIC_RELEASE, "agent");
            asm volatile("s_waitcnt vmcnt(0)" ::: "memory");
            const unsigned og = xb_add(&bar[XB_TOP], 1u);
            const unsigned tg = og / nx;
            if (og + 1u == (tg + 1u) * nx) xb_add(&bar[XB_TOPGEN], 1u);
            else XB_SPIN(xb_ld(&bar[XB_TOPGEN]) == tg, bar);
            __builtin_amdgcn_fence(__ATOMIC_ACQUIRE, "agent");
            xb_add(&bar[XB_XGEN(b.x)], 1u);
            asm volatile("s_waitcnt vmcnt(0)" ::: "memory");
        } else {
            XB_SPIN(xb_ld(&bar[XB_XGEN(b.x)]) == gen, bar);
            __builtin_amdgcn_fence(__ATOMIC_ACQUIRE, "agent");
            asm volatile("s_waitcnt vmcnt(0)" ::: "memory");
        }
    }
    __syncthreads();
}

__device__ __forceinline__ void transpose_item(const float* W, int K, int N, bf16* WT, LAS float* scr, int item, int lane) {
    const int nblk = N / 32, kb = item / nblk, nb = item % nblk, k0 = 64 * kb, n0 = 32 * nb;
    float tv[32];
#pragma unroll
    for (int i = 0; i < 32; ++i) tv[i] = W[(size_t)(k0 + 2 * i + (lane >> 5)) * N + n0 + (lane & 31)];
#pragma unroll
    for (int i = 0; i < 32; ++i) scr[(2 * i + (lane >> 5)) * 33 + (lane & 31)] = tv[i];
    asm volatile("s_waitcnt lgkmcnt(0)" ::: "memory");
    const int c = lane & 7;
#pragma unroll
    for (int j = 0; j < 4; ++j) { const int n = (lane >> 3) + 8 * j; const LAS float* s = scr + (8 * c) * 33 + n;
        v4u o; o.x = pk2(s[0 * 33], s[1 * 33]); o.y = pk2(s[2 * 33], s[3 * 33]); o.z = pk2(s[4 * 33], s[5 * 33]); o.w = pk2(s[6 * 33], s[7 * 33]);
        *(v4u*)(WT + (size_t)(n0 + n) * K + k0 + 8 * c) = o; }
    asm volatile("s_waitcnt lgkmcnt(0)" ::: "memory");
}
__device__ __forceinline__ void phase_prologue(const Args& a, LAS unsigned char* lds, int tid, int lane, int wave, int G) {
    LAS float* sc = (LAS float*)lds;
    const float* c = a.in[1];
    for (int i = tid; i < 8192; i += NT) sc[i] = siluf_(c[i]);
    __syncthreads();
    float* modp = (float*)(a.ws + WS_MODP);
    for (int it = blockIdx.x; it < 2 * NCH * 12; it += G) {
        const int l = it / (NCH * 12), r = it % (NCH * 12), ch = r / 12, eb = r % 12, e = eb * 512 + tid;
        const float* w = a.in[2] + ((size_t)l * 1024 + ch * 64) * 6144 + e;
        float acc0 = 0.f, acc1 = 0.f, acc2 = 0.f, acc3 = 0.f, acc4 = 0.f, acc5 = 0.f, acc6 = 0.f, acc7 = 0.f;
        const LAS float* s = sc + ch * 64;
#pragma unroll 16
        for (int d = 0; d < 64; ++d) { const float wv = w[(size_t)d * 6144];
            acc0 += s[d] * wv; acc1 += s[1024 + d] * wv; acc2 += s[2048 + d] * wv; acc3 += s[3072 + d] * wv;
            acc4 += s[4096 + d] * wv; acc5 += s[5120 + d] * wv; acc6 += s[6144 + d] * wv; acc7 += s[7168 + d] * wv; }
        float* o = modp + (size_t)((ch * 2 + l) * 8) * 6144 + e;
        o[0] = acc0; o[6144] = acc1; o[2 * 6144] = acc2; o[3 * 6144] = acc3; o[4 * 6144] = acc4; o[5 * 6144] = acc5; o[6 * 6144] = acc6; o[7 * 6144] = acc7;
    }
    __syncthreads();
    LAS float* scr = (LAS float*)(lds + 32768 + wave * 8704);
    const int gw = blockIdx.x * 8 + wave, NGW = G * 8;
    constexpr int I0 = 1792, I1 = 512, I2 = 1024, I3 = 512, I4 = 2048, I5 = 2048;
    constexpr int NITEMS = I0 + I1 + I2 + I3 + 2 * I4 + 2 * I5;
    for (int it = gw; it < NITEMS; it += NGW) {
        int r = it;
        if (r < I0) { transpose_item(a.in[6], 1024, NIN0, (bf16*)(a.ws + WS_WIN0), scr, r, lane); continue; } r -= I0;
        if (r < I1) { transpose_item(a.in[11], 1024, 1024, (bf16*)(a.ws + WS_WOUT0), scr, r, lane); continue; } r -= I1;
        if (r < I2) { transpose_item(a.in[12], 1024, NIN1, (bf16*)(a.ws + WS_WIN1), scr, r, lane); continue; } r -= I2;
        if (r < I3) { transpose_item(a.in[18], 1024, 1024, (bf16*)(a.ws + WS_WOUT1), scr, r, lane); continue; } r -= I3;
        if (r < 2 * I4) { const int l = r / I4; transpose_item(a.in[19] + (size_t)l * 1024 * 4096, 1024, 4096, (bf16*)(a.ws + WS_WFF1) + (size_t)l * 4096 * 1024, scr, r % I4, lane); continue; } r -= 2 * I4;
        { const int l = r / I5; transpose_item(a.in[20] + (size_t)l * 4096 * 1024, 4096, 1024, (bf16*)(a.ws + WS_WFF2) + (size_t)l * 1024 * 4096, scr, r % I5, lane); }
    }
}

template <bool PARTIAL>
__device__ __forceinline__ float modval(const Args& a, int l, int b, int idx) {
    if (PARTIAL) {
        const float* modp = (const float*)(a.ws + WS_MODP);
        float s = a.in[3][l * 6144 + idx];
#pragma unroll
        for (int ch = 0; ch < NCH; ++ch) s += modp[(size_t)((ch * 2 + l) * 8 + b) * 6144 + idx];
        return s;
    } else {
        return ((const float*)(a.ws + WS_MODF))[(size_t)(l * 8 + b) * 6144 + idx];
    }
}
template <bool PARTIAL>
__device__ __forceinline__ void phase_norm(const Args& a, LAS unsigned char* lds, const float* xsrc, const float* gvec, int l, int jshift, int jscale, int tid, int lane, int wave, int G) {
    bf16* h = (bf16*)(a.ws + WS_H);
    if (PARTIAL) {
        float* modf = (float*)(a.ws + WS_MODF);
        for (int i = blockIdx.x * NT + tid; i < 2 * 8 * 6144; i += G * NT) { const int ll = i / 49152, bb = (i / 6144) % 8, idx = i % 6144; modf[i] = modval<true>(a, ll, bb, idx); }
    }
    for (int blk = blockIdx.x; blk < 256; blk += G) {
        const int b = blk >> 5;
        f32x4 gs[4], sh[4];
        if (PARTIAL) {
            LAS float* mv = (LAS float*)lds;
            __syncthreads();
#pragma unroll
            for (int i = 0; i < 4; ++i) { const int e = tid + NT * i; mv[e] = modval<true>(a, l, b, (e < 1024 ? jscale * 1024 + e : jshift * 1024 + e - 1024)); }
            __syncthreads();
#pragma unroll
            for (int j = 0; j < 4; ++j) { const int col = lane * 4 + 256 * j;
#pragma unroll
                for (int i = 0; i < 4; ++i) { gs[j][i] = gvec[col + i] * (1.0f + mv[col + i]); sh[j][i] = mv[1024 + col + i]; } }
        } else {
#pragma unroll
        for (int j = 0; j < 4; ++j) { const int col = lane * 4 + 256 * j;
#pragma unroll
            for (int i = 0; i < 4; ++i) { gs[j][i] = gvec[col + i] * (1.0f + modval<PARTIAL>(a, l, b, jscale * 1024 + col + i)); sh[j][i] = modval<PARTIAL>(a, l, b, jshift * 1024 + col + i); } }
        }
        const float* xb = xsrc + (size_t)blk * 128 * 1024;
        f32x4 nx[4];
#pragma unroll
        for (int j = 0; j < 4; ++j) nx[j] = ((const f32x4*)(xb + (size_t)wave * 1024) + lane)[64 * j];
        for (int r = wave; r < 128; r += 8) {
            const size_t m = (size_t)blk * 128 + r;
            f32x4 v[4]; float ss = 0.f;
#pragma unroll
            for (int j = 0; j < 4; ++j) { v[j] = nx[j]; ss += (v[j].x * v[j].x + v[j].y * v[j].y) + (v[j].z * v[j].z + v[j].w * v[j].w); }
            if (r + 8 < 128) {
#pragma unroll
                for (int j = 0; j < 4; ++j) nx[j] = ((const f32x4*)(xb + (size_t)(r + 8) * 1024) + lane)[64 * j];
            }
            const float inv = 1.0f / sqrtf(wave_sum(ss) * (1.0f / 1024.0f) + EPS);
            v2u* o8 = (v2u*)(h + m * 1024) + lane;
#pragma unroll
            for (int j = 0; j < 4; ++j) { const f32x4 o = v[j] * inv * gs[j] + sh[j]; v2u w; w.x = pk2(o.x, o.y); w.y = pk2(o.z, o.w); o8[64 * j] = w; }
        }
    }
}
__device__ __forceinline__ void unpack8(const v4u w, float (&x)[16], int o) {
#pragma unroll
    for (int i = 0; i < 4; ++i) { x[o + 2 * i] = bflo(w[i]); x[o + 2 * i + 1] = bfhi(w[i]); }
}
__device__ __forceinline__ void phase_norm_bf(const Args& a, const float* gvec, int l, int jshift, int jscale, int tid, int lane, int wave, int G) {
    bf16* h = (bf16*)(a.ws + WS_H); const bf16* xr = (const bf16*)(a.ws + WS_XR);
    for (int blk = blockIdx.x; blk < 256; blk += G) {
        const int b = blk >> 5;
        float gs[16], sh[16];
#pragma unroll
        for (int j = 0; j < 2; ++j)
#pragma unroll
            for (int i = 0; i < 8; ++i) { const int col = lane * 8 + 512 * j + i; gs[8 * j + i] = gvec[col] * (1.0f + modval<false>(a, l, b, jscale * 1024 + col)); sh[8 * j + i] = modval<false>(a, l, b, jshift * 1024 + col); }
        const bf16* xb = xr + (size_t)blk * 128 * 1024 + lane * 8;
        v4u n0 = *(const v4u*)(xb + (size_t)wave * 1024), n1 = *(const v4u*)(xb + (size_t)wave * 1024 + 512);
        for (int r = wave; r < 128; r += 8) {
            float x[16]; unpack8(n0, x, 0); unpack8(n1, x, 8);
            if (r + 8 < 128) { n0 = *(const v4u*)(xb + (size_t)(r + 8) * 1024); n1 = *(const v4u*)(xb + (size_t)(r + 8) * 1024 + 512); }
            float ss = 0.f;
#pragma unroll
            for (int i = 0; i < 16; ++i) ss += x[i] * x[i];
            const float inv = 1.0f / sqrtf(wave_sum(ss) * (1.0f / 1024.0f) + EPS);
            bf16* ho = h + ((size_t)blk * 128 + r) * 1024 + lane * 8;
#pragma unroll
            for (int j = 0; j < 2; ++j) { v4u w;
#pragma unroll
                for (int i = 0; i < 4; ++i) w[i] = pk2(x[8 * j + 2 * i] * inv * gs[8 * j + 2 * i] + sh[8 * j + 2 * i], x[8 * j + 2 * i + 1] * inv * gs[8 * j + 2 * i + 1] + sh[8 * j + 2 * i + 1]);
                *(v4u*)(ho + 512 * j) = w; }
        }
    }
}
__device__ __forceinline__ void phase_final_norm(const Args& a, int lane, int wave, int G) {
    const float* g = a.in[21]; const bf16* xr = (const bf16*)(a.ws + WS_XR);
    float gs[16];
#pragma unroll
    for (int j = 0; j < 2; ++j)
#pragma unroll
        for (int i = 0; i < 8; ++i) gs[8 * j + i] = g[lane * 8 + 512 * j + i];
    int m = blockIdx.x * 8 + wave;
    v4u n0 = (v4u){0u, 0u, 0u, 0u}, n1 = n0;
    if (m < M) { n0 = *(const v4u*)(xr + (size_t)m * 1024 + lane * 8); n1 = *(const v4u*)(xr + (size_t)m * 1024 + lane * 8 + 512); }
    for (; m < M; m += G * 8) {
        float x[16]; unpack8(n0, x, 0); unpack8(n1, x, 8);
        if (m + G * 8 < M) { n0 = *(const v4u*)(xr + (size_t)(m + G * 8) * 1024 + lane * 8); n1 = *(const v4u*)(xr + (size_t)(m + G * 8) * 1024 + lane * 8 + 512); }
        float ss = 0.f;
#pragma unroll
        for (int i = 0; i < 16; ++i) ss += x[i] * x[i];
        const float inv = 1.0f / sqrtf(wave_sum(ss) * (1.0f / 1024.0f) + EPS);
        float* o = a.out + (size_t)m * 1024 + lane * 8;
#pragma unroll
        for (int j = 0; j < 2; ++j) {
            *(f32x4*)(o + 512 * j) = (f32x4){x[8 * j] * inv * gs[8 * j], x[8 * j + 1] * inv * gs[8 * j + 1], x[8 * j + 2] * inv * gs[8 * j + 2], x[8 * j + 3] * inv * gs[8 * j + 3]};
            *(f32x4*)(o + 512 * j + 4) = (f32x4){x[8 * j + 4] * inv * gs[8 * j + 4], x[8 * j + 5] * inv * gs[8 * j + 5], x[8 * j + 6] * inv * gs[8 * j + 6], x[8 * j + 7] * inv * gs[8 * j + 7]};
        }
    }
}

__device__ __forceinline__ void conv_mixer(const Args& a, int tid, int G) {
    const bf16* p = (const bf16*)(a.ws + WS_P); bf16* y = (bf16*)(a.ws + WS_H);
    const float* cw = a.in[7]; const float* cb = a.in[8];
    constexpr int TSEG = 16;
    for (int it = blockIdx.x * NT + tid; it < (M / TSEG) * 64; it += G * NT) {
        const int c0 = (it & 63) * 8, mbase = (it >> 6) * TSEG, t0 = mbase & (SEQ - 1);
        float w0[8], w1[8], w2[8], bb[8], z1[8], z2[8];
#pragma unroll
        for (int i = 0; i < 8; ++i) { w0[i] = cw[c0 + i]; w1[i] = cw[512 + c0 + i]; w2[i] = cw[1024 + c0 + i]; bb[i] = cb[c0 + i]; z1[i] = 0.f; z2[i] = 0.f; }
        const bf16* pr = p + (size_t)mbase * NIN0 + c0;
        if (t0 >= 2) {
            const v4u c1 = *(const v4u*)(pr - (size_t)NIN0 + 512), h1 = *(const v4u*)(pr - (size_t)NIN0 + 1024), c2 = *(const v4u*)(pr - (size_t)2 * NIN0 + 512), h2 = *(const v4u*)(pr - (size_t)2 * NIN0 + 1024);
#pragma unroll
            for (int i = 0; i < 4; ++i) { z1[2 * i] = bflo(c1[i]) * bflo(h1[i]); z1[2 * i + 1] = bfhi(c1[i]) * bfhi(h1[i]); z2[2 * i] = bflo(c2[i]) * bflo(h2[i]); z2[2 * i + 1] = bfhi(c2[i]) * bfhi(h2[i]); }
        }
#pragma unroll 4
        for (int j = 0; j < TSEG; ++j) {
            const v4u cc = *(const v4u*)(pr + (size_t)j * NIN0 + 512), hh = *(const v4u*)(pr + (size_t)j * NIN0 + 1024), gb = *(const v4u*)(pr + (size_t)j * NIN0);
            float z0[8], o[8];
#pragma unroll
            for (int i = 0; i < 4; ++i) { z0[2 * i] = bflo(cc[i]) * bflo(hh[i]); z0[2 * i + 1] = bfhi(cc[i]) * bfhi(hh[i]); }
#pragma unroll
            for (int i = 0; i < 8; ++i) o[i] = bb[i] + w0[i] * z2[i] + w1[i] * z1[i] + w2[i] * z0[i];
            v4u w;
#pragma unroll
            for (int i = 0; i < 4; ++i) w[i] = pk2(bflo(gb[i]) * o[2 * i], bfhi(gb[i]) * o[2 * i + 1]);
            *(v4u*)(y + (size_t)(mbase + j) * 1024 + c0) = w;
#pragma unroll
            for (int i = 0; i < 8; ++i) { z2[i] = z1[i]; z1[i] = z0[i]; }
        }
    }
}
constexpr int HP = 272;
constexpr int HG_SEG = 0, HG_QD = 2048, HG_QR = 19456, HG_KR = 36864, HG_V = 54272, HG_S = 71680, HG_P = 106496, HG_O = 19456;
constexpr int PP = 144;
constexpr int OP = 528;
__device__ __forceinline__ void hg_cum(LAS unsigned char* lds, int tid, const unsigned short (&fraw)[16], const float (&lbl)[3], float (&cum)[16], float (&kk)[16], float& mid, float& last) {
    const int k = tid & 127, seg = tid >> 7;
    const float mx = fmaxf(lbl[0], fmaxf(lbl[1], lbl[2]));
    const float e0 = __expf(lbl[0] - mx), e1 = __expf(lbl[1] - mx), e2 = __expf(lbl[2] - mx), lb = e0 / (e0 + e1 + e2);
    float run = 0.f;
#pragma unroll
    for (int i = 0; i < 16; ++i) { const float x = bf2f(fraw[i]); const float f = lb + (1.0f - lb) * sigmoidf_(x); run += __logf(f); cum[i] = run; kk[i] = 1.0f - f; }
    LAS float* st = (LAS float*)(lds + HG_SEG);
    st[seg * 128 + k] = run;
    __syncthreads();
    const float s0 = st[k], s1 = st[128 + k], s2 = st[256 + k], s3 = st[384 + k];
    const float off = seg == 0 ? 0.f : (seg == 1 ? s0 : (seg == 2 ? s0 + s1 : s0 + s1 + s2));
    mid = s0 + s1; last = (s0 + s1) + (s2 + s3);
#pragma unroll
    for (int i = 0; i < 16; ++i) cum[i] += off;
}
__device__ __forceinline__ void hg_ld_col(unsigned short (&r)[16], const bf16* p, int m0, int col, int tid) {
    const bf16* q = p + (size_t)(m0 + (tid >> 7) * 16) * NIN0 + col + (tid & 127);
#pragma unroll
    for (int i = 0; i < 16; ++i) r[i] = q[(size_t)i * NIN0];
}
__device__ __forceinline__ void hg_ld_lb(float (&l)[3], const float* lbp, int h, int tid) { const int ch = h * 128 + (tid & 127); l[0] = lbp[ch]; l[1] = lbp[512 + ch]; l[2] = lbp[1024 + ch]; }
__device__ __forceinline__ void load_tile128(LAS unsigned char* dst, const bf16* src, size_t src_pitch, int rows, int tid) {
    for (int id = tid; id < rows * 16; id += NT) { const int r = id >> 4, c = id & 15; *(LAS v4u*)(dst + r * HP + c * 16) = *(const v4u*)(src + (size_t)r * src_pitch + c * 8); }
}
template <int N16> __device__ __forceinline__ void tile_ld(v4u (&t)[N16], const bf16* src, size_t src_pitch, int tid) {
#pragma unroll
    for (int i = 0; i < N16; ++i) { const int id = tid + NT * i, r = id >> 4, c = id & 15; t[i] = *(const v4u*)(src + (size_t)r * src_pitch + c * 8); }
}
template <int N16> __device__ __forceinline__ void tile_st(const v4u (&t)[N16], LAS unsigned char* dst, int tid) {
#pragma unroll
    for (int i = 0; i < N16; ++i) { const int id = tid + NT * i, r = id >> 4, c = id & 15; *(LAS v4u*)(dst + r * HP + c * 16) = t[i]; }
}
__device__ __forceinline__ void hg_pass_a(const Args& a, LAS unsigned char* lds, int tid, int lane, int wave, int G) {
    const bf16* p = (const bf16*)(a.ws + WS_P);
    bf16* loc = (bf16*)a.out; float* dec = (float*)(a.ws + WS_DEC);
    unsigned short fraw[16]; float lbl[3]; v4u vt[2];
    if ((int)blockIdx.x < 2048) { const int u0 = blockIdx.x, h0 = (u0 >> 6) & 3, mm = (u0 >> 8) * SEQ + (u0 & 63) * 64;
        hg_ld_col(fraw, p, mm, 2048 + h0 * 128, tid); hg_ld_lb(lbl, a.in[9], h0, tid); tile_ld<2>(vt, p + (size_t)mm * NIN0 + 2560 + h0 * 128, NIN0, tid); }
    for (int unit = blockIdx.x; unit < 2048; unit += G) {
        unsigned short nfraw[16]; float nlbl[3]; v4u nvt[2];
        const int nu = unit + G;
        if (nu < 2048) { const int h1 = (nu >> 6) & 3, mm = (nu >> 8) * SEQ + (nu & 63) * 64;
            hg_ld_col(nfraw, p, mm, 2048 + h1 * 128, tid); hg_ld_lb(nlbl, a.in[9], h1, tid); tile_ld<2>(nvt, p + (size_t)mm * NIN0 + 2560 + h1 * 128, NIN0, tid); }
        float cum[16], kk[16], mid, last;
        hg_cum(lds, tid, fraw, lbl, cum, kk, mid, last);
        const int k = tid & 127, seg = tid >> 7;
#pragma unroll
        for (int i = 0; i < 16; ++i) *(LAS unsigned short*)(lds + HG_KR + (seg * 16 + i) * HP + k * 2) = f2bf(kk[i] * __expf(last - cum[i]));
        if (seg == 0) dec[unit * 128 + k] = __expf(last);
        tile_st<2>(vt, lds + HG_V, tid);
        if (nu < 2048) {
#pragma unroll
            for (int i = 0; i < 16; ++i) fraw[i] = nfraw[i];
            lbl[0] = nlbl[0]; lbl[1] = nlbl[1]; lbl[2] = nlbl[2]; vt[0] = nvt[0]; vt[1] = nvt[1]; }
        __syncthreads();
        f32x4 acc[8];
#pragma unroll
        for (int n = 0; n < 8; ++n) acc[n] = (f32x4){0.f, 0.f, 0.f, 0.f};
#pragma unroll
        for (int ks = 0; ks < 2; ++ks) {
            const bf16x8 B = trfrag(lds + HG_KR, HP, 32 * ks, 16 * wave, lane);
#pragma unroll
            for (int n = 0; n < 8; ++n) { const bf16x8 A = trfrag(lds + HG_V, HP, 32 * ks, 16 * n, lane); acc[n] = MFMA16(A, B, acc[n]); }
        }
        const int fr = lane & 15, fq = lane >> 4;
        bf16* lo = loc + (size_t)unit * 16384 + (16 * wave + fr) * 128 + 4 * fq;
#pragma unroll
        for (int n = 0; n < 8; ++n) { v2u w; w.x = pk2(acc[n][0], acc[n][1]); w.y = pk2(acc[n][2], acc[n][3]); *(v2u*)(lo + 16 * n) = w; }
        __syncthreads();
    }
}
__device__ __forceinline__ void hg_pass_b(const Args& a, int tid, int G) {
    const bf16* loc = (const bf16*)a.out; const float* dec = (const float*)(a.ws + WS_DEC); bf16* st = (bf16*)(a.ws + WS_S);
    for (int idx = blockIdx.x * NT + tid; idx < 32 * 128 * 32; idx += G * NT) {
        const int bh = idx >> 12, k = (idx >> 5) & 127, v4 = idx & 31;
        f32x4 S = (f32x4){0.f, 0.f, 0.f, 0.f};
        const size_t e0 = (size_t)bh * 64 * 16384 + k * 128 + v4 * 4;
#pragma unroll 16
        for (int c = 0; c < 64; ++c) {
            const v2u Lw = *(const v2u*)(loc + e0 + (size_t)c * 16384); const float d = dec[(bh * 64 + c) * 128 + k];
            const f32x4 L = (f32x4){bflo(Lw.x), bfhi(Lw.x), bflo(Lw.y), bfhi(Lw.y)};
            v2u w; w.x = pk2(S.x, S.y); w.y = pk2(S.z, S.w);
            *(v2u*)(st + e0 + (size_t)c * 16384) = w;
            S = S * d + L;
        }
    }
}
__device__ __forceinline__ void hg_pass_c(const Args& a, LAS unsigned char* lds, int tid, int lane, int wave, int G) {
    const bf16* p = (const bf16*)(a.ws + WS_P); const bf16* stg = (const bf16*)(a.ws + WS_S); bf16* y = (bf16*)(a.ws + WS_H);
    const float* gain = a.in[10];
    const int fr = lane & 15, fq = lane >> 4;
    unsigned short fraw[16], qraw[16]; float lbl[3]; v4u vt[2], stt4[4], graw[2];
#define HG_LOAD_C(U, F, Q, L, V, S, GR) do { const int h_ = ((U) >> 6) & 3, mm_ = ((U) >> 8) * SEQ + ((U) & 63) * 64; \
        hg_ld_col(F, p, mm_, 2048 + h_ * 128, tid); hg_ld_col(Q, p, mm_, 1536 + h_ * 128, tid); hg_ld_lb(L, a.in[9], h_, tid); \
        tile_ld<2>(V, p + (size_t)mm_ * NIN0 + 2560 + h_ * 128, NIN0, tid); tile_ld<4>(S, stg + (size_t)(U) * 16384, 128, tid); \
        { const bf16* gp_ = p + (size_t)(mm_ + (tid >> 3)) * NIN0 + 3072 + h_ * 128 + (tid & 7) * 16; GR[0] = *(const v4u*)gp_; GR[1] = *(const v4u*)(gp_ + 8); } } while (0)
    if ((int)blockIdx.x < 2048) HG_LOAD_C((int)blockIdx.x, fraw, qraw, lbl, vt, stt4, graw);
    for (int unit = blockIdx.x; unit < 2048; unit += G) {
        const int b = unit >> 8, h = (unit >> 6) & 3, c = unit & 63, m0 = b * SEQ + c * 64;
        unsigned short nfraw[16], nqraw[16]; float nlbl[3]; v4u nvt[2], nstt4[4], ngraw[2];
        const int nu = unit + G;
        if (nu < 2048) HG_LOAD_C(nu, nfraw, nqraw, nlbl, nvt, nstt4, ngraw);
        const v4u g0 = graw[0], g1 = graw[1];
        {
            const int k = tid & 127, seg = tid >> 7;
            float cum[16], kk[16], mid, last;
            hg_cum(lds, tid, fraw, lbl, cum, kk, mid, last);
#pragma unroll
            for (int i = 0; i < 16; ++i) {
                const float q = bf2f(qraw[i]);
                const int o = (seg * 16 + i) * HP + k * 2;
                *(LAS unsigned short*)(lds + HG_QD + o) = f2bf(q * __expf(cum[i]));
                *(LAS unsigned short*)(lds + HG_QR + o) = f2bf(q * __expf(fminf(cum[i] - mid, 80.f)));
                *(LAS unsigned short*)(lds + HG_KR + o) = f2bf(kk[i] * __expf(fminf(mid - cum[i], 80.f)));
            }
        }
        tile_st<2>(vt, lds + HG_V, tid);
        tile_st<4>(stt4, lds + HG_S, tid);
        if (nu < 2048) {
#pragma unroll
            for (int i = 0; i < 16; ++i) { fraw[i] = nfraw[i]; qraw[i] = nqraw[i]; }
            lbl[0] = nlbl[0]; lbl[1] = nlbl[1]; lbl[2] = nlbl[2]; vt[0] = nvt[0]; vt[1] = nvt[1];
#pragma unroll
            for (int i = 0; i < 4; ++i) stt4[i] = nstt4[i];
            graw[0] = ngraw[0]; graw[1] = ngraw[1]; }
        __syncthreads();
        {
            const int tt = wave >> 1;
#pragma unroll
            for (int j = 0; j < 2; ++j) {
                const int stl = (wave & 1) * 2 + j;
                f32x4 sc = (f32x4){0.f, 0.f, 0.f, 0.f};
                if (stl <= tt) {
#pragma unroll
                    for (int ks = 0; ks < 4; ++ks) sc = MFMA16(rowfrag(lds + HG_QR, HP, 16 * tt, 32 * ks, fr, fq), rowfrag(lds + HG_KR, HP, 16 * stl, 32 * ks, fr, fq), sc);
                }
#pragma unroll
                for (int r = 0; r < 4; ++r) { const int t = 16 * tt + 4 * fq + r, s = 16 * stl + fr;
                    *(LAS unsigned short*)(lds + HG_P + t * PP + s * 2) = f2bf(s <= t ? sc[r] : 0.f); }
            }
        }
        __syncthreads();
        {
            const int tt = wave >> 1, n0 = (wave & 1) * 4;
            f32x4 acc[4];
#pragma unroll
            for (int n = 0; n < 4; ++n) acc[n] = (f32x4){0.f, 0.f, 0.f, 0.f};
#pragma unroll
            for (int ks = 0; ks < 4; ++ks) { const bf16x8 A = rowfrag(lds + HG_QD, HP, 16 * tt, 32 * ks, fr, fq);
#pragma unroll
                for (int n = 0; n < 4; ++n) acc[n] = MFMA16(A, trfrag(lds + HG_S, HP, 32 * ks, 16 * (n0 + n), lane), acc[n]); }
#pragma unroll
            for (int ks = 0; ks < 2; ++ks) { const bf16x8 A = rowfrag(lds + HG_P, PP, 16 * tt, 32 * ks, fr, fq);
#pragma unroll
                for (int n = 0; n < 4; ++n) acc[n] = MFMA16(A, trfrag(lds + HG_V, HP, 32 * ks, 16 * (n0 + n), lane), acc[n]); }
#pragma unroll
            for (int n = 0; n < 4; ++n)
#pragma unroll
                for (int r = 0; r < 4; ++r) *(LAS float*)(lds + HG_O + (16 * tt + 4 * fq + r) * OP + (16 * (n0 + n) + fr) * 4) = acc[n][r];
        }
        __syncthreads();
        {
            const int t = tid >> 3, part = tid & 7, v0 = part * 16;
            f32x4 o[4]; float ss = 0.f;
#pragma unroll
            for (int j = 0; j < 4; ++j) { o[j] = *(LAS const f32x4*)(lds + HG_O + t * OP + (v0 + 4 * j) * 4); ss += (o[j].x * o[j].x + o[j].y * o[j].y) + (o[j].z * o[j].z + o[j].w * o[j].w); }
            ss += __shfl_xor(ss, 1); ss += __shfl_xor(ss, 2); ss += __shfl_xor(ss, 4);
            const float inv = 1.0f / sqrtf(ss * (1.0f / 128.0f) + EPS);
            const float* gn = gain + h * 128 + v0;
            v4u w0, w1;
#pragma unroll
            for (int i = 0; i < 4; ++i) {
                const float ga = bflo(g0[i]), gb = bfhi(g0[i]), gc = bflo(g1[i]), gd = bfhi(g1[i]);
                const int e = 2 * i;
                const float oa = o[e >> 2][e & 3], ob = o[(e + 1) >> 2][(e + 1) & 3], oc = o[(8 + e) >> 2][(8 + e) & 3], od = o[(9 + e) >> 2][(9 + e) & 3];
                w0[i] = pk2(oa * inv * gn[e] * siluf_(ga), ob * inv * gn[e + 1] * siluf_(gb));
                w1[i] = pk2(oc * inv * gn[8 + e] * siluf_(gc), od * inv * gn[9 + e] * siluf_(gd));
            }
            bf16* yo = y + (size_t)(m0 + t) * 1024 + 512 + h * 128 + v0;
            *(v4u*)yo = w0; *(v4u*)(yo + 8) = w1;
        }
        __syncthreads();
    }
}

constexpr int SG_STAT = 0, SG_W = 1024, SG_V = 35840, SGVP = 528;
__device__ __forceinline__ void phase_sgu(const Args& a, LAS unsigned char* lds, int tid, int lane, int wave, int G) {
    const bf16* z = (const bf16*)(a.ws + WS_P); bf16* y = (bf16*)(a.ws + WS_H);
    const float* lng = a.in[14]; const float* lnb = a.in[15]; const float* ws = a.in[16]; const float* bs = a.in[17];
    const int fr = lane & 15, fq = lane >> 4;
    for (int unit = blockIdx.x; unit < 256; unit += G) {
        const int m0 = unit * 128;
        LAS float* stt = (LAS float*)(lds + SG_STAT);
        {
            const bf16* vb = z + (size_t)m0 * NIN1 + 1024 + lane * 8;
            v4u a0 = *(const v4u*)(vb + (size_t)wave * NIN1), a1 = *(const v4u*)(vb + (size_t)wave * NIN1 + 512);
            for (int r = wave; r < 128; r += 8) {
                float x[16]; unpack8(a0, x, 0); unpack8(a1, x, 8);
                if (r + 8 < 128) { a0 = *(const v4u*)(vb + (size_t)(r + 8) * NIN1); a1 = *(const v4u*)(vb + (size_t)(r + 8) * NIN1 + 512); }
                float s = 0.f, q = 0.f;
#pragma unroll
                for (int i = 0; i < 16; ++i) { s += x[i]; q += x[i] * x[i]; }
#pragma unroll
                for (int o = 1; o < 64; o <<= 1) { s += __shfl_xor(s, o); q += __shfl_xor(q, o); }
                const float mean = s * (1.0f / 1024.0f);
                const float var = fmaxf(q * (1.0f / 1024.0f) - mean * mean, 0.f);
                if (lane == 0) { stt[2 * r] = mean; stt[2 * r + 1] = 1.0f / sqrtf(var + EPS); }
            }
        }
        __syncthreads();
        for (int g = 0; g < 4; ++g) {
            {
                const int t = tid >> 2, s0 = (tid & 3) * 32;
                const float* wr = ws + (size_t)g * 16384 + t * 128 + s0;
#pragma unroll
                for (int j = 0; j < 4; ++j) {
                    const f32x4 w0 = *(const f32x4*)(wr + 8 * j), w1 = *(const f32x4*)(wr + 8 * j + 4);
                    const int s = s0 + 8 * j;
                    v4u o;
                    o.x = pk2(s + 0 <= t ? w0.x : 0.f, s + 1 <= t ? w0.y : 0.f); o.y = pk2(s + 2 <= t ? w0.z : 0.f, s + 3 <= t ? w0.w : 0.f);
                    o.z = pk2(s + 4 <= t ? w1.x : 0.f, s + 5 <= t ? w1.y : 0.f); o.w = pk2(s + 6 <= t ? w1.z : 0.f, s + 7 <= t ? w1.w : 0.f);
                    *(LAS v4u*)(lds + SG_W + t * HP + s * 2) = o;
                }
            }
#pragma unroll 2
            for (int i = 0; i < 8; ++i) {
                const int id = tid + NT * i, s = id >> 5, dc = (id & 31) * 8, col = g * 256 + dc;
                const v4u vv = *(const v4u*)(z + (size_t)(m0 + s) * NIN1 + 1024 + col);
                const float mean = stt[2 * s], rstd = stt[2 * s + 1];
                const f32x4 g0 = *(const f32x4*)(lng + col), g1 = *(const f32x4*)(lng + col + 4), b0 = *(const f32x4*)(lnb + col), b1 = *(const f32x4*)(lnb + col + 4);
                v4u o;
                o.x = pk2((bflo(vv.x) - mean) * rstd * g0.x + b0.x, (bfhi(vv.x) - mean) * rstd * g0.y + b0.y);
                o.y = pk2((bflo(vv.y) - mean) * rstd * g0.z + b0.z, (bfhi(vv.y) - mean) * rstd * g0.w + b0.w);
                o.z = pk2((bflo(vv.z) - mean) * rstd * g1.x + b1.x, (bfhi(vv.z) - mean) * rstd * g1.y + b1.y);
                o.w = pk2((bflo(vv.w) - mean) * rstd * g1.z + b1.z, (bfhi(vv.w) - mean) * rstd * g1.w + b1.w);
                *(LAS v4u*)(lds + SG_V + s * SGVP + dc * 2) = o;
            }
            __syncthreads();
            f32x4 acc[16];
#pragma unroll
            for (int n = 0; n < 16; ++n) acc[n] = (f32x4){0.f, 0.f, 0.f, 0.f};
            for (int ks = 0; ks < 4; ++ks) {
                if (32 * ks > 16 * wave + 15) break;
                const bf16x8 A = rowfrag(lds + SG_W, HP, 16 * wave, 32 * ks, fr, fq);
#pragma unroll
                for (int n = 0; n < 16; ++n) acc[n] = MFMA16(A, trfrag(lds + SG_V, SGVP, 32 * ks, 16 * n, lane), acc[n]);
            }
            __syncthreads();
#pragma unroll
            for (int r = 0; r < 4; ++r) {
                const int t = 16 * wave + 4 * fq + r; const float bsv = bs[g * 128 + t];
#pragma unroll
                for (int n = 0; n < 16; ++n) *(LAS unsigned short*)(lds + SG_V + t * SGVP + (16 * n + fr) * 2) = f2bf(acc[n][r] + bsv);
            }
            __syncthreads();
#pragma unroll 4
            for (int i = 0; i < 8; ++i) {
                const int id = tid + NT * i, t = id >> 5, dc = (id & 31) * 8;
                const v4u mx = *(LAS const v4u*)(lds + SG_V + t * SGVP + dc * 2);
                const v4u uu = *(const v4u*)(z + (size_t)(m0 + t) * NIN1 + g * 256 + dc);
                v4u o;
#pragma unroll
                for (int j = 0; j < 4; ++j) o[j] = pk2(bflo(mx[j]) * bflo(uu[j]), bfhi(mx[j]) * bfhi(uu[j]));
                *(v4u*)(y + (size_t)(m0 + t) * 1024 + g * 256 + dc) = o;
            }
            __syncthreads();
        }
    }
}

#ifndef MK_N_LAUNCHES
#define MK_N_LAUNCHES 1
#endif

__global__ void __launch_bounds__(512, 2) fwd(Args a) {
    extern __shared__ __attribute__((aligned(16))) unsigned char lds_raw[];
    LAS unsigned char* lds = (LAS unsigned char*)lds_raw;
    cg::grid_group grid = cg::this_grid();
    volatile LAS unsigned* MISC = (volatile LAS unsigned*)(lds + MISC_OFF);
    if (threadIdx.x < 16) MISC[threadIdx.x] = 0u;
    __syncthreads();
    const XcdBarrier xbar = xcd_barrier_post((unsigned*)(a.ws + WS_BAR), MISC + 8);
    const int lo = a.ph_lo, hi = a.ph_hi;
#define IN(k) (lo <= (k) && (k) < hi)
#ifndef DBL_MASK
#define DBL_MASK 0
#endif
#define REP(k) _Pragma("unroll 1") for (int rep_ = 0; rep_ <= ((DBL_MASK >> (k)) & 1); ++rep_)
#define SEAM(k) do { if (IN(k) && IN((k) + 1)) { xcd_barrier(xbar); } } while (0)
#define PHASE_VARS int tid = threadIdx.x; asm volatile("" : "+v"(tid)); int G = gridDim.x; asm volatile("" : "+s"(G)); \
    const int lane = tid & 63, wave = __builtin_amdgcn_readfirstlane(tid >> 6); (void)lane; (void)wave; \
    bf16* const H = (bf16*)(a.ws + WS_H); bf16* const P = (bf16*)(a.ws + WS_P); const float* const modf = (const float*)(a.ws + WS_MODF); (void)H; (void)P; (void)modf;
#define GEMM_RES(ph, l, ffn) if (IN(ph)) REP(ph) { PHASE_VARS \
        const bf16* Bt = (ffn) ? (const bf16*)(a.ws + WS_WFF2) + (size_t)(l) * 1024 * 4096 : (const bf16*)(a.ws + ((l) ? WS_WOUT1 : WS_WOUT0)); \
        pg8::Gemm g{(ffn) ? P : H, Bt, M, 1024, (ffn) ? 4096 : 1024}; pg8::StaticOrder S; S.init(M, 1024, G, (int)blockIdx.x); \
        if ((ph) == 6) { pg8::EpiResGateBf<true> E{a.in[0], (bf16*)(a.ws + WS_XR), modf + (size_t)(l) * 8 * 6144 + ((ffn) ? 5 : 2) * 1024}; \
            pg8::gemm_phase<pg8::EpiResGateBf<true>, pg8::StaticOrder, false, true>(lds, g, S, E); } \
        else { pg8::EpiResGateBf<false> E{a.ws + WS_XR, (bf16*)(a.ws + WS_XR), modf + (size_t)(l) * 8 * 6144 + ((ffn) ? 5 : 2) * 1024}; \
            pg8::gemm_phase<pg8::EpiResGateBf<false>, pg8::StaticOrder, false, true>(lds, g, S, E); } } SEAM(ph);
#define GEMM_FF1(ph, l) if (IN(ph)) REP(ph) { PHASE_VARS \
        pg8::Gemm g{H, (const bf16*)(a.ws + WS_WFF1) + (size_t)(l) * 4096 * 1024, M, FF, 1024}; pg8::StaticOrder S; S.init(M, FF, G, (int)blockIdx.x); \
        pg8::EpiBf16<2> E{P, FF, nullptr}; \
        pg8::gemm_phase<pg8::EpiBf16<2>, pg8::StaticOrder, true, true>(lds, g, S, E); } SEAM(ph);
#define NORM(ph, l, ffn) if (IN(ph)) REP(ph) { PHASE_VARS \
        phase_norm_bf(a, ((ffn) ? a.in[5] : a.in[4]) + (l) * 1024, (l), (ffn) ? 3 : 0, (ffn) ? 4 : 1, tid, lane, wave, G); } SEAM(ph);

    if (a.ph_hi > NPH) grid.sync();
    if (IN(0)) REP(0) { PHASE_VARS phase_prologue(a, lds, tid, lane, wave, G); } SEAM(0);
    if (IN(1)) REP(1) { PHASE_VARS phase_norm<true>(a, lds, a.in[0], a.in[4], 0, 0, 1, tid, lane, wave, G); } SEAM(1);
    if (IN(2)) REP(2) { PHASE_VARS
        pg8::Gemm g{H, (const bf16*)(a.ws + WS_WIN0), M, NIN0, 1024}; pg8::StaticOrder S; S.init(M, NIN0, G, (int)blockIdx.x);
        pg8::EpiBf16<0> E{P, NIN0, nullptr};
        pg8::gemm_phase<pg8::EpiBf16<0>, pg8::StaticOrder, true, true>(lds, g, S, E); } SEAM(2);
    if (IN(3)) REP(3) { PHASE_VARS conv_mixer(a, tid, G); hg_pass_a(a, lds, tid, lane, wave, G); } SEAM(3);
    if (IN(4)) REP(4) { PHASE_VARS hg_pass_b(a, tid, G); } SEAM(4);
    if (IN(5)) REP(5) { PHASE_VARS hg_pass_c(a, lds, tid, lane, wave, G); } SEAM(5);
    GEMM_RES(6, 0, false)
    NORM(7, 0, true)
    GEMM_FF1(8, 0)
    GEMM_RES(9, 0, true)
    NORM(10, 1, false)
    if (IN(11)) REP(11) { PHASE_VARS
        pg8::Gemm g{H, (const bf16*)(a.ws + WS_WIN1), M, NIN1, 1024}; pg8::StaticOrder S; S.init(M, NIN1, G, (int)blockIdx.x);
        pg8::EpiBf16<1> E{P, NIN1, a.in[13]};
        pg8::gemm_phase<pg8::EpiBf16<1>, pg8::StaticOrder, true, true>(lds, g, S, E); } SEAM(11);
    if (IN(12)) REP(12) { PHASE_VARS phase_sgu(a, lds, tid, lane, wave, G); } SEAM(12);
    GEMM_RES(13, 1, false)
    NORM(14, 1, true)
    GEMM_FF1(15, 1)
    GEMM_RES(16, 1, true)
    if (IN(17)) REP(17) { PHASE_VARS phase_final_norm(a, lane, wave, G); }
}
}

extern "C" void kernel_launch(void* const* d_in, const int* in_sizes, int n_in, void* d_out, int out_size, void* d_ws, size_t ws_size, hipStream_t stream) {
    using namespace mk;
    static int grid = 0;
    if (grid == 0) {
        if (n_in != 22 || out_size != M * D || ws_size < WS_END) { fprintf(stderr, "kernel_launch: unexpected shapes (n_in %d out %d ws %zu)\n", n_in, out_size, ws_size); grid = -1; return; }
        int dev = 0, cus = 0, per_cu = 0;
        (void)hipGetDevice(&dev); (void)hipDeviceGetAttribute(&cus, hipDeviceAttributeMultiprocessorCount, dev);
        if (hipFuncSetAttribute((const void*)fwd, hipFuncAttributeMaxDynamicSharedMemorySize, LDS_BYTES) != hipSuccess) fprintf(stderr, "kernel_launch: hipFuncSetAttribute failed\n");
        if (hipOccupancyMaxActiveBlocksPerMultiprocessor(&per_cu, (const void*)fwd, NT, LDS_BYTES) != hipSuccess || per_cu < 1) { fprintf(stderr, "kernel_launch: occupancy query says %d\n", per_cu); per_cu = 1; }
        (void)hipGetLastError();
        grid = cus * per_cu;
        if (grid <= 0) grid = 256;
    }
    if (grid < 0) return;
    if (hipMemsetAsync((char*)d_ws + WS_BAR, 0, BAR_ZERO_BYTES, stream) != hipSuccess) fprintf(stderr, "kernel_launch: memset of barrier words failed\n");
    Args a{};
    for (int i = 0; i < 22; ++i) a.in[i] = (const float*)d_in[i];
    a.out = (float*)d_out; a.ws = (unsigned char*)d_ws;
#if MK_N_LAUNCHES == 1
    a.ph_lo = 0; a.ph_hi = NPH;
    void* args[] = {&a};
    hipError_t e = hipLaunchCooperativeKernel((const void*)fwd, dim3(grid), dim3(NT), args, LDS_BYTES, stream);
    if (e != hipSuccess) fprintf(stderr, "cooperative launch failed: %s (grid %d)\n", hipGetErrorString(e), grid);
#else
    for (int ph = 0; ph < NPH; ++ph) {
        a.ph_lo = ph; a.ph_hi = ph + 1;
        hipLaunchKernelGGL(fwd, dim3(grid), dim3(NT), LDS_BYTES, stream, a);
    }
#endif
}
```

```cpp
#include <hip/hip_runtime.h>
#include <hip/hip_cooperative_groups.h>
#include <cstdio>
#include <cstdint>
namespace cg = cooperative_groups;
namespace pg8 {
#define PG8_LAS __attribute__((address_space(3)))
typedef unsigned short bf16_t;
typedef short bf16x8 __attribute__((ext_vector_type(8)));
typedef float f32x4 __attribute__((ext_vector_type(4)));
typedef unsigned u32x4 __attribute__((ext_vector_type(4)));
constexpr int BM = 256, BK = 64, HALF = 128, HTB = HALF * BK * 2  , STAGE_BYTES = 8 * HTB, NXCD = 8, WGM = 8;

__host__ __device__ __forceinline__ int lds_byte(int r, int c) { const int st = (r >> 4) * 2 + (c >> 5), rr = r & 15, cc = c & 31, ob = rr * 64 + cc * 2; return st * 1024 + (ob ^ (((ob >> 9) & 1) << 5)); }
__host__ __device__ __forceinline__ void stage_rc(int b, int& R, int& C) { const int st = b / 1024, sb = b % 1024, swz = sb ^ (((sb >> 9) & 1) << 5); R = (st >> 1) * 16 + swz / 64; C = (st & 1) * 32 + (swz % 64) / 2; }
__host__ __device__ __forceinline__ int perm32(int rho) { const int n = rho >> 4, i = rho & 15; return 8 * (i >> 2) + 4 * n + (i & 3); }

struct Unit { int pm, pn; };
struct Gemm { const bf16_t* A; const bf16_t* Bt; int M, N, K; };

struct StaticOrder {
    int nM, nN, nwg, G, c;
    __host__ __device__ void init(int M, int N, int G_, int c_) { nM = M / BM; nN = N / BM; nwg = nM * nN; G = G_; c = c_; }
    __host__ __device__ bool next(int i, Unit& u) const {
        const long L = (long)i * G + c; if (L >= nwg) return false;
        int wgid = (int)L; { const int q = nwg / NXCD, r = nwg % NXCD, xcd = wgid % NXCD, off = wgid / NXCD; wgid = (xcd < r ? xcd * (q + 1) : r * (q + 1) + (xcd - r) * q) + off; }
        const int nig = WGM * nN, gid = wgid / nig, fm = gid * WGM, gsz = (nM - fm) < WGM ? (nM - fm) : WGM;
        u.pm = fm + ((wgid % nig) % gsz); u.pn = (wgid % nig) / gsz; return true;
    }
    __device__ __forceinline__ void a_ready(const Unit&) const {}
    __device__ __forceinline__ void done(const Unit&) const {}
};

typedef float f32x2c_t __attribute__((ext_vector_type(2)));
typedef __bf16 bf16x2c_t __attribute__((ext_vector_type(2)));
__device__ __forceinline__ unsigned cvt_pk_bf16(float lo, float hi) { const f32x2c_t v = {lo, hi}; const bf16x2c_t b = __builtin_convertvector(v, bf16x2c_t); return __builtin_bit_cast(unsigned, b); }
typedef float f32x2 __attribute__((ext_vector_type(2)));
__device__ __forceinline__ float gelu_tanh(float x) {
    const float u = 0.7978845608f * (x + 0.044715f * x * x * x);
    const float e = __builtin_amdgcn_exp2f(-2.0f * 1.4426950408889634f * u);
    return x * __builtin_amdgcn_rcpf(1.0f + e);
}
template <int ACT> struct EpiBf16 {
    static constexpr bool PERM = true, AFTER_DRAIN = false;
    bf16_t* O; int ldc; const float* bias;
    __device__ __forceinline__ void operator()(const f32x4 (&acc)[2][2][4][2], const Unit& u, int wr, int wc, int fr, int fq) const {
        const int row0 = u.pm * BM + wr * 64 + fr; const int col0 = u.pn * BM + wc * 32 + 8 * fq;
        f32x4 bv[2][2];
#pragma unroll
        for (int bj = 0; bj < 2; ++bj)
#pragma unroll
            for (int n = 0; n < 2; ++n) bv[bj][n] = bias ? *(const f32x4*)(bias + col0 + bj * HALF + 4 * n) : (f32x4){0.f, 0.f, 0.f, 0.f};
#pragma unroll
        for (int ai = 0; ai < 2; ++ai)
#pragma unroll
            for (int m = 0; m < 4; ++m) { bf16_t* rowp = O + (size_t)(row0 + ai * HALF + m * 16) * ldc + col0;
#pragma unroll
                for (int bj = 0; bj < 2; ++bj) { f32x4 v0 = acc[ai][bj][m][0] + bv[bj][0], v1 = acc[ai][bj][m][1] + bv[bj][1];
                    if (ACT == 1) {
#pragma unroll
                        for (int i = 0; i < 4; ++i) { v0[i] = gelu_tanh(v0[i]); v1[i] = gelu_tanh(v1[i]); } }
                    if (ACT == 2) {
#pragma unroll
                        for (int i = 0; i < 4; ++i) { const float a = fmaxf(v0[i], 0.f), b = fmaxf(v1[i], 0.f); v0[i] = a * a; v1[i] = b * b; } }
                    u32x4 w; w.x = cvt_pk_bf16(v0[0], v0[1]); w.y = cvt_pk_bf16(v0[2], v0[3]); w.z = cvt_pk_bf16(v1[0], v1[1]); w.w = cvt_pk_bf16(v1[2], v1[3]);
                    *(u32x4*)(rowp + bj * HALF) = w; } }
    }
};
struct EpiResGate {
    static constexpr bool PERM = false, AFTER_DRAIN = false;
    const float* base; float* out; const float* gate;
    __device__ __forceinline__ void operator()(const f32x4 (&acc)[2][2][4][2], const Unit& u, int wr, int wc, int fr, int fq) const {
        const int row0 = u.pm * BM + wr * 64 + fr; const int col0 = u.pn * BM + wc * 32 + 4 * fq; const int b = u.pm >> 4;
        f32x4 gv[2][2];
#pragma unroll
        for (int bj = 0; bj < 2; ++bj)
#pragma unroll
            for (int n = 0; n < 2; ++n) gv[bj][n] = *(const f32x4*)(gate + (size_t)b * 6144 + col0 + bj * HALF + n * 16);
#pragma unroll
        for (int ai = 0; ai < 2; ++ai) {
            f32x4 bs[4][2][2];
#pragma unroll
            for (int m = 0; m < 4; ++m) { const size_t off = (size_t)(row0 + ai * HALF + m * 16) * 1024 + col0;
#pragma unroll
                for (int bj = 0; bj < 2; ++bj)
#pragma unroll
                    for (int n = 0; n < 2; ++n) bs[m][bj][n] = *(const f32x4*)(base + off + bj * HALF + n * 16); }
#pragma unroll
            for (int m = 0; m < 4; ++m) { const size_t off = (size_t)(row0 + ai * HALF + m * 16) * 1024 + col0;
#pragma unroll
                for (int bj = 0; bj < 2; ++bj)
#pragma unroll
                    for (int n = 0; n < 2; ++n) *(f32x4*)(out + off + bj * HALF + n * 16) = bs[m][bj][n] + gv[bj][n] * acc[ai][bj][m][n]; }
            asm volatile("" ::: "memory"); }
    }
};
template <bool BASE_F32> struct EpiResGateBf {
    static constexpr bool PERM = true, AFTER_DRAIN = false;
    const void* base; bf16_t* out; const float* gate;
    __device__ __forceinline__ void operator()(const f32x4 (&acc)[2][2][4][2], const Unit& u, int wr, int wc, int fr, int fq) const {
        const int row0 = u.pm * BM + wr * 64 + fr; const int col0 = u.pn * BM + wc * 32 + 8 * fq; const int b = u.pm >> 4;
        f32x4 gv[2][2];
#pragma unroll
        for (int bj = 0; bj < 2; ++bj)
#pragma unroll
            for (int n = 0; n < 2; ++n) gv[bj][n] = *(const f32x4*)(gate + (size_t)b * 6144 + col0 + bj * HALF + 4 * n);
#pragma unroll
        for (int ai = 0; ai < 2; ++ai) {
            f32x4 bs[4][2][2];
#pragma unroll
            for (int m = 0; m < 4; ++m) { const size_t off = (size_t)(row0 + ai * HALF + m * 16) * 1024 + col0;
#pragma unroll
                for (int bj = 0; bj < 2; ++bj) {
                    if (BASE_F32) { bs[m][bj][0] = *(const f32x4*)((const float*)base + off + bj * HALF); bs[m][bj][1] = *(const f32x4*)((const float*)base + off + bj * HALF + 4); }
                    else { const u32x4 w = *(const u32x4*)((const bf16_t*)base + off + bj * HALF);
                        bs[m][bj][0] = (f32x4){__builtin_bit_cast(float, w.x << 16), __builtin_bit_cast(float, w.x & 0xffff0000u), __builtin_bit_cast(float, w.y << 16), __builtin_bit_cast(float, w.y & 0xffff0000u)};
                        bs[m][bj][1] = (f32x4){__builtin_bit_cast(float, w.z << 16), __builtin_bit_cast(float, w.z & 0xffff0000u), __builtin_bit_cast(float, w.w << 16), __builtin_bit_cast(float, w.w & 0xffff0000u)}; } } }
#pragma unroll
            for (int m = 0; m < 4; ++m) { const size_t off = (size_t)(row0 + ai * HALF + m * 16) * 1024 + col0;
#pragma unroll
                for (int bj = 0; bj < 2; ++bj) { const f32x4 v0 = bs[m][bj][0] + gv[bj][0] * acc[ai][bj][m][0], v1 = bs[m][bj][1] + gv[bj][1] * acc[ai][bj][m][1];
                    u32x4 w; w.x = cvt_pk_bf16(v0[0], v0[1]); w.y = cvt_pk_bf16(v0[2], v0[3]); w.z = cvt_pk_bf16(v1[0], v1[1]); w.w = cvt_pk_bf16(v1[2], v1[3]);
                    *(u32x4*)(out + off + bj * HALF) = w; } }
            asm volatile("" ::: "memory"); }
    }
};
template <class Epi, class Sched, bool ALIGN_EPI = false, bool SP2 = false>
__device__ __forceinline__ void gemm_phase(PG8_LAS unsigned char* lds, const Gemm g, const Sched& S, const Epi& E) {
    const int tid = threadIdx.x, wid = __builtin_amdgcn_readfirstlane(tid >> 6), lane = tid & 63, wr = wid >> 2, wc = wid & 3, fr = lane & 15, fq = lane >> 4;
    const int K = g.K, nt = K / BK;
    unsigned voffA[2], voffB[2];
#pragma unroll
    for (int i = 0; i < 2; ++i) { int R, C; stage_rc(tid * 16 + i * 8192, R, C); const int Rb = Epi::PERM ? ((R & ~31) + perm32(R & 31)) : R;
        voffA[i] = (unsigned)(R * K + C) * 2u; voffB[i] = (unsigned)(Rb * K + C) * 2u; }
    const size_t kstep = (size_t)(BK * 2);
    const size_t hstep = (size_t)HALF * K * 2;
    const size_t tstep = 2 * hstep;
    const unsigned ldsw = (unsigned)wid * 1024u;
    const int aoff = lds_byte(wr * 64 + fr, fq * 8), boff = lds_byte(wc * 32 + fr, fq * 8);
#define PG8_SA(b, h) (((b) * 2 + (h)) * HTB)
#define PG8_SB(b, h) ((4 + (b) * 2 + (h)) * HTB)
#define PG8_STAGE(bufoff, gbase, voff) do { _Pragma("unroll") for (int _i = 0; _i < 2; ++_i) \
        __builtin_amdgcn_global_load_lds((const unsigned*)((const char*)(gbase) + (voff)[_i]), (PG8_LAS unsigned*)(lds + (bufoff) + ldsw + _i * 8192), 16, 0, 0); } while (0)
#define PG8_LDA(dst, b, h) do { _Pragma("unroll") for (int m = 0; m < 4; ++m) _Pragma("unroll") for (int k = 0; k < 2; ++k) dst[m][k] = *(const PG8_LAS bf16x8*)(lds + PG8_SA(b, h) + aoff + m * 2048 + k * 1024); } while (0)
#define PG8_LDB(dst, b, h) do { _Pragma("unroll") for (int n = 0; n < 2; ++n) _Pragma("unroll") for (int k = 0; k < 2; ++k) dst[n][k] = *(const PG8_LAS bf16x8*)(lds + PG8_SB(b, h) + boff + n * 2048 + k * 1024); } while (0)
#define PG8_MMA(ai, bj, At, Bt) do { __builtin_amdgcn_s_setprio(1); _Pragma("unroll") for (int m = 0; m < 4; ++m) _Pragma("unroll") for (int n = 0; n < 2; ++n) _Pragma("unroll") for (int k = 0; k < 2; ++k) \
        acc[ai][bj][m][n] = __builtin_amdgcn_mfma_f32_16x16x32_bf16(Bt[n][k], At[m][k], acc[ai][bj][m][n], 0, 0, 0); __builtin_amdgcn_s_setprio(0); } while (0)
#define PG8_WAIT_V(n) asm volatile("s_waitcnt vmcnt(" #n ")" ::: "memory")
#define PG8_WAIT_L(n) asm volatile("s_waitcnt lgkmcnt(" #n ")" ::: "memory")
#define PG8_BAR __builtin_amdgcn_s_barrier()
#define PG8_SCHED __builtin_amdgcn_sched_barrier(0)
    Unit cur, nxt; int ui = 0;
    if (!S.next(0, cur)) return;
    f32x4 acc[2][2][4][2];
#pragma unroll
    for (int a = 0; a < 2; ++a)
#pragma unroll
        for (int b = 0; b < 2; ++b)
#pragma unroll
            for (int m = 0; m < 4; ++m)
#pragma unroll
                for (int n = 0; n < 2; ++n) acc[a][b][m][n] = (f32x4){0.f, 0.f, 0.f, 0.f};
    bf16x8 At[4][2], B0[2][2], B1[2][2];
    const char* cA = (const char*)g.A + (size_t)cur.pm * tstep; const char* cB = (const char*)g.Bt + (size_t)cur.pn * tstep;
    S.a_ready(cur);
    if constexpr (SP2) {
        PG8_STAGE(PG8_SB(0, 0), cB, voffB); PG8_STAGE(PG8_SB(0, 1), cB + hstep, voffB); PG8_STAGE(PG8_SA(0, 0), cA, voffA); PG8_STAGE(PG8_SA(0, 1), cA + hstep, voffA);
        if (wr == 1) PG8_BAR;
        PG8_WAIT_V(2); PG8_BAR;
        PG8_STAGE(PG8_SB(1, 0), cB + kstep, voffB); PG8_STAGE(PG8_SA(1, 0), cA + kstep, voffA); PG8_STAGE(PG8_SB(1, 1), cB + hstep + kstep, voffB);
        PG8_WAIT_V(6); PG8_BAR;
    } else {
        PG8_STAGE(PG8_SB(0, 0), cB, voffB); PG8_STAGE(PG8_SA(0, 0), cA, voffA); PG8_STAGE(PG8_SB(0, 1), cB + hstep, voffB); PG8_STAGE(PG8_SA(0, 1), cA + hstep, voffA);
        if (wr == 1) PG8_BAR;
        PG8_WAIT_V(4); PG8_BAR;
        PG8_STAGE(PG8_SB(1, 0), cB + kstep, voffB); PG8_STAGE(PG8_SA(1, 0), cA + kstep, voffA); PG8_STAGE(PG8_SB(1, 1), cB + hstep + kstep, voffB);
        PG8_WAIT_V(6); PG8_BAR;
    }
    for (;;) {
        const bool has_next = S.next(ui + 1, nxt);
        const char* nA = has_next ? (const char*)g.A + (size_t)nxt.pm * tstep : cA; const char* nB = has_next ? (const char*)g.Bt + (size_t)nxt.pn * tstep : cB;
        for (int t = 0; t < nt; t += 2) {
            const bool last = (t == nt - 2);
            const char* a1 = cA + (size_t)(t + 1) * kstep;
            const char* a2 = last ? nA : cA + (size_t)(t + 2) * kstep; const char* b2 = last ? nB : cB + (size_t)(t + 2) * kstep;
            const char* a3 = a2 + kstep; const char* b3 = b2 + kstep;
            if (last && has_next) S.a_ready(nxt);
            if constexpr (SP2) {
            PG8_LDB(B0, 0, 0); PG8_LDB(B1, 0, 1); PG8_SCHED; PG8_LDA(At, 0, 0); PG8_STAGE(PG8_SA(1, 1), a1 + hstep, voffA);
            PG8_WAIT_V(8); PG8_WAIT_L(0); PG8_BAR; PG8_MMA(0, 0, At, B0); PG8_MMA(0, 1, At, B1); PG8_BAR; PG8_SCHED;
            PG8_LDA(At, 0, 1); PG8_STAGE(PG8_SB(0, 0), b2, voffB); PG8_STAGE(PG8_SB(0, 1), b2 + hstep, voffB); PG8_STAGE(PG8_SA(0, 0), a2, voffA);
            PG8_WAIT_V(8); PG8_WAIT_L(0); PG8_BAR; PG8_MMA(1, 0, At, B0); PG8_MMA(1, 1, At, B1); PG8_BAR; PG8_SCHED;
            PG8_LDB(B0, 1, 0); PG8_LDB(B1, 1, 1); PG8_SCHED; PG8_LDA(At, 1, 0); PG8_STAGE(PG8_SA(0, 1), a2 + hstep, voffA);
            PG8_WAIT_V(8); PG8_WAIT_L(0); PG8_BAR; PG8_MMA(0, 0, At, B0); PG8_MMA(0, 1, At, B1); PG8_BAR; PG8_SCHED;
            PG8_LDA(At, 1, 1); PG8_STAGE(PG8_SB(1, 0), b3, voffB); PG8_STAGE(PG8_SB(1, 1), b3 + hstep, voffB); PG8_STAGE(PG8_SA(1, 0), a3, voffA);
            PG8_WAIT_V(8); PG8_WAIT_L(0); PG8_BAR; PG8_MMA(1, 0, At, B0); PG8_MMA(1, 1, At, B1); PG8_BAR; PG8_SCHED;
            } else {
            PG8_LDB(B0, 0, 0); PG8_SCHED; PG8_LDA(At, 0, 0); PG8_STAGE(PG8_SA(1, 1), a1 + hstep, voffA);
            PG8_WAIT_L(8); PG8_BAR; PG8_WAIT_L(0); PG8_MMA(0, 0, At, B0); PG8_BAR; PG8_SCHED;
            PG8_LDB(B1, 0, 1); PG8_STAGE(PG8_SB(0, 0), b2, voffB);
            PG8_BAR; PG8_WAIT_L(0); PG8_MMA(0, 1, At, B1); PG8_BAR;
            PG8_LDA(At, 0, 1); PG8_STAGE(PG8_SA(0, 0), a2, voffA);
            PG8_BAR; PG8_WAIT_L(0); PG8_MMA(1, 0, At, B0); PG8_BAR; PG8_SCHED;
            PG8_STAGE(PG8_SB(0, 1), b2 + hstep, voffB);
            PG8_WAIT_V(6); PG8_BAR; PG8_MMA(1, 1, At, B1); PG8_BAR;
            PG8_LDB(B0, 1, 0); PG8_SCHED; PG8_LDA(At, 1, 0); PG8_STAGE(PG8_SA(0, 1), a2 + hstep, voffA);
            PG8_WAIT_L(8); PG8_BAR; PG8_WAIT_L(0); PG8_MMA(0, 0, At, B0); PG8_BAR; PG8_SCHED;
            PG8_LDB(B1, 1, 1); PG8_STAGE(PG8_SB(1, 0), b3, voffB);
            PG8_BAR; PG8_WAIT_L(0); PG8_MMA(0, 1, At, B1); PG8_BAR;
            PG8_LDA(At, 1, 1); PG8_STAGE(PG8_SA(1, 0), a3, voffA);
            PG8_BAR; PG8_WAIT_L(0); PG8_MMA(1, 0, At, B0); PG8_BAR; PG8_SCHED;
            PG8_STAGE(PG8_SB(1, 1), b3 + hstep, voffB);
            PG8_WAIT_V(6); PG8_BAR; PG8_MMA(1, 1, At, B1); PG8_BAR;
            }
        }
        if constexpr (ALIGN_EPI) { if (wr == 0) PG8_BAR; }
        if constexpr (!Epi::AFTER_DRAIN) { E(acc, cur, wr, wc, fr, fq); S.done(cur); }
        if (!has_next) break;
#pragma unroll
        for (int a = 0; a < 2; ++a)
#pragma unroll
            for (int b = 0; b < 2; ++b)
#pragma unroll
                for (int m = 0; m < 4; ++m)
#pragma unroll
                    for (int n = 0; n < 2; ++n) acc[a][b][m][n] = (f32x4){0.f, 0.f, 0.f, 0.f};
        cur = nxt; cA = nA; cB = nB; ++ui;
        if constexpr (ALIGN_EPI) { if (wr == 1) PG8_BAR; }
    }
    PG8_WAIT_V(0);
    if constexpr (!ALIGN_EPI) { if (wr == 0) PG8_BAR; }
    PG8_BAR;
    if constexpr (Epi::AFTER_DRAIN) { E.fused(acc, cur, wr, wc, fr, fq, lds, wid, lane); S.done(cur); }
#undef PG8_SA
#undef PG8_SB
#undef PG8_STAGE
#undef PG8_LDA
#undef PG8_LDB
#undef PG8_MMA
#undef PG8_WAIT_V
#undef PG8_WAIT_L
#undef PG8_BAR
#undef PG8_SCHED
}
}
namespace mk {
#define LAS __attribute__((address_space(3)))
typedef unsigned short bf16;
typedef short bf16x8 __attribute__((ext_vector_type(8)));
typedef short s16x4 __attribute__((ext_vector_type(4)));
typedef float f32x4 __attribute__((ext_vector_type(4)));
typedef unsigned v4u __attribute__((ext_vector_type(4)));
typedef unsigned v2u __attribute__((ext_vector_type(2)));

constexpr int BATCH = 8, SEQ = 4096, D = 1024, M = BATCH * SEQ, FF = 4096, NIN0 = 3584, NIN1 = 2048;
constexpr int NT = 512;
constexpr float EPS = 1e-6f;
constexpr size_t MiB = 1u << 20;
constexpr size_t WS_MODP = 440 * MiB;
constexpr int NCH = 16;
constexpr size_t WS_MODF = 3 * MiB;
constexpr size_t WS_DEC = 4 * MiB;
constexpr size_t WS_BAR = 5 * MiB, BAR_ZERO_BYTES = 32768;
constexpr int MISC_OFF = 131072;
constexpr size_t WS_WIN0 = 8 * MiB, WS_WOUT0 = 15 * MiB, WS_WIN1 = 17 * MiB, WS_WOUT1 = 21 * MiB, WS_WFF1 = 23 * MiB, WS_WFF2 = 39 * MiB;
constexpr size_t WS_H = 56 * MiB;
constexpr size_t WS_P = 120 * MiB;
constexpr size_t WS_S = 376 * MiB;
constexpr size_t WS_XR = 376 * MiB;
constexpr size_t WS_END = 448 * MiB;
constexpr int LDS_BYTES = 147456;
constexpr int NPH = 18;

struct Args { const float* in[22]; float* out; unsigned char* ws; int ph_lo, ph_hi; };

__device__ __forceinline__ float bf2f(unsigned u) { return __builtin_bit_cast(float, u << 16); }
__device__ __forceinline__ float bflo(unsigned w) { return __builtin_bit_cast(float, w << 16); }
__device__ __forceinline__ float bfhi(unsigned w) { return __builtin_bit_cast(float, w & 0xffff0000u); }
typedef float f32x2_t __attribute__((ext_vector_type(2)));
typedef __bf16 bf16x2_t __attribute__((ext_vector_type(2)));
__device__ __forceinline__ unsigned pk2(float lo, float hi) { const f32x2_t v = {lo, hi}; const bf16x2_t b = __builtin_convertvector(v, bf16x2_t); return __builtin_bit_cast(unsigned, b); }
__device__ __forceinline__ unsigned short f2bf(float f) { return __builtin_bit_cast(unsigned short, (__bf16)f); }
__device__ __forceinline__ float wave_sum(float v) {
#pragma unroll
    for (int o = 1; o < 64; o <<= 1) v += __shfl_xor(v, o);
    return v;
}
__device__ __forceinline__ float sigmoidf_(float x) { return __builtin_amdgcn_rcpf(1.0f + __expf(-x)); }
__device__ __forceinline__ float siluf_(float x) { return x * sigmoidf_(x); }

__device__ __forceinline__ bf16x8 rowfrag(LAS const unsigned char* T, int pitchB, int r0, int k0, int fr, int fq) {
    return *(LAS const bf16x8*)(T + (r0 + fr) * pitchB + (k0 + 8 * fq) * 2);
}
typedef short v4i16_t __attribute__((ext_vector_type(4)));
__device__ __forceinline__ bf16x8 trfrag(LAS const unsigned char* T, int pitchB, int k0, int n0, int lane) {
    const int g = lane >> 4, q = (lane & 15) >> 2, pp = lane & 3;
    LAS const unsigned char* p0 = T + (k0 + 8 * g + q) * pitchB + (n0 + 4 * pp) * 2;
    const v4i16_t a = __builtin_amdgcn_ds_read_tr16_b64_v4i16((LAS v4i16_t*)p0);
    const v4i16_t b = __builtin_amdgcn_ds_read_tr16_b64_v4i16((LAS v4i16_t*)(p0 + 4 * pitchB));
    return (bf16x8){a.x, a.y, a.z, a.w, b.x, b.y, b.z, b.w};
}
#define MFMA16(a, b, c) __builtin_amdgcn_mfma_f32_16x16x32_bf16((a), (b), (c), 0, 0, 0)

#define XB_TMO      128
#define XB_XCNT(j)  (256  + 64 * (j))
#define XB_XSUB(j)  (1280 + 64 * (j))
#define XB_XGEN(j)  (2304 + 64 * (j))
#define XB_TOP      3328
#define XB_TOPGEN   3392
#define XCD_BAR_WORDS 3456
#define XB_SPIN_CAP (1u << 18)

__device__ __forceinline__ unsigned xb_ld(unsigned* p)              { return __hip_atomic_load(p, __ATOMIC_RELAXED, __HIP_MEMORY_SCOPE_AGENT); }
__device__ __forceinline__ unsigned xb_add(unsigned* p, unsigned v) { return __hip_atomic_fetch_add(p, v, __ATOMIC_RELAXED, __HIP_MEMORY_SCOPE_AGENT); }
__device__ __forceinline__ unsigned xb_xcc_id() { return (unsigned)__builtin_amdgcn_s_getreg((3 << 11) | 20) & 0xFu; }
#define XB_SPIN(cond, bar) do { unsigned _sp = 0; while (cond) { __builtin_amdgcn_s_sleep(1); \
    if ((++_sp & 255u) == 0u) { if (xb_ld(&(bar)[XB_TMO])) break; if (_sp > XB_SPIN_CAP) { atomicAdd(&(bar)[XB_TMO], 1u); break; } } } } while (0)

struct XcdBarrier {
    unsigned* bar; unsigned x;
    volatile LAS unsigned* st;
};

__device__ __forceinline__ XcdBarrier xcd_barrier_post(unsigned* bar, volatile LAS unsigned* st) {
    XcdBarrier b; b.bar = bar; b.x = xb_xcc_id(); b.st = st;
    if (threadIdx.x == 0) (void)xb_add(&bar[XB_XCNT(b.x)], 1u);
    return b;
}
__device__ __forceinline__ void xcd_barrier_complete(unsigned* bar, unsigned x, unsigned& nloc, unsigned& nx) {
    const unsigned G = gridDim.x * gridDim.y * gridDim.z;
    unsigned sum, cnt, mine, sp = 0u;
    for (;;) {
        sum = 0u; cnt = 0u; mine = 0u;
#pragma unroll
        for (unsigned j = 0; j < 16; ++j) { const unsigned c = xb_ld(&bar[XB_XCNT(j)]); sum += c; cnt += (c > 0u) ? 1u : 0u; mine = (j == x) ? c : mine; }
        if (sum == G) break;
        __builtin_amdgcn_s_sleep(1);
        if ((++sp & 255u) == 0u) { if (xb_ld(&bar[XB_TMO])) break; if (sp > XB_SPIN_CAP) { atomicAdd(&bar[XB_TMO], 1u); break; } }
    }
    nloc = mine > 0u ? mine : 1u; nx = cnt > 0u ? cnt : 1u;
}

__device__ __forceinline__ void xcd_barrier(const XcdBarrier& b) {
    asm volatile("s_waitcnt vmcnt(0)" ::: "memory");
    __syncthreads();
    if (threadIdx.x == 0) {
        unsigned* bar = b.bar;
        __builtin_amdgcn_s_waitcnt(0);
        unsigned nloc = b.st[0], nx = b.st[1];
        if (nloc == 0u) { xcd_barrier_complete(bar, b.x, nloc, nx); b.st[0] = nloc; b.st[1] = nx; }
        const unsigned old = xb_add(&bar[XB_XSUB(b.x)], 1u);
        const unsigned gen = old / nloc;
        if (old + 1u == (gen + 1u) * nloc) {
            __builtin_amdgcn_fence(__ATOMIC_RELEASE, "agent");
            asm volatile("s_waitcnt vmcnt(0)" ::: "memory");
            const unsigned og = xb_add(&bar[XB_TOP], 1u);
            const unsigned tg = og / nx;
            if (og + 1u == (tg + 1u) * nx) xb_add(&bar[XB_TOPGEN], 1u);
            else XB_SPIN(xb_ld(&bar[XB_TOPGEN]) == tg, bar);
            __builtin_amdgcn_fence(__ATOMIC_ACQUIRE, "agent");
            xb_add(&bar[XB_XGEN(b.x)], 1u);
            asm volatile("s_waitcnt vmcnt(0)" ::: "memory");
        } else {
            XB_SPIN(xb_ld(&bar[XB_XGEN(b.x)]) == gen, bar);
            __builtin_amdgcn_fence(__ATOMIC_ACQUIRE, "agent");
            asm volatile("s_waitcnt vmcnt(0)" ::: "memory");
        }
    }
    __syncthreads();
}

struct Grp { int NG, GS, grp, gi; };
#define GB_RANK(j) (4096 + 64 * (j))
#define GB_SUB(j)  (5120 + 64 * (j))
#define GB_GEN(j)  (6144 + 64 * (j))
__device__ __forceinline__ Grp make_grp(volatile LAS unsigned* MISC) {
    Grp g; g.GS = __builtin_amdgcn_readfirstlane((int)MISC[8]); g.NG = __builtin_amdgcn_readfirstlane((int)MISC[9]);
    g.grp = __builtin_amdgcn_readfirstlane((int)MISC[10]); g.gi = __builtin_amdgcn_readfirstlane((int)MISC[11]);
    if (g.GS < 1) g.GS = 1; if (g.NG < 1) g.NG = 1;
    return g; }
__device__ __forceinline__ bool grp_item(const Grp& g, int L, int per_batch, int& b, int& j) { b = g.grp + (L / per_batch) * g.NG; j = L % per_batch; return b < 8; }
__device__ __forceinline__ void grp_barrier(unsigned* bar, unsigned x, const Grp& g) {
    asm volatile("s_waitcnt vmcnt(0)" ::: "memory");
    __syncthreads();
    if (threadIdx.x == 0) {
        const unsigned nloc = (unsigned)g.GS;
        const unsigned old = xb_add(&bar[GB_SUB(x)], 1u), gen = old / nloc;
        if (old + 1u == (gen + 1u) * nloc) xb_add(&bar[GB_GEN(x)], 1u);
        else { unsigned sp = 0u; while (xb_ld(&bar[GB_GEN(x)]) == gen) { __builtin_amdgcn_s_sleep(1); if (++sp > (1u << 22)) break; } }
        __builtin_amdgcn_fence(__ATOMIC_ACQUIRE, "agent");
        asm volatile("s_waitcnt vmcnt(0)" ::: "memory");
    }
    __syncthreads();
}
struct GroupOrder {
    int nN, nU, NG, GS, grp, gi;
    __device__ void init(int N, const Grp& g) { nN = N / 256; nU = 16 * nN; NG = g.NG; GS = g.GS; grp = g.grp; gi = g.gi; }
    __device__ bool next(int i, pg8::Unit& u) const {
        const int L = i * GS + gi, b = grp + (L / nU) * NG, w = L % nU; if (b >= 8) return false;
        const int g2 = w / (8 * nN), r = w % (8 * nN);
        u.pm = 16 * b + 8 * g2 + (r % 8); u.pn = r / 8; return true;
    }
    __device__ __forceinline__ void a_ready(const pg8::Unit&) const {}
    __device__ __forceinline__ void done(const pg8::Unit&) const {}
};

__device__ __forceinline__ void transpose_item(const float* W, int K, int N, bf16* WT, LAS float* scr, int item, int lane) {
    const int nblk = N / 32, kb = item / nblk, nb = item % nblk, k0 = 64 * kb, n0 = 32 * nb;
    float tv[32];
#pragma unroll
    for (int i = 0; i < 32; ++i) tv[i] = W[(size_t)(k0 + 2 * i + (lane >> 5)) * N + n0 + (lane & 31)];
#pragma unroll
    for (int i = 0; i < 32; ++i) scr[(2 * i + (lane >> 5)) * 33 + (lane & 31)] = tv[i];
    asm volatile("s_waitcnt lgkmcnt(0)" ::: "memory");
    const int c = lane & 7;
#pragma unroll
    for (int j = 0; j < 4; ++j) { const int n = (lane >> 3) + 8 * j; const LAS float* s = scr + (8 * c) * 33 + n;
        v4u o; o.x = pk2(s[0 * 33], s[1 * 33]); o.y = pk2(s[2 * 33], s[3 * 33]); o.z = pk2(s[4 * 33], s[5 * 33]); o.w = pk2(s[6 * 33], s[7 * 33]);
        *(v4u*)(WT + (size_t)(n0 + n) * K + k0 + 8 * c) = o; }
    asm volatile("s_waitcnt lgkmcnt(0)" ::: "memory");
}
__device__ __forceinline__ void phase_prologue(const Args& a, LAS unsigned char* lds, int tid, int lane, int wave, int G) {
    LAS float* sc = (LAS float*)lds;
    const float* c = a.in[1];
    for (int i = tid; i < 8192; i += NT) sc[i] = siluf_(c[i]);
    __syncthreads();
    float* modp = (float*)(a.ws + WS_MODP);
    for (int it = blockIdx.x; it < 2 * NCH * 12; it += G) {
        const int l = it / (NCH * 12), r = it % (NCH * 12), ch = r / 12, eb = r % 12, e = eb * 512 + tid;
        const float* w = a.in[2] + ((size_t)l * 1024 + ch * 64) * 6144 + e;
        float acc0 = 0.f, acc1 = 0.f, acc2 = 0.f, acc3 = 0.f, acc4 = 0.f, acc5 = 0.f, acc6 = 0.f, acc7 = 0.f;
        const LAS float* s = sc + ch * 64;
#pragma unroll 16
        for (int d = 0; d < 64; ++d) { const float wv = w[(size_t)d * 6144];
            acc0 += s[d] * wv; acc1 += s[1024 + d] * wv; acc2 += s[2048 + d] * wv; acc3 += s[3072 + d] * wv;
            acc4 += s[4096 + d] * wv; acc5 += s[5120 + d] * wv; acc6 += s[6144 + d] * wv; acc7 += s[7168 + d] * wv; }
        float* o = modp + (size_t)((ch * 2 + l) * 8) * 6144 + e;
        o[0] = acc0; o[6144] = acc1; o[2 * 6144] = acc2; o[3 * 6144] = acc3; o[4 * 6144] = acc4; o[5 * 6144] = acc5; o[6 * 6144] = acc6; o[7 * 6144] = acc7;
    }
    __syncthreads();
    LAS float* scr = (LAS float*)(lds + 32768 + wave * 8704);
    const int gw = blockIdx.x * 8 + wave, NGW = G * 8;
    constexpr int I0 = 1792, I1 = 512, I2 = 1024, I3 = 512, I4 = 2048, I5 = 2048;
    constexpr int NITEMS = I0 + I1 + I2 + I3 + 2 * I4 + 2 * I5;
    for (int it = gw; it < NITEMS; it += NGW) {
        int r = it;
        if (r < I0) { transpose_item(a.in[6], 1024, NIN0, (bf16*)(a.ws + WS_WIN0), scr, r, lane); continue; } r -= I0;
        if (r < I1) { transpose_item(a.in[11], 1024, 1024, (bf16*)(a.ws + WS_WOUT0), scr, r, lane); continue; } r -= I1;
        if (r < I2) { transpose_item(a.in[12], 1024, NIN1, (bf16*)(a.ws + WS_WIN1), scr, r, lane); continue; } r -= I2;
        if (r < I3) { transpose_item(a.in[18], 1024, 1024, (bf16*)(a.ws + WS_WOUT1), scr, r, lane); continue; } r -= I3;
        if (r < 2 * I4) { const int l = r / I4; transpose_item(a.in[19] + (size_t)l * 1024 * 4096, 1024, 4096, (bf16*)(a.ws + WS_WFF1) + (size_t)l * 4096 * 1024, scr, r % I4, lane); continue; } r -= 2 * I4;
        { const int l = r / I5; transpose_item(a.in[20] + (size_t)l * 4096 * 1024, 4096, 1024, (bf16*)(a.ws + WS_WFF2) + (size_t)l * 1024 * 4096, scr, r % I5, lane); }
    }
}

template <bool PARTIAL>
__device__ __forceinline__ float modval(const Args& a, int l, int b, int idx) {
    if (PARTIAL) {
        const float* modp = (const float*)(a.ws + WS_MODP);
        float s = a.in[3][l * 6144 + idx];
#pragma unroll
        for (int ch = 0; ch < NCH; ++ch) s += modp[(size_t)((ch * 2 + l) * 8 + b) * 6144 + idx];
        return s;
    } else {
        return ((const float*)(a.ws + WS_MODF))[(size_t)(l * 8 + b) * 6144 + idx];
    }
}
template <bool PARTIAL>
__device__ __forceinline__ void phase_norm(const Args& a, LAS unsigned char* lds, const float* xsrc, const float* gvec, int l, int jshift, int jscale, int tid, int lane, int wave, const Grp& gr) {
    bf16* h = (bf16*)(a.ws + WS_H);
    if (PARTIAL) {
        float* modf = (float*)(a.ws + WS_MODF);
        for (int L = gr.gi * NT + tid;; L += gr.GS * NT) { int bb, i; if (!grp_item(gr, L, 2 * 6144, bb, i)) break; const int ll = i / 6144, idx = i % 6144; modf[(size_t)(ll * 8 + bb) * 6144 + idx] = modval<true>(a, ll, bb, idx); }
    }
    for (int L = gr.gi;; L += gr.GS) {
        int b, j_; if (!grp_item(gr, L, 32, b, j_)) break; const int blk = b * 32 + j_;
        f32x4 gs[4], sh[4];
        if (PARTIAL) {
            LAS float* mv = (LAS float*)lds;
            __syncthreads();
#pragma unroll
            for (int i = 0; i < 4; ++i) { const int e = tid + NT * i; mv[e] = modval<true>(a, l, b, (e < 1024 ? jscale * 1024 + e : jshift * 1024 + e - 1024)); }
            __syncthreads();
#pragma unroll
            for (int j = 0; j < 4; ++j) { const int col = lane * 4 + 256 * j;
#pragma unroll
                for (int i = 0; i < 4; ++i) { gs[j][i] = gvec[col + i] * (1.0f + mv[col + i]); sh[j][i] = mv[1024 + col + i]; } }
        } else {
#pragma unroll
        for (int j = 0; j < 4; ++j) { const int col = lane * 4 + 256 * j;
#pragma unroll
            for (int i = 0; i < 4; ++i) { gs[j][i] = gvec[col + i] * (1.0f + modval<PARTIAL>(a, l, b, jscale * 1024 + col + i)); sh[j][i] = modval<PARTIAL>(a, l, b, jshift * 1024 + col + i); } }
        }
        const float* xb = xsrc + (size_t)blk * 128 * 1024;
        f32x4 nx[4];
#pragma unroll
        for (int j = 0; j < 4; ++j) nx[j] = ((const f32x4*)(xb + (size_t)wave * 1024) + lane)[64 * j];
        for (int r = wave; r < 128; r += 8) {
            const size_t m = (size_t)blk * 128 + r;
            f32x4 v[4]; float ss = 0.f;
#pragma unroll
            for (int j = 0; j < 4; ++j) { v[j] = nx[j]; ss += (v[j].x * v[j].x + v[j].y * v[j].y) + (v[j].z * v[j].z + v[j].w * v[j].w); }
            if (r + 8 < 128) {
#pragma unroll
                for (int j = 0; j < 4; ++j) nx[j] = ((const f32x4*)(xb + (size_t)(r + 8) * 1024) + lane)[64 * j];
            }
            const float inv = 1.0f / sqrtf(wave_sum(ss) * (1.0f / 1024.0f) + EPS);
            v2u* o8 = (v2u*)(h + m * 1024) + lane;
#pragma unroll
            for (int j = 0; j < 4; ++j) { const f32x4 o = v[j] * inv * gs[j] + sh[j]; v2u w; w.x = pk2(o.x, o.y); w.y = pk2(o.z, o.w); o8[64 * j] = w; }
        }
    }
}
__device__ __forceinline__ void unpack8(const v4u w, float (&x)[16], int o) {
#pragma unroll
    for (int i = 0; i < 4; ++i) { x[o + 2 * i] = bflo(w[i]); x[o + 2 * i + 1] = bfhi(w[i]); }
}
__device__ __forceinline__ void phase_norm_bf(const Args& a, const float* gvec, int l, int jshift, int jscale, int tid, int lane, int wave, const Grp& gr) {
    bf16* h = (bf16*)(a.ws + WS_H); const bf16* xr = (const bf16*)(a.ws + WS_XR);
    for (int L = gr.gi;; L += gr.GS) {
        int b, j_; if (!grp_item(gr, L, 32, b, j_)) break; const int blk = b * 32 + j_;
        float gs[16], sh[16];
#pragma unroll
        for (int j = 0; j < 2; ++j)
#pragma unroll
            for (int i = 0; i < 8; ++i) { const int col = lane * 8 + 512 * j + i; gs[8 * j + i] = gvec[col] * (1.0f + modval<false>(a, l, b, jscale * 1024 + col)); sh[8 * j + i] = modval<false>(a, l, b, jshift * 1024 + col); }
        const bf16* xb = xr + (size_t)blk * 128 * 1024 + lane * 8;
        v4u n0 = *(const v4u*)(xb + (size_t)wave * 1024), n1 = *(const v4u*)(xb + (size_t)wave * 1024 + 512);
        for (int r = wave; r < 128; r += 8) {
            float x[16]; unpack8(n0, x, 0); unpack8(n1, x, 8);
            if (r + 8 < 128) { n0 = *(const v4u*)(xb + (size_t)(r + 8) * 1024); n1 = *(const v4u*)(xb + (size_t)(r + 8) * 1024 + 512); }
            float ss = 0.f;
#pragma unroll
            for (int i = 0; i < 16; ++i) ss += x[i] * x[i];
            const float inv = 1.0f / sqrtf(wave_sum(ss) * (1.0f / 1024.0f) + EPS);
            bf16* ho = h + ((size_t)blk * 128 + r) * 1024 + lane * 8;
#pragma unroll
            for (int j = 0; j < 2; ++j) { v4u w;
#pragma unroll
                for (int i = 0; i < 4; ++i) w[i] = pk2(x[8 * j + 2 * i] * inv * gs[8 * j + 2 * i] + sh[8 * j + 2 * i], x[8 * j + 2 * i + 1] * inv * gs[8 * j + 2 * i + 1] + sh[8 * j + 2 * i + 1]);
                *(v4u*)(ho + 512 * j) = w; }
        }
    }
}
__device__ __forceinline__ void phase_final_norm(const Args& a, int lane, int wave, const Grp& gr) {
    const float* g = a.in[21]; const bf16* xr = (const bf16*)(a.ws + WS_XR);
    float gs[16];
#pragma unroll
    for (int j = 0; j < 2; ++j)
#pragma unroll
        for (int i = 0; i < 8; ++i) gs[8 * j + i] = g[lane * 8 + 512 * j + i];
    for (int L = gr.gi;; L += gr.GS) {
        int b, j_; if (!grp_item(gr, L, 32, b, j_)) break; const int blk = b * 32 + j_;
        const bf16* xb = xr + (size_t)blk * 128 * 1024 + lane * 8;
        v4u n0 = *(const v4u*)(xb + (size_t)wave * 1024), n1 = *(const v4u*)(xb + (size_t)wave * 1024 + 512);
        for (int r = wave; r < 128; r += 8) {
            float x[16]; unpack8(n0, x, 0); unpack8(n1, x, 8);
            if (r + 8 < 128) { n0 = *(const v4u*)(xb + (size_t)(r + 8) * 1024); n1 = *(const v4u*)(xb + (size_t)(r + 8) * 1024 + 512); }
            float ss = 0.f;
#pragma unroll
            for (int i = 0; i < 16; ++i) ss += x[i] * x[i];
            const float inv = 1.0f / sqrtf(wave_sum(ss) * (1.0f / 1024.0f) + EPS);
            float* o = a.out + ((size_t)blk * 128 + r) * 1024 + lane * 8;
#pragma unroll
            for (int j = 0; j < 2; ++j) {
                *(f32x4*)(o + 512 * j) = (f32x4){x[8 * j] * inv * gs[8 * j], x[8 * j + 1] * inv * gs[8 * j + 1], x[8 * j + 2] * inv * gs[8 * j + 2], x[8 * j + 3] * inv * gs[8 * j + 3]};
                *(f32x4*)(o + 512 * j + 4) = (f32x4){x[8 * j + 4] * inv * gs[8 * j + 4], x[8 * j + 5] * inv * gs[8 * j + 5], x[8 * j + 6] * inv * gs[8 * j + 6], x[8 * j + 7] * inv * gs[8 * j + 7]};
            }
        }
    }
}

__device__ __forceinline__ void conv_mixer(const Args& a, int tid, const Grp& gr) {
    const bf16* p = (const bf16*)(a.ws + WS_P); bf16* y = (bf16*)(a.ws + WS_H);
    const float* cw = a.in[7]; const float* cb = a.in[8];
    constexpr int TSEG = 16;
    for (int L = gr.gi * NT + tid;; L += gr.GS * NT) {
        int b_, it; if (!grp_item(gr, L, (SEQ / TSEG) * 64, b_, it)) break;
        const int c0 = (it & 63) * 8, mbase = b_ * SEQ + (it >> 6) * TSEG, t0 = mbase & (SEQ - 1);
        float w0[8], w1[8], w2[8], bb[8], z1[8], z2[8];
#pragma unroll
        for (int i = 0; i < 8; ++i) { w0[i] = cw[c0 + i]; w1[i] = cw[512 + c0 + i]; w2[i] = cw[1024 + c0 + i]; bb[i] = cb[c0 + i]; z1[i] = 0.f; z2[i] = 0.f; }
        const bf16* pr = p + (size_t)mbase * NIN0 + c0;
        if (t0 >= 2) {
            const v4u c1 = *(const v4u*)(pr - (size_t)NIN0 + 512), h1 = *(const v4u*)(pr - (size_t)NIN0 + 1024), c2 = *(const v4u*)(pr - (size_t)2 * NIN0 + 512), h2 = *(const v4u*)(pr - (size_t)2 * NIN0 + 1024);
#pragma unroll
            for (int i = 0; i < 4; ++i) { z1[2 * i] = bflo(c1[i]) * bflo(h1[i]); z1[2 * i + 1] = bfhi(c1[i]) * bfhi(h1[i]); z2[2 * i] = bflo(c2[i]) * bflo(h2[i]); z2[2 * i + 1] = bfhi(c2[i]) * bfhi(h2[i]); }
        }
#pragma unroll 4
        for (int j = 0; j < TSEG; ++j) {
            const v4u cc = *(const v4u*)(pr + (size_t)j * NIN0 + 512), hh = *(const v4u*)(pr + (size_t)j * NIN0 + 1024), gb = *(const v4u*)(pr + (size_t)j * NIN0);
            float z0[8], o[8];
#pragma unroll
            for (int i = 0; i < 4; ++i) { z0[2 * i] = bflo(cc[i]) * bflo(hh[i]); z0[2 * i + 1] = bfhi(cc[i]) * bfhi(hh[i]); }
#pragma unroll
            for (int i = 0; i < 8; ++i) o[i] = bb[i] + w0[i] * z2[i] + w1[i] * z1[i] + w2[i] * z0[i];
            v4u w;
#pragma unroll
            for (int i = 0; i < 4; ++i) w[i] = pk2(bflo(gb[i]) * o[2 * i], bfhi(gb[i]) * o[2 * i + 1]);
            *(v4u*)(y + (size_t)(mbase + j) * 1024 + c0) = w;
#pragma unroll
            for (int i = 0; i < 8; ++i) { z2[i] = z1[i]; z1[i] = z0[i]; }
        }
    }
}
constexpr int HP = 272;
constexpr int HG_SEG = 0, HG_QD = 2048, HG_QR = 19456, HG_KR = 36864, HG_V = 54272, HG_S = 71680, HG_P = 106496, HG_O = 19456;
constexpr int PP = 144;
constexpr int OP = 528;
__device__ __forceinline__ void hg_cum(LAS unsigned char* lds, int tid, const unsigned short (&fraw)[16], const float (&lbl)[3], float (&cum)[16], float (&kk)[16], float& mid, float& last) {
    const int k = tid & 127, seg = tid >> 7;
    const float mx = fmaxf(lbl[0], fmaxf(lbl[1], lbl[2]));
    const float e0 = __expf(lbl[0] - mx), e1 = __expf(lbl[1] - mx), e2 = __expf(lbl[2] - mx), lb = e0 / (e0 + e1 + e2);
    float run = 0.f;
#pragma unroll
    for (int i = 0; i < 16; ++i) { const float x = bf2f(fraw[i]); const float f = lb + (1.0f - lb) * sigmoidf_(x); run += __logf(f); cum[i] = run; kk[i] = 1.0f - f; }
    LAS float* st = (LAS float*)(lds + HG_SEG);
    st[seg * 128 + k] = run;
    __syncthreads();
    const float s0 = st[k], s1 = st[128 + k], s2 = st[256 + k], s3 = st[384 + k];
    const float off = seg == 0 ? 0.f : (seg == 1 ? s0 : (seg == 2 ? s0 + s1 : s0 + s1 + s2));
    mid = s0 + s1; last = (s0 + s1) + (s2 + s3);
#pragma unroll
    for (int i = 0; i < 16; ++i) cum[i] += off;
}
__device__ __forceinline__ void hg_ld_col(unsigned short (&r)[16], const bf16* p, int m0, int col, int tid) {
    const bf16* q = p + (size_t)(m0 + (tid >> 7) * 16) * NIN0 + col + (tid & 127);
#pragma unroll
    for (int i = 0; i < 16; ++i) r[i] = q[(size_t)i * NIN0];
}
__device__ __forceinline__ void hg_ld_lb(float (&l)[3], const float* lbp, int h, int tid) { const int ch = h * 128 + (tid & 127); l[0] = lbp[ch]; l[1] = lbp[512 + ch]; l[2] = lbp[1024 + ch]; }
__device__ __forceinline__ void load_tile128(LAS unsigned char* dst, const bf16* src, size_t src_pitch, int rows, int tid) {
    for (int id = tid; id < rows * 16; id += NT) { const int r = id >> 4, c = id & 15; *(LAS v4u*)(dst + r * HP + c * 16) = *(const v4u*)(src + (size_t)r * src_pitch + c * 8); }
}
template <int N16> __device__ __forceinline__ void tile_ld(v4u (&t)[N16], const bf16* src, size_t src_pitch, int tid) {
#pragma unroll
    for (int i = 0; i < N16; ++i) { const int id = tid + NT * i, r = id >> 4, c = id & 15; t[i] = *(const v4u*)(src + (size_t)r * src_pitch + c * 8); }
}
template <int N16> __device__ __forceinline__ void tile_st(const v4u (&t)[N16], LAS unsigned char* dst, int tid) {
#pragma unroll
    for (int i = 0; i < N16; ++i) { const int id = tid + NT * i, r = id >> 4, c = id & 15; *(LAS v4u*)(dst + r * HP + c * 16) = t[i]; }
}
__device__ __forceinline__ int hg_unit(const Grp& gr, int L) { int b, j; return grp_item(gr, L, 256, b, j) ? b * 256 + j : -1; }
__device__ __forceinline__ void hg_pass_a(const Args& a, LAS unsigned char* lds, int tid, int lane, int wave, const Grp& gr) {
    const bf16* p = (const bf16*)(a.ws + WS_P);
    bf16* loc = (bf16*)a.out; float* dec = (float*)(a.ws + WS_DEC);
    unsigned short fraw[16]; float lbl[3]; v4u vt[2];
    int Lc = gr.gi, unit = hg_unit(gr, Lc);
    if (unit >= 0) { const int u0 = unit, h0 = (u0 >> 6) & 3, mm = (u0 >> 8) * SEQ + (u0 & 63) * 64;
        hg_ld_col(fraw, p, mm, 2048 + h0 * 128, tid); hg_ld_lb(lbl, a.in[9], h0, tid); tile_ld<2>(vt, p + (size_t)mm * NIN0 + 2560 + h0 * 128, NIN0, tid); }
    while (unit >= 0) {
        unsigned short nfraw[16]; float nlbl[3]; v4u nvt[2];
        Lc += gr.GS; const int nu = hg_unit(gr, Lc);
        if (nu >= 0) { const int h1 = (nu >> 6) & 3, mm = (nu >> 8) * SEQ + (nu & 63) * 64;
            hg_ld_col(nfraw, p, mm, 2048 + h1 * 128, tid); hg_ld_lb(nlbl, a.in[9], h1, tid); tile_ld<2>(nvt, p + (size_t)mm * NIN0 + 2560 + h1 * 128, NIN0, tid); }
        float cum[16], kk[16], mid, last;
        hg_cum(lds, tid, fraw, lbl, cum, kk, mid, last);
        const int k = tid & 127, seg = tid >> 7;
#pragma unroll
        for (int i = 0; i < 16; ++i) *(LAS unsigned short*)(lds + HG_KR + (seg * 16 + i) * HP + k * 2) = f2bf(kk[i] * __expf(last - cum[i]));
        if (seg == 0) dec[unit * 128 + k] = __expf(last);
        tile_st<2>(vt, lds + HG_V, tid);
        const int unit_c = unit; unit = nu;
        if (nu >= 0) {
#pragma unroll
            for (int i = 0; i < 16; ++i) fraw[i] = nfraw[i];
            lbl[0] = nlbl[0]; lbl[1] = nlbl[1]; lbl[2] = nlbl[2]; vt[0] = nvt[0]; vt[1] = nvt[1]; }
        __syncthreads();
        f32x4 acc[8];
#pragma unroll
        for (int n = 0; n < 8; ++n) acc[n] = (f32x4){0.f, 0.f, 0.f, 0.f};
#pragma unroll
        for (int ks = 0; ks < 2; ++ks) {
            const bf16x8 B = trfrag(lds + HG_KR, HP, 32 * ks, 16 * wave, lane);
#pragma unroll
            for (int n = 0; n < 8; ++n) { const bf16x8 A = trfrag(lds + HG_V, HP, 32 * ks, 16 * n, lane); acc[n] = MFMA16(A, B, acc[n]); }
        }
        const int fr = lane & 15, fq = lane >> 4;
        bf16* lo = loc + (size_t)unit_c * 16384 + (16 * wave + fr) * 128 + 4 * fq;
#pragma unroll
        for (int n = 0; n < 8; ++n) { v2u w; w.x = pk2(acc[n][0], acc[n][1]); w.y = pk2(acc[n][2], acc[n][3]); *(v2u*)(lo + 16 * n) = w; }
        __syncthreads();
    }
}
__device__ __forceinline__ void hg_pass_b(const Args& a, int tid, const Grp& gr) {
    const bf16* loc = (const bf16*)a.out; const float* dec = (const float*)(a.ws + WS_DEC); bf16* st = (bf16*)(a.ws + WS_S);
    for (int L = gr.gi * NT + tid;; L += gr.GS * NT) {
        int b_, j_; if (!grp_item(gr, L, 4 * 128 * 32, b_, j_)) break; const int idx = b_ * (4 * 128 * 32) + j_;
        const int bh = idx >> 12, k = (idx >> 5) & 127, v4 = idx & 31;
        f32x4 S = (f32x4){0.f, 0.f, 0.f, 0.f};
        const size_t e0 = (size_t)bh * 64 * 16384 + k * 128 + v4 * 4;
#pragma unroll 16
        for (int c = 0; c < 64; ++c) {
            const v2u Lw = *(const v2u*)(loc + e0 + (size_t)c * 16384); const float d = dec[(bh * 64 + c) * 128 + k];
            const f32x4 L = (f32x4){bflo(Lw.x), bfhi(Lw.x), bflo(Lw.y), bfhi(Lw.y)};
            v2u w; w.x = pk2(S.x, S.y); w.y = pk2(S.z, S.w);
            *(v2u*)(st + e0 + (size_t)c * 16384) = w;
            S = S * d + L;
        }
    }
}
__device__ __forceinline__ void hg_pass_c(const Args& a, LAS unsigned char* lds, int tid, int lane, int wave, const Grp& gr) {
    const bf16* p = (const bf16*)(a.ws + WS_P); const bf16* stg = (const bf16*)(a.ws + WS_S); bf16* y = (bf16*)(a.ws + WS_H);
    const float* gain = a.in[10];
    const int fr = lane & 15, fq = lane >> 4;
    unsigned short fraw[16], qraw[16]; float lbl[3]; v4u vt[2], stt4[4], graw[2];
#define HG_LOAD_C(U, F, Q, L, V, S, GR) do { const int h_ = ((U) >> 6) & 3, mm_ = ((U) >> 8) * SEQ + ((U) & 63) * 64; \
        hg_ld_col(F, p, mm_, 2048 + h_ * 128, tid); hg_ld_col(Q, p, mm_, 1536 + h_ * 128, tid); hg_ld_lb(L, a.in[9], h_, tid); \
        tile_ld<2>(V, p + (size_t)mm_ * NIN0 + 2560 + h_ * 128, NIN0, tid); tile_ld<4>(S, stg + (size_t)(U) * 16384, 128, tid); \
        { const bf16* gp_ = p + (size_t)(mm_ + (tid >> 3)) * NIN0 + 3072 + h_ * 128 + (tid & 7) * 16; GR[0] = *(const v4u*)gp_; GR[1] = *(const v4u*)(gp_ + 8); } } while (0)
    int Lc = gr.gi, unit = hg_unit(gr, Lc);
    if (unit >= 0) HG_LOAD_C(unit, fraw, qraw, lbl, vt, stt4, graw);
    for (; unit >= 0; ) {
        const int b = unit >> 8, h = (unit >> 6) & 3, c = unit & 63, m0 = b * SEQ + c * 64;
        unsigned short nfraw[16], nqraw[16]; float nlbl[3]; v4u nvt[2], nstt4[4], ngraw[2];
        Lc += gr.GS; const int nu = hg_unit(gr, Lc);
        if (nu >= 0) HG_LOAD_C(nu, nfraw, nqraw, nlbl, nvt, nstt4, ngraw);
        const v4u g0 = graw[0], g1 = graw[1];
        {
            const int k = tid & 127, seg = tid >> 7;
            float cum[16], kk[16], mid, last;
            hg_cum(lds, tid, fraw, lbl, cum, kk, mid, last);
#pragma unroll
            for (int i = 0; i < 16; ++i) {
                const float q = bf2f(qraw[i]);
                const int o = (seg * 16 + i) * HP + k * 2;
                *(LAS unsigned short*)(lds + HG_QD + o) = f2bf(q * __expf(cum[i]));
                *(LAS unsigned short*)(lds + HG_QR + o) = f2bf(q * __expf(fminf(cum[i] - mid, 80.f)));
                *(LAS unsigned short*)(lds + HG_KR + o) = f2bf(kk[i] * __expf(fminf(mid - cum[i], 80.f)));
            }
        }
        tile_st<2>(vt, lds + HG_V, tid);
        tile_st<4>(stt4, lds + HG_S, tid);
        if (nu >= 0) {
#pragma unroll
            for (int i = 0; i < 16; ++i) { fraw[i] = nfraw[i]; qraw[i] = nqraw[i]; }
            lbl[0] = nlbl[0]; lbl[1] = nlbl[1]; lbl[2] = nlbl[2]; vt[0] = nvt[0]; vt[1] = nvt[1];
#pragma unroll
            for (int i = 0; i < 4; ++i) stt4[i] = nstt4[i];
            graw[0] = ngraw[0]; graw[1] = ngraw[1]; }
        __syncthreads();
        {
            const int tt = wave >> 1;
#pragma unroll
            for (int j = 0; j < 2; ++j) {
                const int stl = (wave & 1) * 2 + j;
                f32x4 sc = (f32x4){0.f, 0.f, 0.f, 0.f};
                if (stl <= tt) {
#pragma unroll
                    for (int ks = 0; ks < 4; ++ks) sc = MFMA16(rowfrag(lds + HG_QR, HP, 16 * tt, 32 * ks, fr, fq), rowfrag(lds + HG_KR, HP, 16 * stl, 32 * ks, fr, fq), sc);
                }
#pragma unroll
                for (int r = 0; r < 4; ++r) { const int t = 16 * tt + 4 * fq + r, s = 16 * stl + fr;
                    *(LAS unsigned short*)(lds + HG_P + t * PP + s * 2) = f2bf(s <= t ? sc[r] : 0.f); }
            }
        }
        __syncthreads();
        {
            const int tt = wave >> 1, n0 = (wave & 1) * 4;
            f32x4 acc[4];
#pragma unroll
            for (int n = 0; n < 4; ++n) acc[n] = (f32x4){0.f, 0.f, 0.f, 0.f};
#pragma unroll
            for (int ks = 0; ks < 4; ++ks) { const bf16x8 A = rowfrag(lds + HG_QD, HP, 16 * tt, 32 * ks, fr, fq);
#pragma unroll
                for (int n = 0; n < 4; ++n) acc[n] = MFMA16(A, trfrag(lds + HG_S, HP, 32 * ks, 16 * (n0 + n), lane), acc[n]); }
#pragma unroll
            for (int ks = 0; ks < 2; ++ks) { const bf16x8 A = rowfrag(lds + HG_P, PP, 16 * tt, 32 * ks, fr, fq);
#pragma unroll
                for (int n = 0; n < 4; ++n) acc[n] = MFMA16(A, trfrag(lds + HG_V, HP, 32 * ks, 16 * (n0 + n), lane), acc[n]); }
#pragma unroll
            for (int n = 0; n < 4; ++n)
#pragma unroll
                for (int r = 0; r < 4; ++r) *(LAS float*)(lds + HG_O + (16 * tt + 4 * fq + r) * OP + (16 * (n0 + n) + fr) * 4) = acc[n][r];
        }
        __syncthreads();
        {
            const int t = tid >> 3, part = tid & 7, v0 = part * 16;
            f32x4 o[4]; float ss = 0.f;
#pragma unroll
            for (int j = 0; j < 4; ++j) { o[j] = *(LAS const f32x4*)(lds + HG_O + t * OP + (v0 + 4 * j) * 4); ss += (o[j].x * o[j].x + o[j].y * o[j].y) + (o[j].z * o[j].z + o[j].w * o[j].w); }
            ss += __shfl_xor(ss, 1); ss += __shfl_xor(ss, 2); ss += __shfl_xor(ss, 4);
            const float inv = 1.0f / sqrtf(ss * (1.0f / 128.0f) + EPS);
            const float* gn = gain + h * 128 + v0;
            v4u w0, w1;
#pragma unroll
            for (int i = 0; i < 4; ++i) {
                const float ga = bflo(g0[i]), gb = bfhi(g0[i]), gc = bflo(g1[i]), gd = bfhi(g1[i]);
                const int e = 2 * i;
                const float oa = o[e >> 2][e & 3], ob = o[(e + 1) >> 2][(e + 1) & 3], oc = o[(8 + e) >> 2][(8 + e) & 3], od = o[(9 + e) >> 2][(9 + e) & 3];
                w0[i] = pk2(oa * inv * gn[e] * siluf_(ga), ob * inv * gn[e + 1] * siluf_(gb));
                w1[i] = pk2(oc * inv * gn[8 + e] * siluf_(gc), od * inv * gn[9 + e] * siluf_(gd));
            }
            bf16* yo = y + (size_t)(m0 + t) * 1024 + 512 + h * 128 + v0;
            *(v4u*)yo = w0; *(v4u*)(yo + 8) = w1;
        }
        __syncthreads();
        unit = nu;
    }
}

constexpr int SG_STAT = 0, SG_W = 1024, SG_V = 35840, SGVP = 528;
__device__ __forceinline__ void phase_sgu(const Args& a, LAS unsigned char* lds, int tid, int lane, int wave, const Grp& gr) {
    const bf16* z = (const bf16*)(a.ws + WS_P); bf16* y = (bf16*)(a.ws + WS_H);
    const float* lng = a.in[14]; const float* lnb = a.in[15]; const float* ws = a.in[16]; const float* bs = a.in[17];
    const int fr = lane & 15, fq = lane >> 4;
    for (int L = gr.gi;; L += gr.GS) {
        int b_, j_; if (!grp_item(gr, L, 32, b_, j_)) break; const int unit = b_ * 32 + j_;
        const int m0 = unit * 128;
        LAS float* stt = (LAS float*)(lds + SG_STAT);
        {
            const bf16* vb = z + (size_t)m0 * NIN1 + 1024 + lane * 8;
            v4u a0 = *(const v4u*)(vb + (size_t)wave * NIN1), a1 = *(const v4u*)(vb + (size_t)wave * NIN1 + 512);
            for (int r = wave; r < 128; r += 8) {
                float x[16]; unpack8(a0, x, 0); unpack8(a1, x, 8);
                if (r + 8 < 128) { a0 = *(const v4u*)(vb + (size_t)(r + 8) * NIN1); a1 = *(const v4u*)(vb + (size_t)(r + 8) * NIN1 + 512); }
                float s = 0.f, q = 0.f;
#pragma unroll
                for (int i = 0; i < 16; ++i) { s += x[i]; q += x[i] * x[i]; }
#pragma unroll
                for (int o = 1; o < 64; o <<= 1) { s += __shfl_xor(s, o); q += __shfl_xor(q, o); }
                const float mean = s * (1.0f / 1024.0f);
                const float var = fmaxf(q * (1.0f / 1024.0f) - mean * mean, 0.f);
                if (lane == 0) { stt[2 * r] = mean; stt[2 * r + 1] = 1.0f / sqrtf(var + EPS); }
            }
        }
        __syncthreads();
        for (int g = 0; g < 4; ++g) {
            {
                const int t = tid >> 2, s0 = (tid & 3) * 32;
                const float* wr = ws + (size_t)g * 16384 + t * 128 + s0;
#pragma unroll
                for (int j = 0; j < 4; ++j) {
                    const f32x4 w0 = *(const f32x4*)(wr + 8 * j), w1 = *(const f32x4*)(wr + 8 * j + 4);
                    const int s = s0 + 8 * j;
                    v4u o;
                    o.x = pk2(s + 0 <= t ? w0.x : 0.f, s + 1 <= t ? w0.y : 0.f); o.y = pk2(s + 2 <= t ? w0.z : 0.f, s + 3 <= t ? w0.w : 0.f);
                    o.z = pk2(s + 4 <= t ? w1.x : 0.f, s + 5 <= t ? w1.y : 0.f); o.w = pk2(s + 6 <= t ? w1.z : 0.f, s + 7 <= t ? w1.w : 0.f);
                    *(LAS v4u*)(lds + SG_W + t * HP + s * 2) = o;
                }
            }
#pragma unroll 2
            for (int i = 0; i < 8; ++i) {
                const int id = tid + NT * i, s = id >> 5, dc = (id & 31) * 8, col = g * 256 + dc;
                const v4u vv = *(const v4u*)(z + (size_t)(m0 + s) * NIN1 + 1024 + col);
                const float mean = stt[2 * s], rstd = stt[2 * s + 1];
                const f32x4 g0 = *(const f32x4*)(lng + col), g1 = *(const f32x4*)(lng + col + 4), b0 = *(const f32x4*)(lnb + col), b1 = *(const f32x4*)(lnb + col + 4);
                v4u o;
                o.x = pk2((bflo(vv.x) - mean) * rstd * g0.x + b0.x, (bfhi(vv.x) - mean) * rstd * g0.y + b0.y);
                o.y = pk2((bflo(vv.y) - mean) * rstd * g0.z + b0.z, (bfhi(vv.y) - mean) * rstd * g0.w + b0.w);
                o.z = pk2((bflo(vv.z) - mean) * rstd * g1.x + b1.x, (bfhi(vv.z) - mean) * rstd * g1.y + b1.y);
                o.w = pk2((bflo(vv.w) - mean) * rstd * g1.z + b1.z, (bfhi(vv.w) - mean) * rstd * g1.w + b1.w);
                *(LAS v4u*)(lds + SG_V + s * SGVP + dc * 2) = o;
            }
            __syncthreads();
            f32x4 acc[16];
#pragma unroll
            for (int n = 0; n < 16; ++n) acc[n] = (f32x4){0.f, 0.f, 0.f, 0.f};
            for (int ks = 0; ks < 4; ++ks) {
                if (32 * ks > 16 * wave + 15) break;
                const bf16x8 A = rowfrag(lds + SG_W, HP, 16 * wave, 32 * ks, fr, fq);
#pragma unroll
                for (int n = 0; n < 16; ++n) acc[n] = MFMA16(A, trfrag(lds + SG_V, SGVP, 32 * ks, 16 * n, lane), acc[n]);
            }
            __syncthreads();
#pragma unroll
            for (int r = 0; r < 4; ++r) {
                const int t = 16 * wave + 4 * fq + r; const float bsv = bs[g * 128 + t];
#pragma unroll
                for (int n = 0; n < 16; ++n) *(LAS unsigned short*)(lds + SG_V + t * SGVP + (16 * n + fr) * 2) = f2bf(acc[n][r] + bsv);
            }
            __syncthreads();
#pragma unroll 4
            for (int i = 0; i < 8; ++i) {
                const int id = tid + NT * i, t = id >> 5, dc = (id & 31) * 8;
                const v4u mx = *(LAS const v4u*)(lds + SG_V + t * SGVP + dc * 2);
                const v4u uu = *(const v4u*)(z + (size_t)(m0 + t) * NIN1 + g * 256 + dc);
                v4u o;
#pragma unroll
                for (int j = 0; j < 4; ++j) o[j] = pk2(bflo(mx[j]) * bflo(uu[j]), bfhi(mx[j]) * bfhi(uu[j]));
                *(v4u*)(y + (size_t)(m0 + t) * 1024 + g * 256 + dc) = o;
            }
            __syncthreads();
        }
    }
}

#ifndef MK_N_LAUNCHES
#define MK_N_LAUNCHES 1
#endif

__global__ void __launch_bounds__(512, 2) fwd(Args a) {
    extern __shared__ __attribute__((aligned(16))) unsigned char lds_raw[];
    LAS unsigned char* lds = (LAS unsigned char*)lds_raw;
    cg::grid_group grid = cg::this_grid();
    volatile LAS unsigned* MISC = (volatile LAS unsigned*)(lds + MISC_OFF);
    if (threadIdx.x < 16) MISC[threadIdx.x] = 0u;
    __syncthreads();
    const XcdBarrier xbar = xcd_barrier_post((unsigned*)(a.ws + WS_BAR), MISC + 8);
    if (threadIdx.x == 0) MISC[11] = xb_add((unsigned*)(a.ws + WS_BAR) + GB_RANK(xbar.x), 1u);
    const int lo = a.ph_lo, hi = a.ph_hi;
#define IN(k) (lo <= (k) && (k) < hi)
#ifndef DBL_MASK
#define DBL_MASK 0
#endif
#define REP(k) _Pragma("unroll 1") for (int rep_ = 0; rep_ <= ((DBL_MASK >> (k)) & 1); ++rep_)
#define SEAM(k) do { if (IN(k) && IN((k) + 1)) { if ((k) == 0 || (k) == 7 || (k) == 10 || (k) == 14) xcd_barrier(xbar);   \
        else { const Grp gb_ = make_grp(MISC); grp_barrier((unsigned*)(a.ws + WS_BAR), xbar.x, gb_); } \
        if ((k) == 0) { if (threadIdx.x == 0) { unsigned dense = 0u; for (unsigned j_ = 0; j_ < 16u; ++j_) if (j_ < xbar.x && xb_ld((unsigned*)(a.ws + WS_BAR) + XB_XCNT(j_)) > 0u) ++dense; MISC[10] = dense; } __syncthreads(); } } } while (0)
#define PHASE_VARS int tid = threadIdx.x; asm volatile("" : "+v"(tid)); int G = gridDim.x; asm volatile("" : "+s"(G)); \
    const int lane = tid & 63, wave = __builtin_amdgcn_readfirstlane(tid >> 6); (void)lane; (void)wave; \
    const Grp gr = make_grp(MISC); (void)gr; bf16* const H = (bf16*)(a.ws + WS_H); bf16* const P = (bf16*)(a.ws + WS_P); const float* const modf = (const float*)(a.ws + WS_MODF); (void)H; (void)P; (void)modf;
#define GEMM_RES(ph, l, ffn) if (IN(ph)) REP(ph) { PHASE_VARS \
        const bf16* Bt = (ffn) ? (const bf16*)(a.ws + WS_WFF2) + (size_t)(l) * 1024 * 4096 : (const bf16*)(a.ws + ((l) ? WS_WOUT1 : WS_WOUT0)); \
        pg8::Gemm g{(ffn) ? P : H, Bt, M, 1024, (ffn) ? 4096 : 1024}; GroupOrder S; S.init(1024, gr); \
        if ((ph) == 6) { pg8::EpiResGateBf<true> E{a.in[0], (bf16*)(a.ws + WS_XR), modf + (size_t)(l) * 8 * 6144 + ((ffn) ? 5 : 2) * 1024}; \
            pg8::gemm_phase<pg8::EpiResGateBf<true>, GroupOrder, false, true>(lds, g, S, E); } \
        else { pg8::EpiResGateBf<false> E{a.ws + WS_XR, (bf16*)(a.ws + WS_XR), modf + (size_t)(l) * 8 * 6144 + ((ffn) ? 5 : 2) * 1024}; \
            pg8::gemm_phase<pg8::EpiResGateBf<false>, GroupOrder, false, true>(lds, g, S, E); } } SEAM(ph);
#define GEMM_FF1(ph, l) if (IN(ph)) REP(ph) { PHASE_VARS \
        pg8::Gemm g{H, (const bf16*)(a.ws + WS_WFF1) + (size_t)(l) * 4096 * 1024, M, FF, 1024}; GroupOrder S; S.init(FF, gr); \
        pg8::EpiBf16<2> E{P, FF, nullptr}; \
        pg8::gemm_phase<pg8::EpiBf16<2>, GroupOrder, true, true>(lds, g, S, E); } SEAM(ph);
#define NORM(ph, l, ffn) if (IN(ph)) REP(ph) { PHASE_VARS \
        phase_norm_bf(a, ((ffn) ? a.in[5] : a.in[4]) + (l) * 1024, (l), (ffn) ? 3 : 0, (ffn) ? 4 : 1, tid, lane, wave, gr); } SEAM(ph);

    if (a.ph_hi > NPH) grid.sync();
    if (IN(0)) REP(0) { PHASE_VARS phase_prologue(a, lds, tid, lane, wave, G); } SEAM(0);
    if (IN(1)) REP(1) { PHASE_VARS phase_norm<true>(a, lds, a.in[0], a.in[4], 0, 0, 1, tid, lane, wave, gr); } SEAM(1);
    if (IN(2)) REP(2) { PHASE_VARS
        pg8::Gemm g{H, (const bf16*)(a.ws + WS_WIN0), M, NIN0, 1024}; GroupOrder S; S.init(NIN0, gr);
        pg8::EpiBf16<0> E{P, NIN0, nullptr};
        pg8::gemm_phase<pg8::EpiBf16<0>, GroupOrder, true, true>(lds, g, S, E); } SEAM(2);
    if (IN(3)) REP(3) { PHASE_VARS conv_mixer(a, tid, gr); hg_pass_a(a, lds, tid, lane, wave, gr); } SEAM(3);
    if (IN(4)) REP(4) { PHASE_VARS hg_pass_b(a, tid, gr); } SEAM(4);
    if (IN(5)) REP(5) { PHASE_VARS hg_pass_c(a, lds, tid, lane, wave, gr); } SEAM(5);
    GEMM_RES(6, 0, false)
    NORM(7, 0, true)
    GEMM_FF1(8, 0)
    GEMM_RES(9, 0, true)
    NORM(10, 1, false)
    if (IN(11)) REP(11) { PHASE_VARS
        pg8::Gemm g{H, (const bf16*)(a.ws + WS_WIN1), M, NIN1, 1024}; GroupOrder S; S.init(NIN1, gr);
        pg8::EpiBf16<1> E{P, NIN1, a.in[13]};
        pg8::gemm_phase<pg8::EpiBf16<1>, GroupOrder, true, true>(lds, g, S, E); } SEAM(11);
    if (IN(12)) REP(12) { PHASE_VARS phase_sgu(a, lds, tid, lane, wave, gr); } SEAM(12);
    GEMM_RES(13, 1, false)
    NORM(14, 1, true)
    GEMM_FF1(15, 1)
    GEMM_RES(16, 1, true)
    if (IN(17)) REP(17) { PHASE_VARS phase_final_norm(a, lane, wave, gr); }
}
}

extern "C" void kernel_launch(void* const* d_in, const int* in_sizes, int n_in, void* d_out, int out_size, void* d_ws, size_t ws_size, hipStream_t stream) {
    using namespace mk;
    static int grid = 0;
    if (grid == 0) {
        if (n_in != 22 || out_size != M * D || ws_size < WS_END) { fprintf(stderr, "kernel_launch: unexpected shapes (n_in %d out %d ws %zu)\n", n_in, out_size, ws_size); grid = -1; return; }
        int dev = 0, cus = 0, per_cu = 0;
        (void)hipGetDevice(&dev); (void)hipDeviceGetAttribute(&cus, hipDeviceAttributeMultiprocessorCount, dev);
        if (hipFuncSetAttribute((const void*)fwd, hipFuncAttributeMaxDynamicSharedMemorySize, LDS_BYTES) != hipSuccess) fprintf(stderr, "kernel_launch: hipFuncSetAttribute failed\n");
        if (hipOccupancyMaxActiveBlocksPerMultiprocessor(&per_cu, (const void*)fwd, NT, LDS_BYTES) != hipSuccess || per_cu < 1) { fprintf(stderr, "kernel_launch: occupancy query says %d\n", per_cu); per_cu = 1; }
        (void)hipGetLastError();
        grid = cus * per_cu;
        if (grid <= 0) grid = 256;
    }
    if (grid < 0) return;
    if (hipMemsetAsync((char*)d_ws + WS_BAR, 0, BAR_ZERO_BYTES, stream) != hipSuccess) fprintf(stderr, "kernel_launch: memset of barrier words failed\n");
    Args a{};
    for (int i = 0; i < 22; ++i) a.in[i] = (const float*)d_in[i];
    a.out = (float*)d_out; a.ws = (unsigned char*)d_ws;
#if MK_N_LAUNCHES == 1
    a.ph_lo = 0; a.ph_hi = NPH;
    void* args[] = {&a};
    hipError_t e = hipLaunchCooperativeKernel((const void*)fwd, dim3(grid), dim3(NT), args, LDS_BYTES, stream);
    if (e != hipSuccess) fprintf(stderr, "cooperative launch failed: %s (grid %d)\n", hipGetErrorString(e), grid);
#else
    for (int ph = 0; ph < NPH; ++ph) {
        a.ph_lo = ph; a.ph_hi = ph + 1;
        hipLaunchKernelGGL(fwd, dim3(grid), dim3(NT), LDS_BYTES, stream, a);
    }
#endif
}
```
